# Optimizing an MI355X kernel written in HIP

```python
import jax, jax.numpy as jnp
from jax import lax
import numpy as np

D_MODEL = 1024
BATCH = 8
SEQ = 4096
DEPTH = 4

GRID_W = 64
N_MEM = 256
M_HEADS = 4
M_DQK = 64
M_DV = 128
M_CHUNK = 128
M_CONV = 5
NA_HEADS = 4
NA_DH = 64
NA_KH_MAX = 8
NA_KW = 16
MEM_HEADS = 4
MEM_DH = 64
N_EXPERTS = 16
EC_CAPACITY = 2
D_FF_EXPERT = 2048

N_GATES = 4 * M_HEADS
MIX_WIDTH = M_HEADS * M_DV + NA_HEADS * NA_DH + MEM_HEADS * MEM_DH
COL_SIZES = (M_HEADS * M_DQK, M_HEADS * M_DQK, M_HEADS * M_DV, M_HEADS * M_DV, N_GATES,
             NA_HEADS * NA_DH, NA_HEADS * NA_DH, NA_HEADS * NA_DH, MEM_HEADS * MEM_DH)
D_IN_PROJ = sum(COL_SIZES)
EPS = 1e-6

kernel_name = 'hybrid_mlstm_natten_ec_moe_encoder'


def rms_norm(x, g):
    xf = x.astype(jnp.float32)
    y = xf * lax.rsqrt(jnp.mean(xf * xf, axis=-1, keepdims=True) + EPS)
    return (y * g.astype(jnp.float32)).astype(x.dtype)


def to_heads(t, n_heads):
    bsz, s, _ = t.shape
    return t.reshape(bsz, s, n_heads, -1).transpose(0, 2, 1, 3)


def from_heads(t):
    bsz, nh, s, d = t.shape
    return t.transpose(0, 2, 1, 3).reshape(bsz, s, nh * d)


def split_columns(proj):
    parts, start = [], 0
    for size in COL_SIZES:
        parts.append(proj[..., start:start + size])
        start += size
    return parts


def centred_dwconv(u, w):
    kw = w.shape[0]
    pad = kw // 2
    s = u.shape[1]
    up = jnp.pad(u, ((0, 0), (pad, pad), (0, 0)))
    return sum(up[:, j:j + s] * w[j] for j in range(kw))


def mlstm_chunkwise(q, k, v, log_i, log_f):
    bsz, nh, s, dk = q.shape
    dv = v.shape[-1]
    L = M_CHUNK
    nc = s // L
    q = q.reshape(bsz, nh, nc, L, dk) * (dk ** -0.5)
    k = k.reshape(bsz, nh, nc, L, dk)
    v = v.reshape(bsz, nh, nc, L, dv)
    li = log_i.reshape(bsz, nh, nc, L)
    b = jnp.cumsum(log_f.reshape(bsz, nh, nc, L), axis=-1)
    g = b[..., -1]
    earlier_or_same = jnp.tril(jnp.ones((L, L), dtype=bool))
    d_log = jnp.where(earlier_or_same, b[..., :, None] - b[..., None, :] + li[..., None, :], -jnp.inf)
    w_log = g[..., None] - b + li
    a = jnp.max(w_log, axis=-1)
    w = jnp.exp(w_log - a[..., None])
    kv_chunk = jnp.einsum('bhcsk,bhcsv->bhckv', k * w[..., None], v)
    n_chunk = jnp.einsum('bhcs,bhcsk->bhck', w, k)

    def step(carry, inp):
        c_st, n_st, m_st = carry
        kv_c, n_c, a_c, g_c = inp
        m_new = jnp.maximum(g_c + m_st, a_c)
        s_prev = jnp.exp(g_c + m_st - m_new)
        s_cur = jnp.exp(a_c - m_new)
        c_new = s_prev[..., None, None] * c_st + s_cur[..., None, None] * kv_c
        n_new = s_prev[..., None] * n_st + s_cur[..., None] * n_c
        return (c_new, n_new, m_new), (c_st, n_st, m_st)

    init = (jnp.zeros((bsz, nh, dk, dv), jnp.float32),
            jnp.zeros((bsz, nh, dk), jnp.float32),
            jnp.zeros((bsz, nh), jnp.float32))
    xs = (jnp.moveaxis(kv_chunk, 2, 0), jnp.moveaxis(n_chunk, 2, 0), jnp.moveaxis(a, 2, 0), jnp.moveaxis(g, 2, 0))
    _, (c_prev, n_prev, m_prev) = lax.scan(step, init, xs)
    c_prev = jnp.moveaxis(c_prev, 0, 2)
    n_prev = jnp.moveaxis(n_prev, 0, 2)
    m_prev = jnp.moveaxis(m_prev, 0, 2)
    inter_log = b + m_prev[..., None]
    m_t = jnp.maximum(inter_log, jnp.max(d_log, axis=-1))
    s_inter = jnp.exp(inter_log - m_t)
    scores = jnp.einsum('bhctk,bhcsk->bhcts', q, k) * jnp.exp(d_log - m_t[..., None])
    num = s_inter[..., None] * jnp.einsum('bhctk,bhckv->bhctv', q, c_prev) + jnp.einsum('bhcts,bhcsv->bhctv', scores, v)
    den = s_inter * jnp.einsum('bhctk,bhck->bhct', q, n_prev) + jnp.sum(scores, axis=-1)
    h = num / jnp.maximum(jnp.abs(den), jnp.exp(-m_t))[..., None]
    return h.reshape(bsz, nh, s, dv)


def mlstm_mixer(q, k, v, o, gate_pre, b_gate, conv_w, g_head):
    dtype = v.dtype
    bsz, s, _ = v.shape
    qk = jax.nn.silu(centred_dwconv(jnp.concatenate([q, k], axis=-1), conv_w))
    q, k = jnp.split(qk, 2, axis=-1)
    q = to_heads(q, M_HEADS).astype(jnp.float32)
    k = to_heads(k, M_HEADS).astype(jnp.float32)
    v = to_heads(v, M_HEADS).astype(jnp.float32)
    gates = (gate_pre + b_gate).astype(jnp.float32).reshape(bsz, s, 4, M_HEADS).transpose(2, 0, 3, 1)
    i_fw, f_fw, i_bw, f_bw = gates[0], gates[1], gates[2], gates[3]
    flip = lambda t: jnp.flip(t, axis=2)
    h_fw = mlstm_chunkwise(q, k, v, i_fw, jax.nn.log_sigmoid(f_fw))
    h_bw = flip(mlstm_chunkwise(flip(q), flip(k), flip(v), flip(i_bw), jax.nn.log_sigmoid(flip(f_bw))))
    h = rms_norm(h_fw + h_bw, g_head.reshape(M_HEADS, 1, M_DV))
    return (jax.nn.sigmoid(o.astype(jnp.float32)) * from_heads(h)).astype(dtype)


def neighbourhood_attention(q, k, v, gq, gk, rpb):
    bsz, s, _ = q.shape
    rows = s // GRID_W
    kh = min(NA_KH_MAX, rows)
    q = rms_norm(to_heads(q, NA_HEADS), gq)
    k = rms_norm(to_heads(k, NA_HEADS), gk)
    v = to_heads(v, NA_HEADS)
    qg = q.reshape(bsz, NA_HEADS, rows, GRID_W, NA_DH)
    kg = k.reshape(bsz, NA_HEADS, rows, GRID_W, NA_DH)
    vg = v.reshape(bsz, NA_HEADS, rows, GRID_W, NA_DH)
    r_idx = jnp.arange(rows)
    row_start = jnp.clip(r_idx - kh // 2, 0, rows - kh)
    c_idx = jnp.arange(GRID_W)
    col_start = jnp.clip(c_idx - NA_KW // 2, 0, GRID_W - NA_KW)
    col_win = col_start[:, None] + jnp.arange(NA_KW)[None, :]
    dc = col_win - c_idx[:, None]
    scale = NA_DH ** -0.5

    def row_block(args):
        q_r, r, rs = args
        k_r = lax.dynamic_slice_in_dim(kg, rs, kh, axis=2)
        v_r = lax.dynamic_slice_in_dim(vg, rs, kh, axis=2)
        k_w = k_r[:, :, :, col_win]
        v_w = v_r[:, :, :, col_win]
        dr = rs + jnp.arange(kh) - r
        bias = rpb[:, dr[None, :, None] + NA_KH_MAX - 1, dc[:, None, :] + NA_KW - 1]
        sc = jnp.einsum('bhwd,bhiwjd->bhwij', q_r, k_w).astype(jnp.float32) * scale + bias.astype(jnp.float32)
        p = jax.nn.softmax(sc.reshape(sc.shape[:3] + (kh * NA_KW,)), axis=-1).reshape(sc.shape).astype(v_w.dtype)
        return jnp.einsum('bhwij,bhiwjd->bhwd', p, v_w)

    out = lax.map(row_block, (jnp.moveaxis(qg, 2, 0), r_idx, row_start))
    out = jnp.moveaxis(out, 0, 2).reshape(bsz, NA_HEADS, s, NA_DH)
    return from_heads(out)


def memory_cross_attention(q, mem_h, w_kv, gq, gk):
    q = rms_norm(to_heads(q, MEM_HEADS), gq)
    kv = jnp.einsum('bmd,de->bme', mem_h, w_kv)
    k_m, v_m = jnp.split(kv, 2, axis=-1)
    k_m = rms_norm(to_heads(k_m, MEM_HEADS), gk)
    v_m = to_heads(v_m, MEM_HEADS)
    sc = jnp.einsum('bhqd,bhmd->bhqm', q, k_m).astype(jnp.float32) * (MEM_DH ** -0.5)
    p = jax.nn.softmax(sc, axis=-1).astype(v_m.dtype)
    return from_heads(jnp.einsum('bhqm,bhmd->bhqd', p, v_m))


def expert_choice_ffn(h, w_router, w1, w3, w2):
    bsz, s, d = h.shape
    cap = EC_CAPACITY * s // N_EXPERTS
    aff = jax.nn.softmax(jnp.einsum('bsd,de->bse', h, w_router).astype(jnp.float32), axis=-1)
    gate, idx = lax.top_k(jnp.swapaxes(aff, 1, 2), cap)
    xe = jax.vmap(lambda hb, ib: hb[ib])(h, idx)
    hid = jax.nn.silu(jnp.einsum('becd,edf->becf', xe, w1)) * jnp.einsum('becd,edf->becf', xe, w3)
    ye = jnp.einsum('becf,efd->becd', hid, w2) * gate[..., None].astype(h.dtype)
    return jax.vmap(lambda yb, ib: jnp.zeros((s, d), h.dtype).at[ib.reshape(-1)].add(yb.reshape(-1, d)))(ye, idx)


def setup_inputs(seed: int = 0) -> dict:
    key = jax.random.key(seed)
    ks = jax.random.split(key, 24)
    nrm = lambda k, shape, sc: jax.random.normal(k, shape, jnp.float32) * sc
    gain = lambda k, shape: 1.0 + 0.02 * jax.random.normal(k, shape, jnp.float32)
    f_bias = jnp.linspace(3.0, 6.0, M_HEADS)
    zeros_h = jnp.zeros((M_HEADS,), jnp.float32)
    gate_base = jnp.concatenate([zeros_h, f_bias, zeros_h, f_bias])
    return {
        'x': nrm(ks[0], (BATCH, SEQ, D_MODEL), 1.0),
        'mem': nrm(ks[1], (BATCH, N_MEM, D_MODEL), 1.0),
        'g_mix': gain(ks[2], (DEPTH, D_MODEL)),
        'w_in': nrm(ks[3], (DEPTH, D_MODEL, D_IN_PROJ), D_MODEL ** -0.5),
        'b_gates': gate_base[None, :] + nrm(ks[4], (DEPTH, N_GATES), 0.1),
        'conv_qk': nrm(ks[5], (DEPTH, M_CONV, 2 * M_HEADS * M_DQK), M_CONV ** -0.5),
        'g_mlstm_head': gain(ks[6], (DEPTH, M_HEADS * M_DV)),
        'na_gq': gain(ks[7], (DEPTH, NA_DH)),
        'na_gk': gain(ks[8], (DEPTH, NA_DH)),
        'na_rpb': nrm(ks[9], (DEPTH, NA_HEADS, 2 * NA_KH_MAX - 1, 2 * NA_KW - 1), 0.1),
        'g_mem': gain(ks[10], (DEPTH, D_MODEL)),
        'w_mem_kv': nrm(ks[11], (DEPTH, D_MODEL, 2 * MEM_HEADS * MEM_DH), D_MODEL ** -0.5),
        'mem_gq': gain(ks[12], (DEPTH, MEM_DH)),
        'mem_gk': gain(ks[13], (DEPTH, MEM_DH)),
        'w_out': nrm(ks[14], (DEPTH, MIX_WIDTH, D_MODEL), MIX_WIDTH ** -0.5),
        'g_ffn': gain(ks[15], (DEPTH, D_MODEL)),
        'w_router': nrm(ks[16], (DEPTH, D_MODEL, N_EXPERTS), D_MODEL ** -0.5),
        'w1': nrm(ks[17], (DEPTH, N_EXPERTS, D_MODEL, D_FF_EXPERT), D_MODEL ** -0.5),
        'w3': nrm(ks[18], (DEPTH, N_EXPERTS, D_MODEL, D_FF_EXPERT), D_MODEL ** -0.5),
        'w2': nrm(ks[19], (DEPTH, N_EXPERTS, D_FF_EXPERT, D_MODEL), D_FF_EXPERT ** -0.5),
    }


def reference(x, mem, g_mix, w_in, b_gates, conv_qk, g_mlstm_head, na_gq, na_gk, na_rpb,
              g_mem, w_mem_kv, mem_gq, mem_gk, w_out, g_ffn, w_router, w1, w3, w2):
    for l in range(DEPTH):
        h = rms_norm(x, g_mix[l])
        proj = jnp.einsum('bsd,de->bse', h, w_in[l])
        mq, mk, mv, mo, mg, nq, nk, nv, cq = split_columns(proj)
        y_m = mlstm_mixer(mq, mk, mv, mo, mg, b_gates[l], conv_qk[l], g_mlstm_head[l])
        y_n = neighbourhood_attention(nq, nk, nv, na_gq[l], na_gk[l], na_rpb[l])
        y_c = memory_cross_attention(cq, rms_norm(mem, g_mem[l]), w_mem_kv[l], mem_gq[l], mem_gk[l])
        x = x + jnp.einsum('bse,ed->bsd', jnp.concatenate([y_m, y_n, y_c], axis=-1), w_out[l])
        x = x + expert_choice_ffn(rms_norm(x, g_ffn[l]), w_router[l], w1[l], w3[l], w2[l])
    return x
```

```cpp
#include <hip/hip_runtime.h>
#include <cstdio>
#include <cstdint>

constexpr size_t MiB = (size_t)1 << 20;
constexpr size_t WS_CTL = 0, CTL_BYTES = 1 * MiB;
constexpr size_t WS_WIN = 1 * MiB, WS_WKV = 21 * MiB, WS_WOUT = 25 * MiB, WS_W13 = 33 * MiB, WS_W2 = 545 * MiB;
constexpr size_t WS_H = 801 * MiB, WS_MEMH = 865 * MiB, WS_PROJ = 881 * MiB, WS_GATES = 1041 * MiB, WS_KVMEM = 1043 * MiB, WS_Y = 1051 * MiB;
constexpr size_t WS_AFF = 1115 * MiB, WS_ROUTE = 1117 * MiB, WS_XE = 1121 * MiB, WS_XB = WS_XE, WS_RR = WS_ROUTE + 3 * MiB, WS_OG = WS_H + 32 * MiB, WS_HID = 1249 * MiB, WS_YBUF = 1505 * MiB, WS_QKC = 1633 * MiB, WS_HDIR = 1665 * MiB, WS_VT = 1793 * MiB, WS_NVT = 1825 * MiB, WS_NRM = 1841 * MiB, WS_KMN = 1889 * MiB, WS_VMT = 1893 * MiB, WS_GT = 1897 * MiB, WS_END = 1898 * MiB;
constexpr size_t WS_MKV = WS_HID, WS_MCP = WS_HID + 64 * MiB, WS_MN = WS_HID + 96 * MiB, WS_MNP = WS_HID + 97 * MiB, WS_MCST = WS_HID + 98 * MiB, WS_MMP = WS_HID + 98 * MiB + 512 * 1024, WS_MGST = WS_HID + 99 * MiB;
constexpr size_t RT_SLOTTOK = 0, RT_GATE = 256 * 1024, RT_SLOTMAP = 1 * MiB;
constexpr int CW_BAR = 1024;


__device__ __forceinline__ float shx(float v, int mask, int lane) { return __int_as_float(__builtin_amdgcn_ds_bpermute((lane ^ mask) << 2, __float_as_int(v))); }
__device__ __forceinline__ float shu(float v, int o, int lane) { return __int_as_float(__builtin_amdgcn_ds_bpermute(((lane - o) & 63) << 2, __float_as_int(v))); }
__device__ __forceinline__ float shd(float v, int o, int lane) { return __int_as_float(__builtin_amdgcn_ds_bpermute(((lane + o) & 63) << 2, __float_as_int(v))); }
__device__ __forceinline__ float shb(float v, int src) { return __int_as_float(__builtin_amdgcn_ds_bpermute(src << 2, __float_as_int(v))); }
__device__ __forceinline__ unsigned shuu(unsigned v, int o, int lane) { return (unsigned)__builtin_amdgcn_ds_bpermute(((lane - o) & 63) << 2, (int)v); }

typedef unsigned u32x2s __attribute__((ext_vector_type(2)));
__device__ __forceinline__ float rows_sum4(float v) {
    u32x2s r = __builtin_amdgcn_permlane16_swap(__float_as_uint(v), __float_as_uint(v), false, false); v = __uint_as_float(r.x) + __uint_as_float(r.y);
    r = __builtin_amdgcn_permlane32_swap(__float_as_uint(v), __float_as_uint(v), false, false); return __uint_as_float(r.x) + __uint_as_float(r.y); }
__device__ __forceinline__ float rows_max4(float v) {
    u32x2s r = __builtin_amdgcn_permlane16_swap(__float_as_uint(v), __float_as_uint(v), false, false); v = fmaxf(__uint_as_float(r.x), __uint_as_float(r.y));
    r = __builtin_amdgcn_permlane32_swap(__float_as_uint(v), __float_as_uint(v), false, false); return fmaxf(__uint_as_float(r.x), __uint_as_float(r.y)); }
namespace pg8 {
#define PG8_LAS __attribute__((address_space(3)))
typedef unsigned short bf16_t;
typedef short bf16x8 __attribute__((ext_vector_type(8)));
typedef float f32x4 __attribute__((ext_vector_type(4)));
typedef unsigned u32x4 __attribute__((ext_vector_type(4)));
constexpr int BM = 256, BK = 64, HALF = 128, HTB = HALF * BK * 2  , STAGE_BYTES = 8 * HTB, NXCD = 8, WGM = 8;

__host__ __device__ __forceinline__ int lds_byte(int r, int c) { const int st = (r >> 4) * 2 + (c >> 5), rr = r & 15, cc = c & 31, ob = rr * 64 + cc * 2; return st * 1024 + (ob ^ (((ob >> 9) & 1) << 5)); }
__host__ __device__ __forceinline__ void stage_rc(int b, int& R, int& C) { const int st = b / 1024, sb = b % 1024, swz = sb ^ (((sb >> 9) & 1) << 5); R = (st >> 1) * 16 + swz / 64; C = (st & 1) * 32 + (swz % 64) / 2; }
__host__ __device__ __forceinline__ int perm32(int rho) { const int n = rho >> 4, i = rho & 15; return 8 * (i >> 2) + 4 * n + (i & 3); }

struct Unit { int pm, pn; };
struct Gemm { const bf16_t* A; const bf16_t* Bt; int M, N, K; };

struct StaticOrder {
    int nM, nN, nwg, G, c;
    __host__ __device__ void init(int M, int N, int G_, int c_) { nM = M / BM; nN = N / BM; nwg = nM * nN; G = G_; c = c_; }
    __host__ __device__ bool next(int i, Unit& u) const {
        const long L = (long)i * G + c; if (L >= nwg) return false;
        int wgid = (int)L; { const int q = nwg / NXCD, r = nwg % NXCD, xcd = wgid % NXCD, off = wgid / NXCD; wgid = (xcd < r ? xcd * (q + 1) : r * (q + 1) + (xcd - r) * q) + off; }
        const int nig = WGM * nN, gid = wgid / nig, fm = gid * WGM, gsz = (nM - fm) < WGM ? (nM - fm) : WGM;
        u.pm = fm + ((wgid % nig) % gsz); u.pn = (wgid % nig) / gsz; return true;
    }
    __device__ __forceinline__ void a_ready(const Unit&) const {}
    __device__ __forceinline__ void done(const Unit&) const {}
};

__device__ __forceinline__ unsigned cvt_pk_bf16(float lo, float hi) { unsigned r; asm volatile("v_cvt_pk_bf16_f32 %0, %1, %2" : "=v"(r) : "v"(lo), "v"(hi)); return r; }
typedef float f32x2 __attribute__((ext_vector_type(2)));

struct EpiStoreBf16 {
    static constexpr bool PERM = true, AFTER_DRAIN = false;
    bf16_t* O; int ldc; int ncolt;
    __device__ __forceinline__ void operator()(const f32x4 (&acc)[2][2][4][2], const Unit& u, int wr, int wc, int fr, int fq) const {
        const int row0 = u.pm * BM + wr * 64 + fr, col0 = (u.pn % ncolt) * BM + wc * 32 + 8 * fq;
#pragma unroll
        for (int ai = 0; ai < 2; ++ai)
#pragma unroll
            for (int m = 0; m < 4; ++m) { bf16_t* rowp = O + (size_t)(row0 + ai * HALF + m * 16) * ldc + col0;
#pragma unroll
                for (int bj = 0; bj < 2; ++bj) { const f32x4 v0 = acc[ai][bj][m][0], v1 = acc[ai][bj][m][1];
                    u32x4 w; w.x = cvt_pk_bf16(v0[0], v0[1]); w.y = cvt_pk_bf16(v0[2], v0[3]); w.z = cvt_pk_bf16(v1[0], v1[1]); w.w = cvt_pk_bf16(v1[2], v1[3]);
                    *(u32x4*)(rowp + bj * HALF) = w; } }
    }
};
struct EpiResid {
    static constexpr bool PERM = true, AFTER_DRAIN = false;
    bf16_t* X;
    __device__ __forceinline__ void operator()(const f32x4 (&acc)[2][2][4][2], const Unit& u, int wr, int wc, int fr, int fq) const {
        const int row0 = u.pm * BM + wr * 64 + fr, col0 = u.pn * BM + wc * 32 + 8 * fq;
        u32x4 t[2][4][2];
#pragma unroll
        for (int ai = 0; ai < 2; ++ai)
#pragma unroll
            for (int m = 0; m < 4; ++m) { const bf16_t* rowp = X + (size_t)(row0 + ai * HALF + m * 16) * 1024 + col0;
#pragma unroll
                for (int bj = 0; bj < 2; ++bj) t[ai][m][bj] = *(const u32x4*)(rowp + bj * HALF); }
#pragma unroll
        for (int ai = 0; ai < 2; ++ai)
#pragma unroll
            for (int m = 0; m < 4; ++m) { bf16_t* rowp = X + (size_t)(row0 + ai * HALF + m * 16) * 1024 + col0;
#pragma unroll
                for (int bj = 0; bj < 2; ++bj) { const f32x4 v0 = acc[ai][bj][m][0], v1 = acc[ai][bj][m][1]; const u32x4 x = t[ai][m][bj];
                    u32x4 w; w.x = cvt_pk_bf16(v0[0] + __uint_as_float(x.x << 16), v0[1] + __uint_as_float(x.x & 0xffff0000u)); w.y = cvt_pk_bf16(v0[2] + __uint_as_float(x.y << 16), v0[3] + __uint_as_float(x.y & 0xffff0000u));
                    w.z = cvt_pk_bf16(v1[0] + __uint_as_float(x.z << 16), v1[1] + __uint_as_float(x.z & 0xffff0000u)); w.w = cvt_pk_bf16(v1[2] + __uint_as_float(x.w << 16), v1[3] + __uint_as_float(x.w & 0xffff0000u));
                    *(u32x4*)(rowp + bj * HALF) = w; } }
    }
};
struct EpiSwiGLU {
    static constexpr bool PERM = true, AFTER_DRAIN = false;
    bf16_t* Hd;
    __device__ __forceinline__ void operator()(const f32x4 (&acc)[2][2][4][2], const Unit& u, int wr, int wc, int fr, int fq) const {
        const int row0 = u.pm * BM + wr * 64 + fr, col0 = (u.pn & 15) * HALF + wc * 32 + 8 * fq;
#pragma unroll
        for (int ai = 0; ai < 2; ++ai)
#pragma unroll
            for (int m = 0; m < 4; ++m) { bf16_t* rowp = Hd + (size_t)(row0 + ai * HALF + m * 16) * 2048 + col0;
                float h[8];
#pragma unroll
                for (int n = 0; n < 2; ++n)
#pragma unroll
                    for (int j = 0; j < 4; ++j) { const float a = acc[ai][0][m][n][j], b = acc[ai][1][m][n][j]; h[n * 4 + j] = a * __builtin_amdgcn_rcpf(1.0f + __expf(-a)) * b; }
                u32x4 w; w.x = cvt_pk_bf16(h[0], h[1]); w.y = cvt_pk_bf16(h[2], h[3]); w.z = cvt_pk_bf16(h[4], h[5]); w.w = cvt_pk_bf16(h[6], h[7]);
                *(u32x4*)rowp = w; }
    }
};

typedef unsigned u32x2v __attribute__((ext_vector_type(2)));
__device__ __forceinline__ unsigned pk4_fp8(float a, float b, float c, float d) {
    a = fminf(fmaxf(a, -448.f), 448.f); b = fminf(fmaxf(b, -448.f), 448.f); c = fminf(fmaxf(c, -448.f), 448.f); d = fminf(fmaxf(d, -448.f), 448.f);
    int w = 0; w = __builtin_amdgcn_cvt_pk_fp8_f32(a, b, w, false); w = __builtin_amdgcn_cvt_pk_fp8_f32(c, d, w, true); return (unsigned)w; }
typedef short v2s16 __attribute__((ext_vector_type(2)));
__device__ __forceinline__ unsigned pk4_fp8s(float a, float b, float c, float d, float scale) {
    v2s16 r = {0, 0}; r = __builtin_amdgcn_cvt_scalef32_pk_fp8_f32(r, a, b, scale, false); r = __builtin_amdgcn_cvt_scalef32_pk_fp8_f32(r, c, d, scale, true); return __builtin_bit_cast(unsigned, r); }
struct EpiSwiGLU8 {
    static constexpr bool PERM = true, AFTER_DRAIN = false;
    unsigned char* Hd;
    __device__ __forceinline__ void operator()(const f32x4 (&acc)[2][2][4][2], const Unit& u, int wr, int wc, int fr, int fq) const {
        const int row0 = u.pm * BM + wr * 64 + fr, col0 = (u.pn & 15) * HALF + wc * 32 + 8 * fq;
#pragma unroll
        for (int ai = 0; ai < 2; ++ai)
#pragma unroll
            for (int m = 0; m < 4; ++m) { unsigned char* rowp = Hd + (size_t)(row0 + ai * HALF + m * 16) * 2048 + col0;
                float h[8];
#pragma unroll
                for (int n = 0; n < 2; ++n)
#pragma unroll
                    for (int j = 0; j < 4; ++j) { const float a = acc[ai][0][m][n][j], b = acc[ai][1][m][n][j]; h[n * 4 + j] = 8.0f * a * __builtin_amdgcn_rcpf(1.0f + __expf(-a)) * b; }
                u32x2v w; w.x = pk4_fp8(h[0], h[1], h[2], h[3]); w.y = pk4_fp8(h[4], h[5], h[6], h[7]);
                *(u32x2v*)rowp = w; }
    }
};
struct EpiGate {
    static constexpr bool PERM = true, AFTER_DRAIN = false;
    bf16_t* Y; const float* gate;
    __device__ __forceinline__ void operator()(const f32x4 (&acc)[2][2][4][2], const Unit& u, int wr, int wc, int fr, int fq) const {
        const int row0 = u.pm * BM + wr * 64 + fr, col0 = (u.pn & 3) * BM + wc * 32 + 8 * fq;
        float gs[2][4];
#pragma unroll
        for (int ai = 0; ai < 2; ++ai)
#pragma unroll
            for (int m = 0; m < 4; ++m) gs[ai][m] = gate[row0 + ai * HALF + m * 16];
#pragma unroll
        for (int ai = 0; ai < 2; ++ai)
#pragma unroll
            for (int m = 0; m < 4; ++m) { const int row = row0 + ai * HALF + m * 16; const float g = gs[ai][m]; unsigned char* rowp = (unsigned char*)Y + (size_t)row * 1024 + col0;
#pragma unroll
                for (int bj = 0; bj < 2; ++bj) { const f32x4 v0 = acc[ai][bj][m][0] * g, v1 = acc[ai][bj][m][1] * g;
                    u32x2v w; w.x = pk4_fp8s(v0[0], v0[1], v0[2], v0[3], 0.125f); w.y = pk4_fp8s(v1[0], v1[1], v1[2], v1[3], 0.125f);
                    *(u32x2v*)(rowp + bj * HALF) = w; } }
    }
};

__device__ __forceinline__ void st_bf16(bf16_t* p, unsigned w, bool hi) { *p = (bf16_t)(hi ? (w >> 16) : (w & 0xffffu)); }
struct EpiProj {
    static constexpr bool PERM = true, AFTER_DRAIN = false;
    unsigned char* ws; const float* gt; const float* rrow;
    __device__ __forceinline__ void operator()(const f32x4 (&acc)[2][2][4][2], const Unit& u, int wr, int wc, int fr, int fq) const {
        const int pn = u.pn, row0 = u.pm * BM + wr * 64 + fr, lane = fq * 16 + fr;
        float rs[2][4];
#pragma unroll
        for (int ai = 0; ai < 2; ++ai)
#pragma unroll
            for (int m = 0; m < 4; ++m) rs[ai][m] = rrow[row0 + ai * HALF + m * 16];
        bf16_t* P = (bf16_t*)(ws + WS_PROJ); bf16_t* VT = (bf16_t*)(ws + WS_VT); bf16_t* NVT = (bf16_t*)(ws + WS_NVT); bf16_t* NRM = (bf16_t*)(ws + WS_NRM);
        if (pn == 6 || pn == 7 || pn == 9) {
            const int sel = pn == 6 ? 0 : (pn == 7 ? 1 : 2); const float* gsrc = gt + sel * 64; const float qs = pn == 7 ? 1.0f : 0.125f;
            f32x4 gv[2][2];
#pragma unroll
            for (int bj = 0; bj < 2; ++bj)
#pragma unroll
                for (int n = 0; n < 2; ++n) gv[bj][n] = *(const f32x4*)(gsrc + 32 * bj + 8 * fq + 4 * n);
            const int nb = (pn == 6 ? 0 : (pn == 7 ? 256 : 512)) + 64 * wc + 8 * fq, pb = pn * BM + 64 * wc + 8 * fq;
#pragma unroll
            for (int ai = 0; ai < 2; ++ai)
#pragma unroll
                for (int m = 0; m < 4; ++m) { const size_t row = (size_t)(row0 + ai * HALF + m * 16); float ss = 0.f;
#pragma unroll
                    for (int bj = 0; bj < 2; ++bj)
#pragma unroll
                        for (int n = 0; n < 2; ++n) { const f32x4 v = acc[ai][bj][m][n]; ss += v[0] * v[0] + v[1] * v[1] + v[2] * v[2] + v[3] * v[3]; }
                    ss = rows_sum4(ss) * rs[ai][m] * rs[ai][m];
                    const float rr = rsqrtf(ss * (1.0f / 64.0f) + 1e-6f) * qs * rs[ai][m];
#pragma unroll
                    for (int bj = 0; bj < 2; ++bj) { const f32x4 v0 = acc[ai][bj][m][0], v1 = acc[ai][bj][m][1];
                        const f32x4 n0 = v0 * gv[bj][0] * rr, n1 = v1 * gv[bj][1] * rr; u32x4 w;
                        w.x = cvt_pk_bf16(n0[0], n0[1]); w.y = cvt_pk_bf16(n0[2], n0[3]); w.z = cvt_pk_bf16(n1[0], n1[1]); w.w = cvt_pk_bf16(n1[2], n1[3]);
                        *(u32x4*)(NRM + row * 768 + nb + 32 * bj) = w; } }
            return;
        }
        const int col0 = pn * BM + wc * 32 + 8 * fq;
        if (pn == 4 || pn == 5) {
            unsigned char* OG = ws + WS_OG;
#pragma unroll
            for (int ai = 0; ai < 2; ++ai)
#pragma unroll
                for (int m = 0; m < 4; ++m) { unsigned char* rowp = OG + (size_t)(row0 + ai * HALF + m * 16) * 512 + (pn - 4) * BM + wc * 32 + 8 * fq;
#pragma unroll
                    for (int bj = 0; bj < 2; ++bj) { const f32x4 v0 = acc[ai][bj][m][0] * rs[ai][m], v1 = acc[ai][bj][m][1] * rs[ai][m];
                        u32x2v w; w.x = pk4_fp8(8.f * v0[0], 8.f * v0[1], 8.f * v0[2], 8.f * v0[3]); w.y = pk4_fp8(8.f * v1[0], 8.f * v1[1], 8.f * v1[2], 8.f * v1[3]);
                        *(u32x2v*)(rowp + bj * HALF) = w; } }
            return;
        }
        if (!(pn == 2 || pn == 3 || pn == 8))
#pragma unroll
        for (int ai = 0; ai < 2; ++ai)
#pragma unroll
            for (int m = 0; m < 4; ++m) { bf16_t* rowp = P + (size_t)(row0 + ai * HALF + m * 16) * 2560 + col0;
#pragma unroll
                for (int bj = 0; bj < 2; ++bj) { const f32x4 v0 = acc[ai][bj][m][0] * rs[ai][m], v1 = acc[ai][bj][m][1] * rs[ai][m];
                    u32x4 w; w.x = cvt_pk_bf16(v0[0], v0[1]); w.y = cvt_pk_bf16(v0[2], v0[3]); w.z = cvt_pk_bf16(v1[0], v1[1]); w.w = cvt_pk_bf16(v1[2], v1[3]);
                    *(u32x4*)(rowp + bj * HALF) = w; } }
        if (pn == 2 || pn == 3 || pn == 8) {
            const int b = u.pm >> 4, s0 = (u.pm & 15) * BM + wr * 64 + fr;
#pragma unroll
            for (int bj = 0; bj < 2; ++bj) {
                bf16_t* base;
                if (pn == 8) base = NVT + ((size_t)((b * 4 + 2 * bj + (wc >> 1)) * 64 + 32 * (wc & 1) + 8 * fq)) * 4096 + s0;
                else base = VT + ((size_t)((b * 4 + (pn - 2) * 2 + bj) * 128 + 32 * wc + 8 * fq)) * 4096 + s0;
#pragma unroll
                for (int ai = 0; ai < 2; ++ai)
#pragma unroll
                    for (int m = 0; m < 4; ++m)
#pragma unroll
                        for (int n = 0; n < 2; ++n) { const f32x4 v = acc[ai][bj][m][n] * rs[ai][m]; const unsigned w0 = cvt_pk_bf16(v[0], v[1]), w1 = cvt_pk_bf16(v[2], v[3]);
                            if (pn == 8) {
                                const int head = 2 * bj + (wc >> 1), dim = 32 * (wc & 1) + 8 * fq + 4 * n, gr = (u.pm & 15) * 4 + wr + 2 * ai, colq = m * 16 + fr;
                                bf16_t* q = NVT + ((size_t)(((b * 4 + head) * 64 + gr) * 64 + dim)) * 64 + colq;
                                st_bf16(q, w0, false); st_bf16(q + 64, w0, true); st_bf16(q + 128, w1, false); st_bf16(q + 192, w1, true); }
                            else {
                                const int head = (pn - 2) * 2 + bj, dv = 32 * wc + 8 * fq + 4 * n, chunk = (u.pm & 15) * 2 + ai, tkn = wr * 64 + m * 16 + fr;
                                bf16_t* q = VT + ((size_t)(((b * 4 + head) * 32 + chunk) * 128 + dv)) * 128 + tkn;
                                st_bf16(q, w0, false); st_bf16(q + 128, w0, true); st_bf16(q + 256, w1, false); st_bf16(q + 384, w1, true); } }
            }
        }
    }
};
struct EpiKvMem {
    static constexpr bool PERM = true, AFTER_DRAIN = false;
    unsigned char* ws; const float* gk;
    __device__ __forceinline__ void operator()(const f32x4 (&acc)[2][2][4][2], const Unit& u, int wr, int wc, int fr, int fq) const {
        const int row0 = u.pm * BM + wr * 64 + fr, l = u.pn >> 1, lane = fq * 16 + fr;
        bf16_t* KMN = (bf16_t*)(ws + WS_KMN); bf16_t* VMT = (bf16_t*)(ws + WS_VMT);
        if ((u.pn & 1) == 0) {
            f32x4 gv[2][2];
#pragma unroll
            for (int bj = 0; bj < 2; ++bj)
#pragma unroll
                for (int n = 0; n < 2; ++n) gv[bj][n] = *(const f32x4*)(gk + l * 64 + 32 * bj + 8 * fq + 4 * n);
#pragma unroll
            for (int ai = 0; ai < 2; ++ai)
#pragma unroll
                for (int m = 0; m < 4; ++m) { const size_t row = (size_t)(row0 + ai * HALF + m * 16); float ss = 0.f;
#pragma unroll
                    for (int bj = 0; bj < 2; ++bj)
#pragma unroll
                        for (int n = 0; n < 2; ++n) { const f32x4 v = acc[ai][bj][m][n]; ss += v[0] * v[0] + v[1] * v[1] + v[2] * v[2] + v[3] * v[3]; }
                    ss = rows_sum4(ss);
                    const float rr = rsqrtf(ss * (1.0f / 64.0f) + 1e-6f);
#pragma unroll
                    for (int bj = 0; bj < 2; ++bj) { const f32x4 v0 = acc[ai][bj][m][0], v1 = acc[ai][bj][m][1];
                        const f32x4 n0 = v0 * gv[bj][0] * rr, n1 = v1 * gv[bj][1] * rr; u32x4 w;
                        w.x = cvt_pk_bf16(n0[0], n0[1]); w.y = cvt_pk_bf16(n0[2], n0[3]); w.z = cvt_pk_bf16(n1[0], n1[1]); w.w = cvt_pk_bf16(n1[2], n1[3]);
                        *(u32x4*)(KMN + row * 256 + 64 * wc + 32 * bj + 8 * fq) = w; } }
            return;
        }
        const int lb = u.pm;
#pragma unroll
        for (int bj = 0; bj < 2; ++bj) { bf16_t* base = VMT + ((size_t)((lb * 4 + 2 * bj + (wc >> 1)) * 64 + 32 * (wc & 1) + 8 * fq)) * 256 + wr * 64 + fr;
#pragma unroll
            for (int ai = 0; ai < 2; ++ai)
#pragma unroll
                for (int m = 0; m < 4; ++m)
#pragma unroll
                    for (int n = 0; n < 2; ++n) { const f32x4 v = acc[ai][bj][m][n]; const unsigned w0 = cvt_pk_bf16(v[0], v[1]), w1 = cvt_pk_bf16(v[2], v[3]);
                        bf16_t* q = base + (size_t)(4 * n) * 256 + ai * HALF + m * 16;
                        st_bf16(q, w0, false); st_bf16(q + 256, w0, true); st_bf16(q + 512, w1, false); st_bf16(q + 768, w1, true); } }
    }
};
struct KvOrder {
    int G, c;
    __device__ bool next(int i, Unit& u) const { const int L = i * G + c; if (L >= 64) return false; const int l = L >> 4, w = L & 15; u.pm = l * 8 + (w & 7); u.pn = l * 2 + (w >> 3); return true; }
    __device__ __forceinline__ void a_ready(const Unit&) const {}
    __device__ __forceinline__ void done(const Unit&) const {}
};
struct MoeOrder {
    int G, c, nN, upe;
    __device__ bool next(int i, Unit& u) const {
        const int L = i * G + c; if (L >= 16 * upe) return false;
        const int e = L / upe, w = L % upe, q = upe / NXCD, wgid = (w % NXCD) * q + w / NXCD;
        int nig = WGM * nN, gid = wgid / nig, pml = gid * WGM + (wgid % nig) % WGM, pnl = (wgid % nig) / WGM;
        if (nN == 4) { pml = 2 * (w % NXCD) + ((w / NXCD) & 1); pnl = (w / NXCD) >> 1; }
        const int ee = (nN == 4) ? 15 - e : e;
        u.pm = ee * 16 + pml; u.pn = ee * nN + pnl; return true;
    }
    __device__ __forceinline__ void a_ready(const Unit&) const {}
    __device__ __forceinline__ void done(const Unit&) const {}
};

template <class Epi, class Sched, bool ALIGN_EPI = false, bool SP2 = false>
__device__ __forceinline__ void gemm_phase(PG8_LAS unsigned char* lds, const Gemm g, const Sched& S, const Epi& E, const int tid) {
    const int wid = __builtin_amdgcn_readfirstlane(tid >> 6), lane = tid & 63, wr = wid >> 2, wc = wid & 3, fr = lane & 15, fq = lane >> 4;
    const int K = g.K, nt = K / BK;
    unsigned voffA[2], voffB[2];
#pragma unroll
    for (int i = 0; i < 2; ++i) { int R, C; stage_rc(tid * 16 + i * 8192, R, C); const int Rb = Epi::PERM ? ((R & ~31) + perm32(R & 31)) : R;
        voffA[i] = (unsigned)(R * K + C) * 2u; voffB[i] = (unsigned)(Rb * K + C) * 2u; }
    const size_t kstep = (size_t)(BK * 2);
    const size_t hstep = (size_t)HALF * K * 2;
    const size_t tstep = 2 * hstep;
    const unsigned ldsw = (unsigned)wid * 1024u;
    const int aoff = lds_byte(wr * 64 + fr, fq * 8), boff = lds_byte(wc * 32 + fr, fq * 8);
#define PG8_SA(b, h) (((b) * 2 + (h)) * HTB)
#define PG8_SB(b, h) ((4 + (b) * 2 + (h)) * HTB)
#define PG8_STAGE(bufoff, gbase, voff) do { _Pragma("unroll") for (int _i = 0; _i < 2; ++_i) \
        __builtin_amdgcn_global_load_lds((const unsigned*)((const char*)(gbase) + (voff)[_i]), (PG8_LAS unsigned*)(lds + (bufoff) + ldsw + _i * 8192), 16, 0, 0); } while (0)
#define PG8_LDA(dst, b, h) do { _Pragma("unroll") for (int m = 0; m < 4; ++m) _Pragma("unroll") for (int k = 0; k < 2; ++k) dst[m][k] = *(const PG8_LAS bf16x8*)(lds + PG8_SA(b, h) + aoff + m * 2048 + k * 1024); } while (0)
#define PG8_LDB(dst, b, h) do { _Pragma("unroll") for (int n = 0; n < 2; ++n) _Pragma("unroll") for (int k = 0; k < 2; ++k) dst[n][k] = *(const PG8_LAS bf16x8*)(lds + PG8_SB(b, h) + boff + n * 2048 + k * 1024); } while (0)
#define PG8_MMA(ai, bj, At, Bt) do { __builtin_amdgcn_s_setprio(1); _Pragma("unroll") for (int m = 0; m < 4; ++m) _Pragma("unroll") for (int n = 0; n < 2; ++n) _Pragma("unroll") for (int k = 0; k < 2; ++k) \
        acc[ai][bj][m][n] = __builtin_amdgcn_mfma_f32_16x16x32_bf16(Bt[n][k], At[m][k], acc[ai][bj][m][n], 0, 0, 0); __builtin_amdgcn_s_setprio(0); } while (0)
#define PG8_WAIT_V(n) asm volatile("s_waitcnt vmcnt(" #n ")" ::: "memory")
#define PG8_WAIT_L(n) asm volatile("s_waitcnt lgkmcnt(" #n ")" ::: "memory")
#define PG8_BAR __builtin_amdgcn_s_barrier()
#define PG8_SCHED __builtin_amdgcn_sched_barrier(0)
    Unit cur, nxt; int ui = 0;
    if (!S.next(0, cur)) return;
    f32x4 acc[2][2][4][2];
#pragma unroll
    for (int a = 0; a < 2; ++a)
#pragma unroll
        for (int b = 0; b < 2; ++b)
#pragma unroll
            for (int m = 0; m < 4; ++m)
#pragma unroll
                for (int n = 0; n < 2; ++n) acc[a][b][m][n] = (f32x4){0.f, 0.f, 0.f, 0.f};
    bf16x8 At[4][2], B0[2][2], B1[2][2];
    const char* cA = (const char*)g.A + (size_t)cur.pm * tstep; const char* cB = (const char*)g.Bt + (size_t)cur.pn * tstep;
    S.a_ready(cur);
    if constexpr (SP2) {
        PG8_STAGE(PG8_SB(0, 0), cB, voffB); PG8_STAGE(PG8_SB(0, 1), cB + hstep, voffB); PG8_STAGE(PG8_SA(0, 0), cA, voffA); PG8_STAGE(PG8_SA(0, 1), cA + hstep, voffA);
        if (wr == 1) PG8_BAR;
        PG8_WAIT_V(2); PG8_BAR;
        PG8_STAGE(PG8_SB(1, 0), cB + kstep, voffB); PG8_STAGE(PG8_SA(1, 0), cA + kstep, voffA); PG8_STAGE(PG8_SB(1, 1), cB + hstep + kstep, voffB);
        PG8_WAIT_V(6); PG8_BAR;
    } else {
        PG8_STAGE(PG8_SB(0, 0), cB, voffB); PG8_STAGE(PG8_SA(0, 0), cA, voffA); PG8_STAGE(PG8_SB(0, 1), cB + hstep, voffB); PG8_STAGE(PG8_SA(0, 1), cA + hstep, voffA);
        if (wr == 1) PG8_BAR;
        PG8_WAIT_V(4); PG8_BAR;
        PG8_STAGE(PG8_SB(1, 0), cB + kstep, voffB); PG8_STAGE(PG8_SA(1, 0), cA + kstep, voffA); PG8_STAGE(PG8_SB(1, 1), cB + hstep + kstep, voffB);
        PG8_WAIT_V(6); PG8_BAR;
    }
    for (;;) {
        const bool has_next = S.next(ui + 1, nxt);
        const char* nA = has_next ? (const char*)g.A + (size_t)nxt.pm * tstep : cA; const char* nB = has_next ? (const char*)g.Bt + (size_t)nxt.pn * tstep : cB;
        for (int t = 0; t < nt; t += 2) {
            const bool last = (t == nt - 2);
            const char* a1 = cA + (size_t)(t + 1) * kstep;
            const char* a2 = last ? nA : cA + (size_t)(t + 2) * kstep; const char* b2 = last ? nB : cB + (size_t)(t + 2) * kstep;
            const char* a3 = a2 + kstep; const char* b3 = b2 + kstep;
            if (last && has_next) S.a_ready(nxt);
            if constexpr (SP2) {
            PG8_LDB(B0, 0, 0); PG8_LDB(B1, 0, 1); PG8_SCHED; PG8_LDA(At, 0, 0); PG8_STAGE(PG8_SA(1, 1), a1 + hstep, voffA);
            PG8_WAIT_V(8); PG8_WAIT_L(0); PG8_BAR; PG8_MMA(0, 0, At, B0); PG8_MMA(0, 1, At, B1); PG8_BAR; PG8_SCHED;
            PG8_LDA(At, 0, 1); PG8_STAGE(PG8_SB(0, 0), b2, voffB); PG8_STAGE(PG8_SB(0, 1), b2 + hstep, voffB); PG8_STAGE(PG8_SA(0, 0), a2, voffA);
            PG8_WAIT_V(8); PG8_WAIT_L(0); PG8_BAR; PG8_MMA(1, 0, At, B0); PG8_MMA(1, 1, At, B1); PG8_BAR; PG8_SCHED;
            PG8_LDB(B0, 1, 0); PG8_LDB(B1, 1, 1); PG8_SCHED; PG8_LDA(At, 1, 0); PG8_STAGE(PG8_SA(0, 1), a2 + hstep, voffA);
            PG8_WAIT_V(8); PG8_WAIT_L(0); PG8_BAR; PG8_MMA(0, 0, At, B0); PG8_MMA(0, 1, At, B1); PG8_BAR; PG8_SCHED;
            PG8_LDA(At, 1, 1); PG8_STAGE(PG8_SB(1, 0), b3, voffB); PG8_STAGE(PG8_SB(1, 1), b3 + hstep, voffB); PG8_STAGE(PG8_SA(1, 0), a3, voffA);
            PG8_WAIT_V(8); PG8_WAIT_L(0); PG8_BAR; PG8_MMA(1, 0, At, B0); PG8_MMA(1, 1, At, B1); PG8_BAR; PG8_SCHED;
            } else {
            PG8_LDB(B0, 0, 0); PG8_SCHED; PG8_LDA(At, 0, 0); PG8_STAGE(PG8_SA(1, 1), a1 + hstep, voffA);
            PG8_WAIT_L(8); PG8_BAR; PG8_WAIT_L(0); PG8_MMA(0, 0, At, B0); PG8_BAR; PG8_SCHED;
            PG8_LDB(B1, 0, 1); PG8_STAGE(PG8_SB(0, 0), b2, voffB);
            PG8_BAR; PG8_WAIT_L(0); PG8_MMA(0, 1, At, B1); PG8_BAR;
            PG8_LDA(At, 0, 1); PG8_STAGE(PG8_SA(0, 0), a2, voffA);
            PG8_BAR; PG8_WAIT_L(0); PG8_MMA(1, 0, At, B0); PG8_BAR; PG8_SCHED;
            PG8_STAGE(PG8_SB(0, 1), b2 + hstep, voffB);
            PG8_WAIT_V(6); PG8_BAR; PG8_MMA(1, 1, At, B1); PG8_BAR;
            PG8_LDB(B0, 1, 0); PG8_SCHED; PG8_LDA(At, 1, 0); PG8_STAGE(PG8_SA(0, 1), a2 + hstep, voffA);
            PG8_WAIT_L(8); PG8_BAR; PG8_WAIT_L(0); PG8_MMA(0, 0, At, B0); PG8_BAR; PG8_SCHED;
            PG8_LDB(B1, 1, 1); PG8_STAGE(PG8_SB(1, 0), b3, voffB);
            PG8_BAR; PG8_WAIT_L(0); PG8_MMA(0, 1, At, B1); PG8_BAR;
            PG8_LDA(At, 1, 1); PG8_STAGE(PG8_SA(1, 0), a3, voffA);
            PG8_BAR; PG8_WAIT_L(0); PG8_MMA(1, 0, At, B0); PG8_BAR; PG8_SCHED;
            PG8_STAGE(PG8_SB(1, 1), b3 + hstep, voffB);
            PG8_WAIT_V(6); PG8_BAR; PG8_MMA(1, 1, At, B1); PG8_BAR;
            }
        }
        if constexpr (ALIGN_EPI) { if (wr == 0) PG8_BAR; }
        asm volatile("s_nop 15\n\ts_nop 15" ::: "memory");
        if constexpr (!Epi::AFTER_DRAIN) { E(acc, cur, wr, wc, fr, fq); S.done(cur); }
        if (!has_next) break;
#pragma unroll
        for (int a = 0; a < 2; ++a)
#pragma unroll
            for (int b = 0; b < 2; ++b)
#pragma unroll
                for (int m = 0; m < 4; ++m)
#pragma unroll
                    for (int n = 0; n < 2; ++n) acc[a][b][m][n] = (f32x4){0.f, 0.f, 0.f, 0.f};
        cur = nxt; cA = nA; cB = nB; ++ui;
        if constexpr (ALIGN_EPI) { if (wr == 1) PG8_BAR; }
    }
    PG8_WAIT_V(0);
    if constexpr (!ALIGN_EPI) { if (wr == 0) PG8_BAR; }
    PG8_BAR;
    if constexpr (Epi::AFTER_DRAIN) { E.fused(acc, cur, wr, wc, fr, fq, lds, wid, lane); S.done(cur); }
#undef PG8_SA
#undef PG8_SB
#undef PG8_STAGE
#undef PG8_LDA
#undef PG8_LDB
#undef PG8_MMA
#undef PG8_WAIT_V
#undef PG8_WAIT_L
#undef PG8_BAR
#undef PG8_SCHED
}

typedef int v8i __attribute__((ext_vector_type(8)));
typedef int v4i __attribute__((ext_vector_type(4)));
__host__ __device__ __forceinline__ int lds_byte8(int r, int c) { const int st = (r >> 4) * 2 + (c >> 5), rr = r & 15, cc = c & 31, ob = rr * 64 + cc * 2; return st * 1024 + (ob ^ (((ob >> 9) & 1) << 4)); }
__host__ __device__ __forceinline__ void stage_rc8(int b, int& R, int& C) { const int st = b / 1024, sb = b % 1024, swz = sb ^ (((sb >> 9) & 1) << 4); R = (st >> 1) * 16 + swz / 64; C = (st & 1) * 32 + (swz % 64) / 2; }
template <class Epi, class Sched, bool ALIGN_EPI, bool SP2, int SCA  , int SCB  >
__device__ __forceinline__ void gemm_phase_f8(PG8_LAS unsigned char* lds, const Gemm g, const Sched& S, const Epi& E, const int tid) {
    const int wid = __builtin_amdgcn_readfirstlane(tid >> 6), lane = tid & 63, wr = wid >> 2, wc = wid & 3, fr = lane & 15, fq = lane >> 4;
    const int K = g.K, nt = K / BK;
    unsigned voffA[2], voffB[2];
#pragma unroll
    for (int i = 0; i < 2; ++i) { int R, C; stage_rc8(tid * 16 + i * 8192, R, C); const int Rb = Epi::PERM ? ((R & ~31) + perm32(R & 31)) : R;
        voffA[i] = (unsigned)(R * K + C) * 2u; voffB[i] = (unsigned)(Rb * K + C) * 2u; }
    const size_t kstep = (size_t)(BK * 2);
    const size_t hstep = (size_t)HALF * K * 2;
    const size_t tstep = 2 * hstep;
    const unsigned ldsw = (unsigned)wid * 1024u;
    const int aoff = lds_byte8(wr * 64 + fr, fq * 16), boff = lds_byte8(wc * 32 + fr, fq * 16);
#define PG8_SA(b, h) (((b) * 2 + (h)) * HTB)
#define PG8_SB(b, h) ((4 + (b) * 2 + (h)) * HTB)
#define PG8_STAGE(bufoff, gbase, voff) do { _Pragma("unroll") for (int _i = 0; _i < 2; ++_i) \
        __builtin_amdgcn_global_load_lds((const unsigned*)((const char*)(gbase) + (voff)[_i]), (PG8_LAS unsigned*)(lds + (bufoff) + ldsw + _i * 8192), 16, 0, 0); } while (0)
#define PG8_LDA(dst, b, h) do { _Pragma("unroll") for (int m = 0; m < 4; ++m) { const u32x4 lo_ = *(const PG8_LAS u32x4*)(lds + PG8_SA(b, h) + aoff + m * 2048), hi_ = *(const PG8_LAS u32x4*)(lds + PG8_SA(b, h) + (aoff ^ 16) + m * 2048); \
        dst[m] = __builtin_shufflevector(__builtin_bit_cast(v4i, lo_), __builtin_bit_cast(v4i, hi_), 0, 1, 2, 3, 4, 5, 6, 7); } } while (0)
#define PG8_LDB(dst, b, h) do { _Pragma("unroll") for (int n = 0; n < 2; ++n) { const u32x4 lo_ = *(const PG8_LAS u32x4*)(lds + PG8_SB(b, h) + boff + n * 2048), hi_ = *(const PG8_LAS u32x4*)(lds + PG8_SB(b, h) + (boff ^ 16) + n * 2048); \
        dst[n] = __builtin_shufflevector(__builtin_bit_cast(v4i, lo_), __builtin_bit_cast(v4i, hi_), 0, 1, 2, 3, 4, 5, 6, 7); } } while (0)
#define PG8_MMA(ai, bj, At, Bt) do { __builtin_amdgcn_s_setprio(1); _Pragma("unroll") for (int m = 0; m < 4; ++m) _Pragma("unroll") for (int n = 0; n < 2; ++n) \
        asm volatile("v_mfma_scale_f32_16x16x128_f8f6f4 %0, %1, %2, %0, %3, %4 op_sel_hi:[0,0,0]" : "+v"(acc[ai][bj][m][n]) : "v"(Bt[n]), "v"(At[m]), "v"(scb_), "v"(sca_)); __builtin_amdgcn_s_setprio(0); } while (0)
#define PG8_WAIT_V(n) asm volatile("s_waitcnt vmcnt(" #n ")" ::: "memory")
#define PG8_WAIT_L(n) asm volatile("s_waitcnt lgkmcnt(" #n ")" ::: "memory")
#define PG8_BAR __builtin_amdgcn_s_barrier()
#define PG8_SCHED __builtin_amdgcn_sched_barrier(0)
    Unit cur, nxt; int ui = 0;
    if (!S.next(0, cur)) return;
    f32x4 acc[2][2][4][2];
#pragma unroll
    for (int a = 0; a < 2; ++a)
#pragma unroll
        for (int b = 0; b < 2; ++b)
#pragma unroll
            for (int m = 0; m < 4; ++m)
#pragma unroll
                for (int n = 0; n < 2; ++n) acc[a][b][m][n] = (f32x4){0.f, 0.f, 0.f, 0.f};
    v8i At[4], B0[2], B1[2]; const int scb_ = SCB, sca_ = SCA;
    const char* cA = (const char*)g.A + (size_t)cur.pm * tstep; const char* cB = (const char*)g.Bt + (size_t)cur.pn * tstep;
    S.a_ready(cur);
    if constexpr (SP2) {
        PG8_STAGE(PG8_SB(0, 0), cB, voffB); PG8_STAGE(PG8_SB(0, 1), cB + hstep, voffB); PG8_STAGE(PG8_SA(0, 0), cA, voffA); PG8_STAGE(PG8_SA(0, 1), cA + hstep, voffA);
        if (wr == 1) PG8_BAR;
        PG8_WAIT_V(2); PG8_BAR;
        PG8_STAGE(PG8_SB(1, 0), cB + kstep, voffB); PG8_STAGE(PG8_SA(1, 0), cA + kstep, voffA); PG8_STAGE(PG8_SB(1, 1), cB + hstep + kstep, voffB);
        PG8_WAIT_V(6); PG8_BAR;
    } else {
        PG8_STAGE(PG8_SB(0, 0), cB, voffB); PG8_STAGE(PG8_SA(0, 0), cA, voffA); PG8_STAGE(PG8_SB(0, 1), cB + hstep, voffB); PG8_STAGE(PG8_SA(0, 1), cA + hstep, voffA);
        if (wr == 1) PG8_BAR;
        PG8_WAIT_V(4); PG8_BAR;
        PG8_STAGE(PG8_SB(1, 0), cB + kstep, voffB); PG8_STAGE(PG8_SA(1, 0), cA + kstep, voffA); PG8_STAGE(PG8_SB(1, 1), cB + hstep + kstep, voffB);
        PG8_WAIT_V(6); PG8_BAR;
    }
    for (;;) {
        const bool has_next = S.next(ui + 1, nxt);
        const char* nA = has_next ? (const char*)g.A + (size_t)nxt.pm * tstep : cA; const char* nB = has_next ? (const char*)g.Bt + (size_t)nxt.pn * tstep : cB;
        for (int t = 0; t < nt; t += 2) {
            const bool last = (t == nt - 2);
            const char* a1 = cA + (size_t)(t + 1) * kstep;
            const char* a2 = last ? nA : cA + (size_t)(t + 2) * kstep; const char* b2 = last ? nB : cB + (size_t)(t + 2) * kstep;
            const char* a3 = a2 + kstep; const char* b3 = b2 + kstep;
            if (last && has_next) S.a_ready(nxt);
            if constexpr (SP2) {
            PG8_LDB(B0, 0, 0); PG8_LDB(B1, 0, 1); PG8_SCHED; PG8_LDA(At, 0, 0); PG8_STAGE(PG8_SA(1, 1), a1 + hstep, voffA);
            PG8_WAIT_V(8); PG8_WAIT_L(0); PG8_BAR; PG8_MMA(0, 0, At, B0); PG8_MMA(0, 1, At, B1); PG8_BAR; PG8_SCHED;
            PG8_LDA(At, 0, 1); PG8_STAGE(PG8_SB(0, 0), b2, voffB); PG8_STAGE(PG8_SB(0, 1), b2 + hstep, voffB); PG8_STAGE(PG8_SA(0, 0), a2, voffA);
            PG8_WAIT_V(8); PG8_WAIT_L(0); PG8_BAR; PG8_MMA(1, 0, At, B0); PG8_MMA(1, 1, At, B1); PG8_BAR; PG8_SCHED;
            PG8_LDB(B0, 1, 0); PG8_LDB(B1, 1, 1); PG8_SCHED; PG8_LDA(At, 1, 0); PG8_STAGE(PG8_SA(0, 1), a2 + hstep, voffA);
            PG8_WAIT_V(8); PG8_WAIT_L(0); PG8_BAR; PG8_MMA(0, 0, At, B0); PG8_MMA(0, 1, At, B1); PG8_BAR; PG8_SCHED;
            PG8_LDA(At, 1, 1); PG8_STAGE(PG8_SB(1, 0), b3, voffB); PG8_STAGE(PG8_SB(1, 1), b3 + hstep, voffB); PG8_STAGE(PG8_SA(1, 0), a3, voffA);
            PG8_WAIT_V(8); PG8_WAIT_L(0); PG8_BAR; PG8_MMA(1, 0, At, B0); PG8_MMA(1, 1, At, B1); PG8_BAR; PG8_SCHED;
            } else {
            PG8_LDB(B0, 0, 0); PG8_SCHED; PG8_LDA(At, 0, 0); PG8_STAGE(PG8_SA(1, 1), a1 + hstep, voffA);
            PG8_WAIT_L(8); PG8_BAR; PG8_WAIT_L(0); PG8_MMA(0, 0, At, B0); PG8_BAR; PG8_SCHED;
            PG8_LDB(B1, 0, 1); PG8_STAGE(PG8_SB(0, 0), b2, voffB);
            PG8_BAR; PG8_WAIT_L(0); PG8_MMA(0, 1, At, B1); PG8_BAR;
            PG8_LDA(At, 0, 1); PG8_STAGE(PG8_SA(0, 0), a2, voffA);
            PG8_BAR; PG8_WAIT_L(0); PG8_MMA(1, 0, At, B0); PG8_BAR; PG8_SCHED;
            PG8_STAGE(PG8_SB(0, 1), b2 + hstep, voffB);
            PG8_WAIT_V(6); PG8_BAR; PG8_MMA(1, 1, At, B1); PG8_BAR;
            PG8_LDB(B0, 1, 0); PG8_SCHED; PG8_LDA(At, 1, 0); PG8_STAGE(PG8_SA(0, 1), a2 + hstep, voffA);
            PG8_WAIT_L(8); PG8_BAR; PG8_WAIT_L(0); PG8_MMA(0, 0, At, B0); PG8_BAR; PG8_SCHED;
            PG8_LDB(B1, 1, 1); PG8_STAGE(PG8_SB(1, 0), b3, voffB);
            PG8_BAR; PG8_WAIT_L(0); PG8_MMA(0, 1, At, B1); PG8_BAR;
            PG8_LDA(At, 1, 1); PG8_STAGE(PG8_SA(1, 0), a3, voffA);
            PG8_BAR; PG8_WAIT_L(0); PG8_MMA(1, 0, At, B0); PG8_BAR; PG8_SCHED;
            PG8_STAGE(PG8_SB(1, 1), b3 + hstep, voffB);
            PG8_WAIT_V(6); PG8_BAR; PG8_MMA(1, 1, At, B1); PG8_BAR;
            }
        }
        if constexpr (ALIGN_EPI) { if (wr == 0) PG8_BAR; }
        asm volatile("s_nop 15\n\ts_nop 15" ::: "memory");
        if constexpr (!Epi::AFTER_DRAIN) { E(acc, cur, wr, wc, fr, fq); S.done(cur); }
        if (!has_next) break;
#pragma unroll
        for (int a = 0; a < 2; ++a)
#pragma unroll
            for (int b = 0; b < 2; ++b)
#pragma unroll
                for (int m = 0; m < 4; ++m)
#pragma unroll
                    for (int n = 0; n < 2; ++n) acc[a][b][m][n] = (f32x4){0.f, 0.f, 0.f, 0.f};
        cur = nxt; cA = nA; cB = nB; ++ui;
        if constexpr (ALIGN_EPI) { if (wr == 1) PG8_BAR; }
    }
    PG8_WAIT_V(0);
    if constexpr (!ALIGN_EPI) { if (wr == 0) PG8_BAR; }
    PG8_BAR;
    if constexpr (Epi::AFTER_DRAIN) { E.fused(acc, cur, wr, wc, fr, fq, lds, wid, lane); S.done(cur); }
#undef PG8_SA
#undef PG8_SB
#undef PG8_STAGE
#undef PG8_LDA
#undef PG8_LDB
#undef PG8_MMA
#undef PG8_WAIT_V
#undef PG8_WAIT_L
#undef PG8_BAR
#undef PG8_SCHED
}


template <class Epi, class Sched, bool ALIGN_EPI, bool SP2, int SCA  , int SCB  >
__device__ __forceinline__ void gemm_phase_f8g(PG8_LAS unsigned char* lds, const Gemm g, const Sched& S, const Epi& E, const int tid, const int* rowtab) {
    const int wid = __builtin_amdgcn_readfirstlane(tid >> 6), lane = tid & 63, wr = wid >> 2, wc = wid & 3, fr = lane & 15, fq = lane >> 4;
    const int K = g.K, nt = K / BK;
    unsigned voffA[2], voffB[2]; int gR0 = 0; unsigned gCb = 0;
#pragma unroll
    for (int i = 0; i < 2; ++i) { int R, C; stage_rc8(tid * 16 + i * 8192, R, C); const int Rb = Epi::PERM ? ((R & ~31) + perm32(R & 31)) : R;
        voffA[i] = (unsigned)(R * K + C) * 2u; voffB[i] = (unsigned)(Rb * K + C) * 2u; if (i == 0) { gR0 = R; gCb = (unsigned)C * 2u; } }
    const size_t kstep = (size_t)(BK * 2);
    const size_t hstep = (size_t)HALF * K * 2;
    const size_t tstep = 2 * hstep;
    const unsigned ldsw = (unsigned)wid * 1024u;
    const int aoff = lds_byte8(wr * 64 + fr, fq * 16), boff = lds_byte8(wc * 32 + fr, fq * 16);
#define PG8_SA(b, h) (((b) * 2 + (h)) * HTB)
#define PG8_SB(b, h) ((4 + (b) * 2 + (h)) * HTB)
#define PG8_STAGE(bufoff, gbase, voff) do { _Pragma("unroll") for (int _i = 0; _i < 2; ++_i) \
        __builtin_amdgcn_global_load_lds((const unsigned*)((const char*)(gbase) + (voff)[_i]), (PG8_LAS unsigned*)(lds + (bufoff) + ldsw + _i * 8192), 16, 0, 0); } while (0)
#define PG8_STAGE_G(bufoff, o0, o1, kb) do { __builtin_amdgcn_global_load_lds((const unsigned*)((const char*)g.A + (o0) + (kb)), (PG8_LAS unsigned*)(lds + (bufoff) + ldsw), 16, 0, 0); \
        __builtin_amdgcn_global_load_lds((const unsigned*)((const char*)g.A + (o1) + (kb)), (PG8_LAS unsigned*)(lds + (bufoff) + ldsw + 8192), 16, 0, 0); } while (0)
#define PG8_ROWOFF(dst, pm_) do { const int* rt_ = rowtab + (pm_) * 256 + gR0; const unsigned kb_ = 2u * (unsigned)K; \
        dst[0][0] = (unsigned)rt_[0] * kb_ + gCb; dst[0][1] = (unsigned)rt_[64] * kb_ + gCb; dst[1][0] = (unsigned)rt_[128] * kb_ + gCb; dst[1][1] = (unsigned)rt_[192] * kb_ + gCb; } while (0)
#define PG8_LDA(dst, b, h) do { _Pragma("unroll") for (int m = 0; m < 4; ++m) { const u32x4 lo_ = *(const PG8_LAS u32x4*)(lds + PG8_SA(b, h) + aoff + m * 2048), hi_ = *(const PG8_LAS u32x4*)(lds + PG8_SA(b, h) + (aoff ^ 16) + m * 2048); \
        dst[m] = __builtin_shufflevector(__builtin_bit_cast(v4i, lo_), __builtin_bit_cast(v4i, hi_), 0, 1, 2, 3, 4, 5, 6, 7); } } while (0)
#define PG8_LDB(dst, b, h) do { _Pragma("unroll") for (int n = 0; n < 2; ++n) { const u32x4 lo_ = *(const PG8_LAS u32x4*)(lds + PG8_SB(b, h) + boff + n * 2048), hi_ = *(const PG8_LAS u32x4*)(lds + PG8_SB(b, h) + (boff ^ 16) + n * 2048); \
        dst[n] = __builtin_shufflevector(__builtin_bit_cast(v4i, lo_), __builtin_bit_cast(v4i, hi_), 0, 1, 2, 3, 4, 5, 6, 7); } } while (0)
#define PG8_MMA(ai, bj, At, Bt) do { __builtin_amdgcn_s_setprio(1); _Pragma("unroll") for (int m = 0; m < 4; ++m) _Pragma("unroll") for (int n = 0; n < 2; ++n) \
        asm volatile("v_mfma_scale_f32_16x16x128_f8f6f4 %0, %1, %2, %0, %3, %4 op_sel_hi:[0,0,0]" : "+v"(acc[ai][bj][m][n]) : "v"(Bt[n]), "v"(At[m]), "v"(scb_), "v"(sca_)); __builtin_amdgcn_s_setprio(0); } while (0)
#define PG8_WAIT_V(n) asm volatile("s_waitcnt vmcnt(" #n ")" ::: "memory")
#define PG8_WAIT_L(n) asm volatile("s_waitcnt lgkmcnt(" #n ")" ::: "memory")
#define PG8_BAR __builtin_amdgcn_s_barrier()
#define PG8_SCHED __builtin_amdgcn_sched_barrier(0)
    Unit cur, nxt; int ui = 0;
    if (!S.next(0, cur)) return;
    f32x4 acc[2][2][4][2];
#pragma unroll
    for (int a = 0; a < 2; ++a)
#pragma unroll
        for (int b = 0; b < 2; ++b)
#pragma unroll
            for (int m = 0; m < 4; ++m)
#pragma unroll
                for (int n = 0; n < 2; ++n) acc[a][b][m][n] = (f32x4){0.f, 0.f, 0.f, 0.f};
    v8i At[4], B0[2], B1[2]; const int scb_ = SCB, sca_ = SCA;
    const char* cA = (const char*)g.A + (size_t)cur.pm * tstep; const char* cB = (const char*)g.Bt + (size_t)cur.pn * tstep;
    S.a_ready(cur);
    unsigned co[2][2], no[2][2]; PG8_ROWOFF(co, cur.pm);
    if constexpr (SP2) {
        PG8_STAGE(PG8_SB(0, 0), cB, voffB); PG8_STAGE(PG8_SB(0, 1), cB + hstep, voffB); PG8_STAGE_G(PG8_SA(0, 0), co[0][0], co[0][1], 0); PG8_STAGE_G(PG8_SA(0, 1), co[1][0], co[1][1], 0);
        if (wr == 1) PG8_BAR;
        PG8_WAIT_V(2); PG8_BAR;
        PG8_STAGE(PG8_SB(1, 0), cB + kstep, voffB); PG8_STAGE_G(PG8_SA(1, 0), co[0][0], co[0][1], kstep); PG8_STAGE(PG8_SB(1, 1), cB + hstep + kstep, voffB);
        PG8_WAIT_V(6); PG8_BAR;
    } else {
        PG8_STAGE(PG8_SB(0, 0), cB, voffB); PG8_STAGE(PG8_SA(0, 0), cA, voffA); PG8_STAGE(PG8_SB(0, 1), cB + hstep, voffB); PG8_STAGE(PG8_SA(0, 1), cA + hstep, voffA);
        if (wr == 1) PG8_BAR;
        PG8_WAIT_V(4); PG8_BAR;
        PG8_STAGE(PG8_SB(1, 0), cB + kstep, voffB); PG8_STAGE(PG8_SA(1, 0), cA + kstep, voffA); PG8_STAGE(PG8_SB(1, 1), cB + hstep + kstep, voffB);
        PG8_WAIT_V(6); PG8_BAR;
    }
    for (;;) {
        const bool has_next = S.next(ui + 1, nxt);
        const char* nA = cA; const char* nB = has_next ? (const char*)g.Bt + (size_t)nxt.pn * tstep : cB;
        if (has_next) PG8_ROWOFF(no, nxt.pm); else { no[0][0] = co[0][0]; no[0][1] = co[0][1]; no[1][0] = co[1][0]; no[1][1] = co[1][1]; }
        for (int t = 0; t < nt; t += 2) {
            const bool last = (t == nt - 2);
            const char* a1 = cA + (size_t)(t + 1) * kstep;
            const char* a2 = last ? nA : cA + (size_t)(t + 2) * kstep; const char* b2 = last ? nB : cB + (size_t)(t + 2) * kstep;
            const char* a3 = a2 + kstep; const char* b3 = b2 + kstep;
            if (last && has_next) S.a_ready(nxt);
            const unsigned s00 = last ? no[0][0] : co[0][0], s01 = last ? no[0][1] : co[0][1], s10 = last ? no[1][0] : co[1][0], s11 = last ? no[1][1] : co[1][1];
            const size_t k1 = (size_t)(t + 1) * kstep, k2 = last ? (size_t)0 : (size_t)(t + 2) * kstep;
            if constexpr (SP2) {
            PG8_LDB(B0, 0, 0); PG8_LDB(B1, 0, 1); PG8_SCHED; PG8_LDA(At, 0, 0); PG8_STAGE_G(PG8_SA(1, 1), co[1][0], co[1][1], k1);
            PG8_WAIT_V(8); PG8_WAIT_L(0); PG8_BAR; PG8_MMA(0, 0, At, B0); PG8_MMA(0, 1, At, B1); PG8_BAR; PG8_SCHED;
            PG8_LDA(At, 0, 1); PG8_STAGE(PG8_SB(0, 0), b2, voffB); PG8_STAGE(PG8_SB(0, 1), b2 + hstep, voffB); PG8_STAGE_G(PG8_SA(0, 0), s00, s01, k2);
            PG8_WAIT_V(8); PG8_WAIT_L(0); PG8_BAR; PG8_MMA(1, 0, At, B0); PG8_MMA(1, 1, At, B1); PG8_BAR; PG8_SCHED;
            PG8_LDB(B0, 1, 0); PG8_LDB(B1, 1, 1); PG8_SCHED; PG8_LDA(At, 1, 0); PG8_STAGE_G(PG8_SA(0, 1), s10, s11, k2);
            PG8_WAIT_V(8); PG8_WAIT_L(0); PG8_BAR; PG8_MMA(0, 0, At, B0); PG8_MMA(0, 1, At, B1); PG8_BAR; PG8_SCHED;
            PG8_LDA(At, 1, 1); PG8_STAGE(PG8_SB(1, 0), b3, voffB); PG8_STAGE(PG8_SB(1, 1), b3 + hstep, voffB); PG8_STAGE_G(PG8_SA(1, 0), s00, s01, k2 + kstep);
            PG8_WAIT_V(8); PG8_WAIT_L(0); PG8_BAR; PG8_MMA(1, 0, At, B0); PG8_MMA(1, 1, At, B1); PG8_BAR; PG8_SCHED;
            } else {
            PG8_LDB(B0, 0, 0); PG8_SCHED; PG8_LDA(At, 0, 0); PG8_STAGE(PG8_SA(1, 1), a1 + hstep, voffA);
            PG8_WAIT_L(8); PG8_BAR; PG8_WAIT_L(0); PG8_MMA(0, 0, At, B0); PG8_BAR; PG8_SCHED;
            PG8_LDB(B1, 0, 1); PG8_STAGE(PG8_SB(0, 0), b2, voffB);
            PG8_BAR; PG8_WAIT_L(0); PG8_MMA(0, 1, At, B1); PG8_BAR;
            PG8_LDA(At, 0, 1); PG8_STAGE(PG8_SA(0, 0), a2, voffA);
            PG8_BAR; PG8_WAIT_L(0); PG8_MMA(1, 0, At, B0); PG8_BAR; PG8_SCHED;
            PG8_STAGE(PG8_SB(0, 1), b2 + hstep, voffB);
            PG8_WAIT_V(6); PG8_BAR; PG8_MMA(1, 1, At, B1); PG8_BAR;
            PG8_LDB(B0, 1, 0); PG8_SCHED; PG8_LDA(At, 1, 0); PG8_STAGE(PG8_SA(0, 1), a2 + hstep, voffA);
            PG8_WAIT_L(8); PG8_BAR; PG8_WAIT_L(0); PG8_MMA(0, 0, At, B0); PG8_BAR; PG8_SCHED;
            PG8_LDB(B1, 1, 1); PG8_STAGE(PG8_SB(1, 0), b3, voffB);
            PG8_BAR; PG8_WAIT_L(0); PG8_MMA(0, 1, At, B1); PG8_BAR;
            PG8_LDA(At, 1, 1); PG8_STAGE(PG8_SA(1, 0), a3, voffA);
            PG8_BAR; PG8_WAIT_L(0); PG8_MMA(1, 0, At, B0); PG8_BAR; PG8_SCHED;
            PG8_STAGE(PG8_SB(1, 1), b3 + hstep, voffB);
            PG8_WAIT_V(6); PG8_BAR; PG8_MMA(1, 1, At, B1); PG8_BAR;
            }
        }
        if constexpr (ALIGN_EPI) { if (wr == 0) PG8_BAR; }
        asm volatile("s_nop 15\n\ts_nop 15" ::: "memory");
        if constexpr (!Epi::AFTER_DRAIN) { E(acc, cur, wr, wc, fr, fq); S.done(cur); }
        if (!has_next) break;
#pragma unroll
        for (int a = 0; a < 2; ++a)
#pragma unroll
            for (int b = 0; b < 2; ++b)
#pragma unroll
                for (int m = 0; m < 4; ++m)
#pragma unroll
                    for (int n = 0; n < 2; ++n) acc[a][b][m][n] = (f32x4){0.f, 0.f, 0.f, 0.f};
        cur = nxt; cA = nA; cB = nB; ++ui; co[0][0] = no[0][0]; co[0][1] = no[0][1]; co[1][0] = no[1][0]; co[1][1] = no[1][1];
        if constexpr (ALIGN_EPI) { if (wr == 1) PG8_BAR; }
    }
    PG8_WAIT_V(0);
    if constexpr (!ALIGN_EPI) { if (wr == 0) PG8_BAR; }
    PG8_BAR;
    if constexpr (Epi::AFTER_DRAIN) { E.fused(acc, cur, wr, wc, fr, fq, lds, wid, lane); S.done(cur); }
#undef PG8_SA
#undef PG8_SB
#undef PG8_STAGE
#undef PG8_STAGE_G
#undef PG8_ROWOFF
#undef PG8_LDA
#undef PG8_LDB
#undef PG8_MMA
#undef PG8_WAIT_V
#undef PG8_WAIT_L
#undef PG8_BAR
#undef PG8_SCHED
}


}

#ifndef ATTN_NAIVE
#define ATTN_NAIVE 0
#endif
#ifndef REP_MASK
#define REP_MASK 0
#endif
#define REPEAT(j) for (int rep_ = 0; rep_ < ((REP_MASK >> (j)) & 1) + 1; ++rep_)
#ifndef MLSTM_NAIVE
#define MLSTM_NAIVE 0
#endif
constexpr int D = 1024, BATCH = 8, SEQ = 4096, DEPTH = 4, NTOK = BATCH * SEQ, NMEM = 256, NE = 16, CAP = 512, DFF = 2048, NSLOT = BATCH * NE * CAP;
constexpr int DIN = 2576, NPROJ = 2560;
constexpr int C_MQ = 0, C_MK = 256, C_MV = 512, C_MO = 1024, C_NQ = 1536, C_NK = 1792, C_NV = 2048, C_CQ = 2304;
constexpr int GATE_COL = 1536;
constexpr float EPS = 1e-6f;
constexpr int NPHASE = 2 + 11 * DEPTH + 1;

constexpr int LDS_BYTES = 147456;
constexpr int LDS_SCR = 256;

#define LAS __attribute__((address_space(3)))
typedef pg8::bf16_t bf16_t;
typedef pg8::f32x4 f32x4;
typedef pg8::u32x4 u32x4;
typedef unsigned u32x2 __attribute__((ext_vector_type(2)));
typedef float f32x2 __attribute__((ext_vector_type(2)));
#define LDS_WAIT() asm volatile("s_waitcnt lgkmcnt(0)" ::: "memory")
#ifndef Y8_FROM
#define Y8_FROM 1
#endif
#define GAS __attribute__((address_space(1)))
#define LAUNDER_V(x) asm volatile("" : "+v"(x))
#define LAUNDER_S(x) asm volatile("" : "+s"(x))
__device__ __forceinline__ int fresh_tid(int wave0) { int t_; asm volatile("v_mbcnt_lo_u32_b32 %0, -1, 0\n\tv_mbcnt_hi_u32_b32 %0, -1, %0" : "=v"(t_)); return (wave0 << 6) | t_; }
#define FRESH_TID() fresh_tid(wave0)
__device__ __forceinline__ float bflo(unsigned w) { return __uint_as_float(w << 16); }
__device__ __forceinline__ float bfhi(unsigned w) { return __uint_as_float(w & 0xffff0000u); }
__device__ __forceinline__ float bf1(bf16_t h) { return __uint_as_float(((unsigned)h) << 16); }
__device__ __forceinline__ unsigned pk2(float lo, float hi) { return pg8::cvt_pk_bf16(lo, hi); }
__device__ __forceinline__ unsigned f2bf_c(float f) { const unsigned u = __float_as_uint(f); return (u + 0x7fffu + ((u >> 16) & 1u)) >> 16; }
__device__ __forceinline__ unsigned pk2c(float lo, float hi) { return f2bf_c(lo) | (f2bf_c(hi) << 16); }
__device__ __forceinline__ float wave_sum(float v, int lane) {
#pragma unroll
    for (int o = 1; o < 64; o <<= 1) v += shx(v, o, lane);
    return v;
}
#define DPPF(v, ctrl) __int_as_float(__builtin_amdgcn_update_dpp(0, __float_as_int(v), (ctrl), 0xF, 0xF, true))
__device__ __forceinline__ float row_sum16(float v) { v += DPPF(v, 0xB1); v += DPPF(v, 0x4E); v += DPPF(v, 0x141); v += DPPF(v, 0x140); return v; }
__device__ __forceinline__ float row_max16(float v) { v = fmaxf(v, DPPF(v, 0xB1)); v = fmaxf(v, DPPF(v, 0x4E)); v = fmaxf(v, DPPF(v, 0x141)); v = fmaxf(v, DPPF(v, 0x140)); return v; }
__device__ __forceinline__ float wave_sum_fast(float v) { return rows_sum4(row_sum16(v)); }
#define SWZF(v, pat) __int_as_float(__builtin_amdgcn_ds_swizzle(__float_as_int(v), (pat)))
__device__ __forceinline__ float sigmoidf_(float x) { return __builtin_amdgcn_rcpf(1.0f + __expf(-x)); }

#define XB_TMO      128
#define XB_XCNT(j)  (256  + 64 * (j))
#define XB_XSUB(j)  (1280 + 64 * (j))
#define XB_XGEN(j)  (2304 + 64 * (j))
#define XB_TOP      3328
#define XB_TOPGEN   3392
#define XCD_BAR_WORDS 3456
#define XB_SPIN_CAP (1u << 18)
__device__ __forceinline__ unsigned xb_ld(unsigned* p)              { return __hip_atomic_load(p, __ATOMIC_RELAXED, __HIP_MEMORY_SCOPE_AGENT); }
__device__ __forceinline__ unsigned xb_add(unsigned* p, unsigned v) { return __hip_atomic_fetch_add(p, v, __ATOMIC_RELAXED, __HIP_MEMORY_SCOPE_AGENT); }
__device__ __forceinline__ unsigned xb_xcc_id() { return (unsigned)__builtin_amdgcn_s_getreg((3 << 11) | 20) & 0xFu; }
#define XB_SPIN(cond, bar) do { unsigned _sp = 0; while (cond) { __builtin_amdgcn_s_sleep(1); \
    if ((++_sp & 255u) == 0u) { if (xb_ld(&(bar)[XB_TMO])) break; if (_sp > XB_SPIN_CAP) { atomicAdd(&(bar)[XB_TMO], 1u); break; } } } } while (0)
struct XcdBarrier { unsigned* bar; unsigned x; volatile LAS unsigned* st; int w0; };
__device__ __forceinline__ XcdBarrier xcd_barrier_post(unsigned* bar, volatile LAS unsigned* st, int w0) {
    XcdBarrier b; b.bar = bar; b.x = xb_xcc_id(); b.st = st; b.w0 = w0;
    if (fresh_tid(w0) == 0) (void)xb_add(&bar[XB_XCNT(b.x)], 1u);
    return b;
}
__device__ __forceinline__ void xcd_barrier_complete(unsigned* bar, unsigned x, unsigned& nloc, unsigned& nx) {
    const unsigned G = gridDim.x * gridDim.y * gridDim.z;
    unsigned sum, cnt, mine, sp = 0u;
    for (;;) {
        sum = 0u; cnt = 0u; mine = 0u;
#pragma unroll
        for (unsigned j = 0; j < 16; ++j) { const unsigned c = xb_ld(&bar[XB_XCNT(j)]); sum += c; cnt += (c > 0u) ? 1u : 0u; mine = (j == x) ? c : mine; }
        if (sum == G) break;
        __builtin_amdgcn_s_sleep(1);
        if ((++sp & 255u) == 0u) { if (xb_ld(&bar[XB_TMO])) break; if (sp > XB_SPIN_CAP) { atomicAdd(&bar[XB_TMO], 1u); break; } }
    }
    nloc = mine > 0u ? mine : 1u; nx = cnt > 0u ? cnt : 1u;
}
__device__ __forceinline__ void xcd_barrier(const XcdBarrier& b) {
    asm volatile("s_waitcnt vmcnt(0)" ::: "memory");
    __syncthreads();
    if (fresh_tid(b.w0) == 0) {
        unsigned* bar = b.bar;
        __builtin_amdgcn_s_waitcnt(0);
        unsigned nloc = b.st[0], nx = b.st[1];
        if (nloc == 0u) { xcd_barrier_complete(bar, b.x, nloc, nx); b.st[0] = nloc; b.st[1] = nx; }
        const unsigned old = xb_add(&bar[XB_XSUB(b.x)], 1u);
        const unsigned gen = old / nloc;
        if (old + 1u == (gen + 1u) * nloc) {
            __builtin_amdgcn_fence(__ATOMIC_RELEASE, "agent");
            asm volatile("s_waitcnt vmcnt(0)" ::: "memory");
            const unsigned og = xb_add(&bar[XB_TOP], 1u);
            const unsigned tg = og / nx;
            if (og + 1u == (tg + 1u) * nx) xb_add(&bar[XB_TOPGEN], 1u);
            else XB_SPIN(xb_ld(&bar[XB_TOPGEN]) == tg, bar);
            __builtin_amdgcn_fence(__ATOMIC_ACQUIRE, "agent");
            xb_add(&bar[XB_XGEN(b.x)], 1u);
            asm volatile("s_waitcnt vmcnt(0)" ::: "memory");
        } else {
            XB_SPIN(xb_ld(&bar[XB_XGEN(b.x)]) == gen, bar);
            __builtin_amdgcn_fence(__ATOMIC_ACQUIRE, "agent");
            asm volatile("s_waitcnt vmcnt(0)" ::: "memory");
        }
    }
    __syncthreads();
}

struct Params {
    const float *x, *mem, *g_mix, *w_in, *b_gates, *conv_qk, *g_mh, *na_gq, *na_gk, *na_rpb, *g_mem, *w_mem_kv, *mem_gq, *mem_gk, *w_out, *g_ffn, *w_router, *w1, *w3, *w2;
    float* out; unsigned char* ws; int ph_lo, ph_hi, li, pad;
};

__device__ __forceinline__ void tr_tile(const float* src, int ldw, bf16_t* dst, int K, LAS float* scr, int lane, int jump = 0, const float* ksc = nullptr) {
    f32x4 v[16]; const int c = lane & 7;
    f32x4 g0 = {1.f, 1.f, 1.f, 1.f}, g1 = g0;
#pragma unroll
    for (int i = 0; i < 16; ++i) v[i] = *(const f32x4*)(src + (size_t)(4 * i + (lane >> 4)) * ldw + 4 * (lane & 15));
    if (ksc) { g0 = *(const f32x4*)(ksc + 8 * c); g1 = *(const f32x4*)(ksc + 8 * c + 4); }
#pragma unroll
    for (int i = 0; i < 16; ++i) { LAS float* s = scr + (4 * i + (lane >> 4)) * 65 + 4 * (lane & 15); s[0] = v[i].x; s[1] = v[i].y; s[2] = v[i].z; s[3] = v[i].w; }
    LDS_WAIT();
#pragma unroll
    for (int j = 0; j < 8; ++j) { const int n = (lane >> 3) + 8 * j; const LAS float* s = scr + (8 * c) * 65 + n;
        u32x4 o; o.x = pk2(s[0] * g0.x, s[65] * g0.y); o.y = pk2(s[130] * g0.z, s[195] * g0.w); o.z = pk2(s[260] * g1.x, s[325] * g1.y); o.w = pk2(s[390] * g1.z, s[455] * g1.w);
        *(u32x4*)(dst + (size_t)(n + (n >= 32 ? jump : 0)) * K + 8 * c) = o; }
    LDS_WAIT();
}
__device__ __forceinline__ void tr8_load(const float* src, int ldw, int lane, f32x4 (&v)[16]) {
#pragma unroll
    for (int i = 0; i < 16; ++i) v[i] = *(const f32x4*)(src + (size_t)(4 * i + (lane >> 4)) * ldw + 4 * (lane & 15));
}
__device__ __forceinline__ void tr8_finish(const f32x4 (&v)[16], unsigned char* dst, int K, LAS float* scr, int lane) {
#pragma unroll
    for (int i = 0; i < 16; ++i) { LAS float* s = scr + (4 * i + (lane >> 4)) * 65 + 4 * (lane & 15); s[0] = v[i].x; s[1] = v[i].y; s[2] = v[i].z; s[3] = v[i].w; }
    LDS_WAIT();
    const int c = lane & 7;
#pragma unroll
    for (int j = 0; j < 8; ++j) { const int n = (lane >> 3) + 8 * j; const LAS float* s = scr + (8 * c) * 65 + n;
        u32x2 o; o.x = pg8::pk4_fp8(256.f * s[0], 256.f * s[65], 256.f * s[130], 256.f * s[195]); o.y = pg8::pk4_fp8(256.f * s[260], 256.f * s[325], 256.f * s[390], 256.f * s[455]);
        *(u32x2*)(dst + (size_t)n * K + 8 * c) = o; }
    LDS_WAIT();
}
__device__ __forceinline__ void f8_tile(const Params& p, unsigned char* ws_, int it, const float*& src, int& ldw, unsigned char*& dst, int& K) {
    constexpr int T_W1 = 64 * 512;
    if (it < 2 * T_W1) { const int which = it / T_W1, r = it - which * T_W1, le = r >> 9, q = r & 511, kb = q >> 5, nb = q & 31, n0 = nb * 64, drow = (n0 >> 7) * 256 + (n0 & 127) + which * 128;
        src = (which ? p.w3 : p.w1) + (size_t)le * D * DFF + (size_t)kb * 64 * DFF + n0; ldw = DFF; dst = ws_ + WS_W13 + ((size_t)le * 4096 + drow) * D + kb * 64; K = D; }
    else { const int r = it - 2 * T_W1, le = r >> 9, q = r & 511, kb = q >> 4, nb = q & 15;
        src = p.w2 + (size_t)le * DFF * D + (size_t)kb * 64 * D + nb * 64; ldw = D; dst = ws_ + WS_W2 + ((size_t)le * D + nb * 64) * DFF + kb * 64; K = DFF; }
}
__device__ __forceinline__ void tr_tile8(const float* src, int ldw, unsigned char* dst, int K, LAS float* scr, int lane) {
#pragma unroll 4
    for (int i = 0; i < 16; ++i) { const int kk = 4 * i + (lane >> 4); const f32x4 v = *(const f32x4*)(src + (size_t)kk * ldw + 4 * (lane & 15));
        LAS float* s = scr + kk * 65 + 4 * (lane & 15); s[0] = v.x; s[1] = v.y; s[2] = v.z; s[3] = v.w; }
    LDS_WAIT();
    const int c = lane & 7;
#pragma unroll
    for (int j = 0; j < 8; ++j) { const int n = (lane >> 3) + 8 * j; const LAS float* s = scr + (8 * c) * 65 + n;
        u32x2 o; o.x = pg8::pk4_fp8(256.f * s[0], 256.f * s[65], 256.f * s[130], 256.f * s[195]); o.y = pg8::pk4_fp8(256.f * s[260], 256.f * s[325], 256.f * s[390], 256.f * s[455]);
        *(u32x2*)(dst + (size_t)n * K + 8 * c) = o; }
    LDS_WAIT();
}
__device__ __forceinline__ void ph_cvt_experts(const Params& p, LAS unsigned char* lds, const int tid, int G, int bid) {
    unsigned char* ws_ = p.ws; LAUNDER_S(ws_);
    const int lane = tid & 63, wave = __builtin_amdgcn_readfirstlane(tid >> 6);
    constexpr int NB = 3 * 4096;
    const bool shift = (G == 256);
    const int nmine = (NB - bid + G - 1) / G, nown = shift && bid < 64 ? 45 : nmine, n = shift && bid >= 64 ? nmine + 1 : nown;
    {
        LAS float* tile = (LAS float*)(lds + LDS_SCR);
        f32x4 cur[16]; const float* src = nullptr; int ldw = 0; unsigned char* dst = nullptr; int Kd = 0, hi = 0;
#define CVT_DECODE(I, src_, ldw_, dst_, K_, hi_) do { const int mtx = (I) >> 12, r_ = (I) & 4095, le = r_ >> 6, q_ = r_ & 63; \
            if (mtx < 2) { const int kb = q_ >> 3, nb = q_ & 7; \
                src_ = (mtx ? p.w3 : p.w1) + (size_t)le * D * DFF + (size_t)kb * 128 * DFF + nb * 256; ldw_ = DFF; dst_ = ws_ + WS_W13 + ((size_t)le * 4096 + nb * 512 + mtx * 128) * D + kb * 128; K_ = D; hi_ = 128; } \
            else { const int kb = q_ >> 2, nb = q_ & 3; \
                src_ = p.w2 + (size_t)le * DFF * D + (size_t)kb * 128 * D + nb * 256; ldw_ = D; dst_ = ws_ + WS_W2 + ((size_t)le * D + nb * 256) * DFF + kb * 128; K_ = DFF; hi_ = 0; } } while (0)
#define CVT_LOAD(v, src_, ldw_) do { _Pragma("unroll") for (int i = 0; i < 16; ++i) v[i] = *(const f32x4*)((src_) + (size_t)(16 * wave + i) * (ldw_) + 4 * lane); } while (0)
#define CVT_PROC(v, dst_, K_, hi_) do { \
            _Pragma("unroll") for (int i = 0; i < 16; ++i) { const int k = 16 * wave + i; *(LAS f32x4*)(tile + k * 256 + ((4 * lane) ^ ((k >> 3) << 2))) = v[i]; } \
            __syncthreads(); \
            { const int c = lane & 15; \
              _Pragma("unroll") for (int j = 0; j < 8; ++j) { const int n = 32 * wave + 4 * j + (lane >> 4); const LAS float* t1 = tile + (8 * c) * 256 + (n ^ (c << 2)); \
                  u32x2 o; o.x = pg8::pk4_fp8s(t1[0], t1[256], t1[512], t1[768], 0.00390625f); o.y = pg8::pk4_fp8s(t1[1024], t1[1280], t1[1536], t1[1792], 0.00390625f); \
                  *(u32x2*)((dst_) + (size_t)(n + (n >> 7) * (hi_)) * (K_) + 8 * c) = o; } } \
            __syncthreads(); } while (0)
        f32x4 vb[16]; const float* srcb = nullptr; int ldwb = 0; unsigned char* dstb = nullptr; int Kb = 0, hib = 0;
#define CVT_BLK(t_) ((t_) < nown ? bid + (t_) * G : ((bid - 64) & 63) + (45 + ((bid - 64) >> 6)) * G)
        int t = 0;
        if (t < n) { const int I = CVT_BLK(t); CVT_DECODE(I, src, ldw, dst, Kd, hi); CVT_LOAD(cur, src, ldw); }
#pragma unroll 1
        while (t < n) {
            if (t + 1 < n) { const int I2 = CVT_BLK(t + 1); CVT_DECODE(I2, srcb, ldwb, dstb, Kb, hib); CVT_LOAD(vb, srcb, ldwb); }
            CVT_PROC(cur, dst, Kd, hi);
            if (t + 1 >= n) break;
            if (t + 2 < n) { const int I3 = CVT_BLK(t + 2); CVT_DECODE(I3, src, ldw, dst, Kd, hi); CVT_LOAD(cur, src, ldw); }
            CVT_PROC(vb, dstb, Kb, hib);
            t += 2; }
#undef CVT_BLK
#undef CVT_PROC
#undef CVT_DECODE
#undef CVT_LOAD
    }
}
__device__ __forceinline__ void ph_convert(const Params& p, LAS unsigned char* lds, const int tid, int G, int bid) {
    unsigned char* ws_ = p.ws; LAUNDER_S(ws_);
    const int lane = tid & 63, wave = __builtin_amdgcn_readfirstlane(tid >> 6);
    LAS float* scr = (LAS float*)(lds + LDS_SCR + wave * 16640);
    const int gw = bid * 8 + wave, NGW = G * 8;
    bf16_t* w13t = (bf16_t*)(ws_ + WS_W13); bf16_t* w2t = (bf16_t*)(ws_ + WS_W2); bf16_t* wint = (bf16_t*)(ws_ + WS_WIN); bf16_t* wkvt = (bf16_t*)(ws_ + WS_WKV); bf16_t* woutt = (bf16_t*)(ws_ + WS_WOUT);
    constexpr int T_IN = 4 * 16 * 40, T_KV = 4 * 16 * 8, T_OUT = 4 * 16 * 16;
    for (int it = gw; it < T_IN + T_KV + T_OUT; it += NGW) {
        int r = it;
        if (r < T_IN) { const int l = r / 640, q = r % 640, kb = q / 40, nb = q % 40, n0 = nb * 64, sc = n0 < GATE_COL ? n0 : n0 + 16;
            const int tile = n0 >> 8; const bool hp = (tile == 6 || tile == 7 || tile == 9); const int drow = hp ? (tile * 256 + 32 * ((n0 & 255) >> 6)) : n0;
            tr_tile(p.w_in + (size_t)l * D * DIN + (size_t)kb * 64 * DIN + sc, DIN, wint + ((size_t)l * NPROJ + drow) * D + kb * 64, D, scr, lane, hp ? 96 : 0, p.g_mix + l * D + kb * 64); continue; }
        r -= T_IN;
        if (r < T_KV) { const int l = r >> 7, q = r & 127, kb = q >> 3, nb = q & 7;
            const bool hp = nb < 4; const int drow = hp ? 32 * nb : nb * 64;
            tr_tile(p.w_mem_kv + (size_t)l * D * 512 + (size_t)kb * 64 * 512 + nb * 64, 512, wkvt + ((size_t)l * 512 + drow) * D + kb * 64, D, scr, lane, hp ? 96 : 0); continue; }
        r -= T_KV;
        { const int l = r >> 8, q = r & 255, kb = q >> 4, nb = q & 15;
            if (l >= Y8_FROM) tr_tile8(p.w_out + (size_t)l * D * D + (size_t)kb * 64 * D + nb * 64, D, (unsigned char*)(woutt + (size_t)l * D * D) + (size_t)(nb * 64) * D + kb * 64, D, scr, lane);
          else tr_tile(p.w_out + (size_t)l * D * D + (size_t)kb * 64 * D + nb * 64, D, woutt + ((size_t)l * D + nb * 64) * D + kb * 64, D, scr, lane); }
    }
    bf16_t* memh = (bf16_t*)(ws_ + WS_MEMH);
    for (int r = gw; r < BATCH * NMEM; r += NGW) {
        const f32x4* xr = (const f32x4*)(p.mem + (size_t)r * D) + lane; f32x4 v[4]; float ss = 0.f;
#pragma unroll
        for (int j = 0; j < 4; ++j) { v[j] = xr[64 * j]; ss += v[j].x * v[j].x + v[j].y * v[j].y + v[j].z * v[j].z + v[j].w * v[j].w; }
        const float rr = rsqrtf(wave_sum(ss, lane) * (1.f / D) + EPS);
        f32x4 gm[DEPTH][4];
#pragma unroll
        for (int l = 0; l < DEPTH; ++l)
#pragma unroll
            for (int j = 0; j < 4; ++j) gm[l][j] = *((const f32x4*)(p.g_mem + l * D) + lane + 64 * j);
#pragma unroll
        for (int l = 0; l < DEPTH; ++l) { u32x2* o = (u32x2*)(memh + ((size_t)l * BATCH * NMEM + r) * D) + lane;
#pragma unroll
            for (int j = 0; j < 4; ++j) { const f32x4 g = gm[l][j]; u32x2 w; w.x = pk2(v[j].x * rr * g.x, v[j].y * rr * g.y); w.y = pk2(v[j].z * rr * g.z, v[j].w * rr * g.w); o[64 * j] = w; } }
    }
    { float* gt = (float*)(ws_ + WS_GT); const int i = bid * 512 + tid;
      if (i < DEPTH * 192) { const int l = i / 192, q = i % 192, w = q >> 6, d = q & 63; gt[i] = (w == 0 ? p.na_gq : (w == 1 ? p.na_gk : p.mem_gq))[l * 64 + d]; } }
}

__device__ __forceinline__ float reduce16(float (&pv)[16], int lane) {
    float a8[8], a4[4], a2[2];
#pragma unroll
    for (int i = 0; i < 8; ++i) { const bool od = lane & 1; const float keep = od ? pv[2 * i + 1] : pv[2 * i], send = od ? pv[2 * i] : pv[2 * i + 1]; a8[i] = keep + DPPF(send, 0xB1); }
#pragma unroll
    for (int i = 0; i < 4; ++i) { const bool od = lane & 2; const float keep = od ? a8[2 * i + 1] : a8[2 * i], send = od ? a8[2 * i] : a8[2 * i + 1]; a4[i] = keep + DPPF(send, 0x4E); }
#pragma unroll
    for (int i = 0; i < 2; ++i) { const bool od = lane & 4; const float keep = od ? a4[2 * i + 1] : a4[2 * i], send = od ? a4[2 * i] : a4[2 * i + 1]; a2[i] = keep + SWZF(send, 0x101F); }
    const bool od = lane & 8; const float keep = od ? a2[1] : a2[0], send = od ? a2[0] : a2[1];
    return rows_sum4(keep + SWZF(send, 0x201F));
}
template <bool F> struct NormRaw { typedef u32x2 T; };
template <> struct NormRaw<true> { typedef f32x4 T; };
__device__ __forceinline__ void nrm_ld(f32x4& r, const void* base, size_t tok, int idx) { r = *((const f32x4*)((const float*)base + tok * D) + idx); }
__device__ __forceinline__ void nrm_ld(u32x2& r, const void* base, size_t tok, int idx) { r = *((const u32x2*)((const bf16_t*)base + tok * D) + idx); }
__device__ __forceinline__ f32x4 nrm_up(const f32x4& r) { return r; }
__device__ __forceinline__ f32x4 nrm_up(const u32x2& r) { return f32x4{bflo(r.x), bfhi(r.x), bflo(r.y), bfhi(r.y)}; }
template <int MODE, bool XF32>
__device__ __forceinline__ void ph_norm(const Params& p, int l, bool combine, LAS unsigned char* lds, const int tid, int G, int bid, const void* xin) {
    GAS unsigned char* ws_ = (GAS unsigned char*)p.ws; LAUNDER_S(ws_);
    const int lane = tid & 63, wave = __builtin_amdgcn_readfirstlane(tid >> 6);
    LAS unsigned char* wl = lds + LDS_SCR;
    if (MODE != 2) {
        const GAS float* wsrc = (const GAS float*)(MODE == 0 ? p.w_in + (size_t)l * D * DIN + GATE_COL : p.w_router + (size_t)l * D * NE); const int ldw = MODE == 0 ? DIN : NE;
        f32x4 wt[8];
#pragma unroll
        for (int j = 0; j < 8; ++j) { const int i = tid + 512 * j, k = i >> 2, part = i & 3; wt[j] = *(const GAS f32x4*)(wsrc + (size_t)k * ldw + part * 4); }
#pragma unroll
        for (int j = 0; j < 8; ++j) { const int i = tid + 512 * j, k = i >> 2, part = i & 3; *(LAS f32x4*)(wl + k * 64 + (k >> 2) * 16 + part * 16) = wt[j]; }
        __syncthreads();
    }
    const GAS float* gsrc = (const GAS float*)(MODE == 0 ? p.g_mix + l * D : p.g_ffn + l * D);
    f32x4 gv[4];
#pragma unroll
    for (int j = 0; j < 4; ++j) gv[j] = MODE != 2 ? *((const GAS f32x4*)gsrc + lane + 64 * j) : (f32x4){0.f, 0.f, 0.f, 0.f};
    GAS bf16_t* hb = (GAS bf16_t*)(ws_ + WS_H); const GAS bf16_t* ybuf = (const GAS bf16_t*)(ws_ + WS_YBUF); const GAS int* slotmap = (const GAS int*)(ws_ + WS_ROUTE + RT_SLOTMAP);
    GAS float* gates = (GAS float*)(ws_ + WS_GATES); GAS float* aff = (GAS float*)(ws_ + WS_AFF);
    LAS unsigned char* stg = lds + LDS_SCR + 70656 + wave * 8192;
#define NORM_ISSUE(tok, e, c, slot) do { const GAS unsigned char* yr = (const GAS unsigned char*)ybuf + ((size_t)(((e) * BATCH + ((tok) >> 12)) * CAP + (c))) * D + lane * 16; LAS unsigned char* dl = stg + __builtin_amdgcn_readfirstlane(slot) * 1024; \
        __builtin_amdgcn_global_load_lds((const GAS unsigned*)yr, (LAS unsigned*)dl, 16, 0, 0); } while (0)
#define NORM_COMBINE2(va_, tokA_, cva_, vb_, tokB_, cvb_) do { int ca = 0, cb = 0; \
        _Pragma("unroll 1") for (int e = 0; e < NE; ++e) { const int c = __builtin_amdgcn_readlane(cva_, e);        \
            if (c >= 0) { NORM_ISSUE(tokA_, e, c, ca); if (++ca == 8) NORM_FLUSH2(va_, vb_); } } \
        _Pragma("unroll 1") for (int e = 0; e < NE; ++e) { const int c = __builtin_amdgcn_readlane(cvb_, e); \
            if (c >= 0) { NORM_ISSUE(tokB_, e, c, ca + cb); ++cb; if (ca + cb == 8) NORM_FLUSH2(va_, vb_); } } \
        if (ca + cb) NORM_FLUSH2(va_, vb_); \
        NORM_XSTORE(va_, tokA_); NORM_XSTORE(vb_, tokB_); } while (0)
#define NORM_FLUSH2(va_, vb_) do { asm volatile("s_waitcnt vmcnt(0)" ::: "memory"); \
        for (int k = 0; k < ca; ++k) { _Pragma("unroll") for (int j = 0; j < 4; ++j) { const unsigned w = *(const LAS unsigned*)(stg + k * 1024 + j * 256 + lane * 4); \
            va_[j].x += 0.125f * __builtin_amdgcn_cvt_f32_fp8(w, 0); va_[j].y += 0.125f * __builtin_amdgcn_cvt_f32_fp8(w, 1); va_[j].z += 0.125f * __builtin_amdgcn_cvt_f32_fp8(w, 2); va_[j].w += 0.125f * __builtin_amdgcn_cvt_f32_fp8(w, 3); } } \
        for (int k = 0; k < cb; ++k) { _Pragma("unroll") for (int j = 0; j < 4; ++j) { const unsigned w = *(const LAS unsigned*)(stg + (ca + k) * 1024 + j * 256 + lane * 4); \
            vb_[j].x += 0.125f * __builtin_amdgcn_cvt_f32_fp8(w, 0); vb_[j].y += 0.125f * __builtin_amdgcn_cvt_f32_fp8(w, 1); vb_[j].z += 0.125f * __builtin_amdgcn_cvt_f32_fp8(w, 2); vb_[j].w += 0.125f * __builtin_amdgcn_cvt_f32_fp8(w, 3); } } \
        asm volatile("s_waitcnt lgkmcnt(0)" ::: "memory"); ca = 0; cb = 0; } while (0)
#define NORM_XSTORE(v, tok) do { if (MODE == 2) { _Pragma("unroll") for (int j = 0; j < 4; ++j) *((GAS f32x4*)(p.out + (size_t)(tok) * D) + lane + 64 * j) = v[j]; } \
        else { _Pragma("unroll") for (int j = 0; j < 4; ++j) { u32x2 w_; w_.x = pk2(v[j].x, v[j].y); w_.y = pk2(v[j].z, v[j].w); ((GAS u32x2*)(xb + (size_t)(tok) * D))[lane + 64 * j] = w_; } } } while (0)
    GAS bf16_t* xb = (GAS bf16_t*)(ws_ + WS_XB);
    const float bgate = MODE == 0 ? p.b_gates[l * 16 + (lane & 15)] : 0.f;
    int sna_ = -1, snb_ = -1;
    typename NormRaw<XF32>::T na_[4], nb_[4];
    { const int t0 = (bid * 8 + wave) * 2;
      if (t0 < NTOK) {
        if (combine) { sna_ = slotmap[(size_t)t0 * NE + (lane & 15)]; snb_ = slotmap[(size_t)(t0 + 1) * NE + (lane & 15)]; }
#pragma unroll
        for (int j = 0; j < 4; ++j) { nrm_ld(na_[j], xin, (size_t)t0, lane + 64 * j); nrm_ld(nb_[j], xin, (size_t)(t0 + 1), lane + 64 * j); } } }
#pragma unroll 1
    for (int tokA = (bid * 8 + wave) * 2; tokA < NTOK; tokA += G * 8 * 2) {
        const int tokB = tokA + 1;
        f32x4 va[4], vb[4];
#pragma unroll
        for (int j = 0; j < 4; ++j) { va[j] = nrm_up(na_[j]); vb[j] = nrm_up(nb_[j]); }
        const int cva = sna_, cvb = snb_;
        { const int tn = tokA + G * 8 * 2;
          if (tn < NTOK) {
            if (combine) { sna_ = slotmap[(size_t)tn * NE + (lane & 15)]; snb_ = slotmap[(size_t)(tn + 1) * NE + (lane & 15)]; }
#pragma unroll
            for (int j = 0; j < 4; ++j) { nrm_ld(na_[j], xin, (size_t)tn, lane + 64 * j); nrm_ld(nb_[j], xin, (size_t)(tn + 1), lane + 64 * j); } } }
        if (combine) { NORM_COMBINE2(va, tokA, cva, vb, tokB, cvb); }
        else if (XF32) { NORM_XSTORE(va, tokA); NORM_XSTORE(vb, tokB); }
        if (MODE == 2) continue;
        float ssa = 0.f, ssb = 0.f;
#pragma unroll
        for (int j = 0; j < 4; ++j) { ssa += va[j].x * va[j].x + va[j].y * va[j].y + va[j].z * va[j].z + va[j].w * va[j].w; }
#pragma unroll
        for (int j = 0; j < 4; ++j) { ssb += vb[j].x * vb[j].x + vb[j].y * vb[j].y + vb[j].z * vb[j].z + vb[j].w * vb[j].w; }
        const float rra = rsqrtf(wave_sum_fast(ssa) * (1.f / D) + EPS); float rrb = rsqrtf(wave_sum_fast(ssb) * (1.f / D) + EPS); asm volatile("" : "+v"(rrb));
        f32x2 pab[16];
#pragma unroll
        for (int g = 0; g < 16; ++g) pab[g] = (f32x2){0.f, 0.f};
        unsigned lb = (unsigned)lane * 272u + LDS_SCR; LAUNDER_V(lb);
        f32x4 hA[4], hB[4];
#pragma unroll
        for (int j = 0; j < 4; ++j) { const f32x4 gj = gv[j]; hA[j] = va[j] * gj * rra; hB[j] = vb[j] * gj * rrb; }
        f32x4 wc[2][4], wn[2][4];
#pragma unroll
        for (int qq = 0; qq < 2; ++qq) { const LAS f32x4* wr4 = (const LAS f32x4*)(lds + lb + qq * 64);
#pragma unroll
            for (int part = 0; part < 4; ++part) wc[qq][part] = wr4[part]; }
#pragma unroll
        for (int hs = 0; hs < 8; ++hs) {
            if (hs < 7) { const int jn = (hs + 1) >> 1, qb = 2 * ((hs + 1) & 1);
#pragma unroll
                for (int qq = 0; qq < 2; ++qq) { const LAS f32x4* wr4 = (const LAS f32x4*)(lds + lb + jn * 17408 + (qb + qq) * 64);
#pragma unroll
                    for (int part = 0; part < 4; ++part) wn[qq][part] = wr4[part]; } }
            __builtin_amdgcn_sched_barrier(0);
            { const int j = hs >> 1, qb = 2 * (hs & 1);
#pragma unroll
              for (int qq = 0; qq < 2; ++qq) { const f32x2 hq = {hA[j][qb + qq], hB[j][qb + qq]};
#pragma unroll
                  for (int part = 0; part < 4; ++part) { const f32x4 w4 = wc[qq][part];
                      pab[part * 4 + 0] += hq * w4.x; pab[part * 4 + 1] += hq * w4.y; pab[part * 4 + 2] += hq * w4.z; pab[part * 4 + 3] += hq * w4.w; } } }
            __builtin_amdgcn_sched_barrier(0);
            if (hs < 7) {
#pragma unroll
                for (int qq = 0; qq < 2; ++qq)
#pragma unroll
                    for (int part = 0; part < 4; ++part) wc[qq][part] = wn[qq][part]; } }
        float pa[16], pb[16];
#pragma unroll
        for (int g = 0; g < 16; ++g) { pa[g] = pab[g].x; pb[g] = pab[g].y; }
        const int g = lane & 15; const float ta = reduce16(pa, lane); float tb = reduce16(pb, lane);
        if (MODE == 0) { if (lane < 16) { gates[(size_t)tokA * 16 + g] = ta + bgate; gates[(size_t)tokB * 16 + g] = tb + bgate; }
            if (lane == 16) { GAS float* rrow = (GAS float*)(ws_ + WS_RR); rrow[tokA] = rra; rrow[tokB] = rrb; } }
        else { const float mxa = row_max16(ta), exa = __expf(ta - mxa), sma = row_sum16(exa); const float mxb = row_max16(tb), exb = __expf(tb - mxb), smb = row_sum16(exb);
            if (lane < 16) { aff[((size_t)(tokA >> 12) * NE + g) * SEQ + (tokA & (SEQ - 1))] = exa / sma; aff[((size_t)(tokB >> 12) * NE + g) * SEQ + (tokB & (SEQ - 1))] = exb / smb; } }
    }
#undef NORM_COMBINE2
#undef NORM_ISSUE
#undef NORM_XSTORE
#undef NORM_FLUSH2
}


__device__ __forceinline__ float reduce8(float (&pv)[8], int lane) {
    float a4[4], a2[2];
#pragma unroll
    for (int i = 0; i < 4; ++i) { const bool od = lane & 1; const float keep = od ? pv[2 * i + 1] : pv[2 * i], send = od ? pv[2 * i] : pv[2 * i + 1]; a4[i] = keep + DPPF(send, 0xB1); }
#pragma unroll
    for (int i = 0; i < 2; ++i) { const bool od = lane & 2; const float keep = od ? a4[2 * i + 1] : a4[2 * i], send = od ? a4[2 * i] : a4[2 * i + 1]; a2[i] = keep + DPPF(send, 0x4E); }
    const bool od = lane & 4; const float keep = od ? a2[1] : a2[0], send = od ? a2[0] : a2[1];
    float a1 = keep + SWZF(send, 0x101F);
    a1 += SWZF(a1, 0x201F);
    return rows_sum4(a1);
}
__device__ __forceinline__ void ph_norm1_t4(const Params& p, int l, LAS unsigned char* lds, const int tid, int G, int bid) {
    GAS unsigned char* ws_ = (GAS unsigned char*)p.ws; LAUNDER_S(ws_);
    const int lane = tid & 63, wave = __builtin_amdgcn_readfirstlane(tid >> 6);
    LAS unsigned char* wl = lds + LDS_SCR;
    { const GAS float* wsrc = (const GAS float*)(p.w_router + (size_t)l * D * NE);
      f32x4 wt[8];
#pragma unroll
      for (int j = 0; j < 8; ++j) { const int i = tid + 512 * j, k = i >> 2, part = i & 3; wt[j] = *(const GAS f32x4*)(wsrc + (size_t)k * NE + part * 4); }
#pragma unroll
      for (int j = 0; j < 8; ++j) { const int i = tid + 512 * j, k = i >> 2, part = i & 3; *(LAS f32x4*)(wl + k * 64 + (k >> 2) * 16 + part * 16) = wt[j]; }
      __syncthreads(); }
    const GAS float* gsrc = (const GAS float*)(p.g_ffn + l * D);
    f32x4 gv[4];
#pragma unroll
    for (int j = 0; j < 4; ++j) gv[j] = *((const GAS f32x4*)gsrc + lane + 64 * j);
    const GAS bf16_t* xb = (const GAS bf16_t*)(ws_ + WS_XB); GAS unsigned char* hb8 = ws_ + WS_H; GAS float* aff = (GAS float*)(ws_ + WS_AFF);
    u32x2 nr[4][4];
    const int tfirst = (bid * 8 + wave) * 4, tstep = G * 32;
    if (tfirst < NTOK) {
#pragma unroll
        for (int t = 0; t < 4; ++t)
#pragma unroll
            for (int j = 0; j < 4; ++j) nr[t][j] = *((const GAS u32x2*)(xb + (size_t)(tfirst + t) * D) + lane + 64 * j); }
#pragma unroll 1
    for (int tok0 = tfirst; tok0 < NTOK; tok0 += tstep) {
        f32x4 v[4][4]; float rr[4];
#pragma unroll
        for (int t = 0; t < 4; ++t)
#pragma unroll
            for (int j = 0; j < 4; ++j) { const u32x2 r = nr[t][j]; v[t][j] = (f32x4){bflo(r.x), bfhi(r.x), bflo(r.y), bfhi(r.y)}; }
        if (tok0 + tstep < NTOK) {
#pragma unroll
            for (int t = 0; t < 4; ++t)
#pragma unroll
                for (int j = 0; j < 4; ++j) nr[t][j] = *((const GAS u32x2*)(xb + (size_t)(tok0 + tstep + t) * D) + lane + 64 * j); }
#pragma unroll
        for (int t = 0; t < 4; ++t) { float ss = 0.f;
#pragma unroll
            for (int j = 0; j < 4; ++j) ss += v[t][j].x * v[t][j].x + v[t][j].y * v[t][j].y + v[t][j].z * v[t][j].z + v[t][j].w * v[t][j].w;
            rr[t] = rsqrtf(wave_sum_fast(ss) * (1.f / D) + EPS); }
#pragma unroll
        for (int j = 0; j < 4; ++j)
#pragma unroll
            for (int t = 0; t < 4; ++t) { const f32x4 h = v[t][j] * gv[j] * rr[t]; v[t][j] = h;
                ((GAS unsigned*)(hb8 + (size_t)(tok0 + t) * D))[lane + 64 * j] = pg8::pk4_fp8s(h.x, h.y, h.z, h.w, 0.125f); }
        float lg[4];
#pragma unroll
        for (int pass = 0; pass < 2; ++pass) {
            f32x2 pab[8], pcd[8];
#pragma unroll
            for (int e = 0; e < 8; ++e) { pab[e] = (f32x2){0.f, 0.f}; pcd[e] = (f32x2){0.f, 0.f}; }
            unsigned lb = (unsigned)lane * 272u + LDS_SCR + 32u * pass; LAUNDER_V(lb);
            f32x4 wcur[4][2], wnxt[4][2];
#pragma unroll
            for (int q = 0; q < 4; ++q) { const LAS f32x4* wr4 = (const LAS f32x4*)(lds + lb + q * 64); wcur[q][0] = wr4[0]; wcur[q][1] = wr4[1]; }
#pragma unroll
            for (int j = 0; j < 4; ++j) {
                if (j < 3) {
#pragma unroll
                    for (int q = 0; q < 4; ++q) { const LAS f32x4* wr4 = (const LAS f32x4*)(lds + lb + (j + 1) * 17408 + q * 64); wnxt[q][0] = wr4[0]; wnxt[q][1] = wr4[1]; } }
                __builtin_amdgcn_sched_barrier(0);
#pragma unroll
                for (int q = 0; q < 4; ++q) { const f32x2 hab = {v[0][j][q], v[1][j][q]}, hcd = {v[2][j][q], v[3][j][q]};
#pragma unroll
                    for (int pp = 0; pp < 2; ++pp) { const f32x4 w4 = wcur[q][pp];
                        pab[pp * 4 + 0] += hab * w4.x; pab[pp * 4 + 1] += hab * w4.y; pab[pp * 4 + 2] += hab * w4.z; pab[pp * 4 + 3] += hab * w4.w;
                        pcd[pp * 4 + 0] += hcd * w4.x; pcd[pp * 4 + 1] += hcd * w4.y; pcd[pp * 4 + 2] += hcd * w4.z; pcd[pp * 4 + 3] += hcd * w4.w; } }
                __builtin_amdgcn_sched_barrier(0);
                if (j < 3) {
#pragma unroll
                    for (int q = 0; q < 4; ++q) { wcur[q][0] = wnxt[q][0]; wcur[q][1] = wnxt[q][1]; } } }
            float pa[8], pb[8], pc[8], pd[8];
#pragma unroll
            for (int e = 0; e < 8; ++e) { pa[e] = pab[e].x; pb[e] = pab[e].y; pc[e] = pcd[e].x; pd[e] = pcd[e].y; }
            const float ra = reduce8(pa, lane), rb = reduce8(pb, lane), rc = reduce8(pc, lane), rd = reduce8(pd, lane);
            const bool mine = ((lane >> 3) & 1) == pass;
            if (pass == 0) { lg[0] = ra; lg[1] = rb; lg[2] = rc; lg[3] = rd; }
            else { lg[0] = mine ? ra : lg[0]; lg[1] = mine ? rb : lg[1]; lg[2] = mine ? rc : lg[2]; lg[3] = mine ? rd : lg[3]; }
        }
        const int g = lane & 15;
#pragma unroll
        for (int t = 0; t < 4; ++t) { const float mx = row_max16(lg[t]), ex = __expf(lg[t] - mx), sm = row_sum16(ex); const int tok = tok0 + t;
            if (lane < 16) aff[((size_t)(tok >> 12) * NE + g) * SEQ + (tok & (SEQ - 1))] = ex * __builtin_amdgcn_rcpf(sm); }
    }
}

typedef pg8::bf16x8 bf16x8;
template <bool NA>
__device__ __forceinline__ void ph_attn_mfma(const Params& p, int l, LAS unsigned char* lds, const int tid, int G, int bid) {
    unsigned char* ws_ = p.ws; LAUNDER_S(ws_);
    const int lane = tid & 63, gw = bid * 8 + __builtin_amdgcn_readfirstlane(tid >> 6), NGW = G * 8, fr = lane & 15, g = lane >> 4;
    const bf16_t* nrm = (const bf16_t*)(ws_ + WS_NRM); const bf16_t* nvt = (const bf16_t*)(ws_ + WS_NVT); const bf16_t* kmn = (const bf16_t*)(ws_ + WS_KMN); const bf16_t* vmt = (const bf16_t*)(ws_ + WS_VMT);
    bf16_t* y = (bf16_t*)(ws_ + WS_Y);
    LAS float* tb = (LAS float*)(lds + LDS_SCR);
    if (NA) { const float* rpb = p.na_rpb + (size_t)l * 4 * 15 * 31;
        for (int i = tid; i < 4 * 15 * 64; i += 512) { const int dcp = (i & 63) - 16, hr = i >> 6; tb[i] = (dcp >= 0 && dcp < 31) ? rpb[hr * 31 + dcp] : 0.f; }
        __syncthreads(); }
#pragma unroll 1
    for (int it = gw; it < BATCH * 4 * 256; it += NGW) {
        const int qb = it & 255, head = (it >> 8) & 3, b = it >> 10, tok0 = b * SEQ + qb * 16, r = qb >> 2, seg = qb & 3;
        const int rs = min(max(r - 4, 0), 56), kc0 = min(max(seg * 16 - 8, 0), 32);
        const bf16_t* qp = nrm + (size_t)(tok0 + fr) * 768 + (NA ? 0 : 512) + head * 64 + 8 * g;
        const bf16x8 qf0 = *(const bf16x8*)qp, qf1 = *(const bf16x8*)(qp + 32);
        const int jj0 = 8 * (fr >> 2) + (fr & 3);
        const bf16_t* kb = NA ? nrm + (size_t)(b * SEQ + rs * 64 + kc0 + jj0) * 768 + 256 + head * 64 + 8 * g : kmn + (size_t)((l * BATCH + b) * NMEM + jj0) * 256 + head * 64 + 8 * g;
        constexpr int KGS = NA ? 64 * 768 : 32 * 256, KTS = NA ? 4 * 768 : 4 * 256;
        bf16x8 ka[16][2];
#pragma unroll
        for (int i = 0; i < 16; ++i) { const bf16_t* kp = kb + (i >> 1) * KGS + (i & 1) * KTS; ka[i][0] = *(const bf16x8*)kp; ka[i][1] = *(const bf16x8*)(kp + 32); }
        __builtin_amdgcn_sched_barrier(0);
        f32x4 S[16];
#pragma unroll
        for (int i = 0; i < 16; ++i) { f32x4 z = {0.f, 0.f, 0.f, 0.f}; z = __builtin_amdgcn_mfma_f32_16x16x32_bf16(ka[i][0], qf0, z, 0, 0, 0); S[i] = __builtin_amdgcn_mfma_f32_16x16x32_bf16(ka[i][1], qf1, z, 0, 0, 0); }
        const bf16_t* vb = NA ? nvt + ((size_t)((b * 4 + head) * 64 + fr)) * SEQ + rs * 64 + kc0 + 8 * g : vmt + ((size_t)(((l * BATCH + b) * 4 + head) * 64 + fr)) * NMEM + 8 * g;
        constexpr int VMS = NA ? 16 * SEQ : 16 * NMEM, VGS = NA ? 64 : 32;
        bf16x8 va[16];
#pragma unroll
        for (int i = 0; i < 16; ++i) va[i] = *(const bf16x8*)(vb + (i >> 3) * VMS + (i & 7) * VGS);
        __builtin_amdgcn_sched_barrier(0);
        float mx = -1e30f;
        if (NA) { const int c = seg * 16 + fr, lo = min(max(c - 8, 0), 48) - c, dc0 = kc0 + 8 * g - c;
            const LAS float* tbl = tb + (head * 15 + (rs - r + 7)) * 64 + dc0 + 31;
#pragma unroll
            for (int i = 0; i < 16; ++i)
#pragma unroll
                for (int q = 0; q < 4; ++q) { const int dj = 4 * (i & 1) + q, dc = dc0 + dj; const float bv = tbl[(i >> 1) * 64 + dj];
                    const float mk = (dc >= lo && dc <= lo + 15) ? 0.f : -1e30f; const float v = (S[i][q] + bv) + mk; S[i][q] = v; mx = fmaxf(mx, v); } }
        else {
#pragma unroll
            for (int i = 0; i < 16; ++i)
#pragma unroll
                for (int q = 0; q < 4; ++q) mx = fmaxf(mx, S[i][q]); }
        mx = rows_max4(mx);
        float sum = 0.f; bf16x8 pf[8];
#pragma unroll
        for (int Gk = 0; Gk < 8; ++Gk) { float e[8];
#pragma unroll
            for (int t = 0; t < 2; ++t)
#pragma unroll
                for (int q = 0; q < 4; ++q) { e[t * 4 + q] = __expf(S[2 * Gk + t][q] - mx); sum += e[t * 4 + q]; }
            u32x4 w; w.x = pk2(e[0], e[1]); w.y = pk2(e[2], e[3]); w.z = pk2(e[4], e[5]); w.w = pk2(e[6], e[7]);
            pf[Gk] = __builtin_bit_cast(bf16x8, w); }
        sum = rows_sum4(sum);
        bf16x8 vc[16];
#pragma unroll
        for (int i = 0; i < 16; ++i) vc[i] = *(const bf16x8*)(vb + (2 + (i >> 3)) * VMS + (i & 7) * VGS);
        __builtin_amdgcn_sched_barrier(0);
        f32x4 O[4];
#pragma unroll
        for (int mt = 0; mt < 2; ++mt) { O[mt] = (f32x4){0.f, 0.f, 0.f, 0.f};
#pragma unroll
            for (int Gk = 0; Gk < 8; ++Gk) O[mt] = __builtin_amdgcn_mfma_f32_16x16x32_bf16(va[mt * 8 + Gk], pf[Gk], O[mt], 0, 0, 0); }
#pragma unroll
        for (int mt = 0; mt < 2; ++mt) { O[2 + mt] = (f32x4){0.f, 0.f, 0.f, 0.f};
#pragma unroll
            for (int Gk = 0; Gk < 8; ++Gk) O[2 + mt] = __builtin_amdgcn_mfma_f32_16x16x32_bf16(vc[mt * 8 + Gk], pf[Gk], O[2 + mt], 0, 0, 0); }
        const float inv = 1.0f / sum; bf16_t* yo = y + (size_t)(tok0 + fr) * D + (NA ? 512 : 768) + head * 64 + 4 * g;
#pragma unroll
        for (int mt = 0; mt < 4; ++mt) { u32x2 w; w.x = pk2(O[mt][0] * inv, O[mt][1] * inv); w.y = pk2(O[mt][2] * inv, O[mt][3] * inv); *(u32x2*)(yo + 16 * mt) = w; }
    }
    if (NA) __syncthreads();
}


__device__ __forceinline__ void ph_na_lds(const Params& p, int l, LAS unsigned char* lds, const int tid, int G, int bid) {
    GAS unsigned char* ws_ = (GAS unsigned char*)p.ws; LAUNDER_S(ws_);
    const GAS bf16_t* nrm = (const GAS bf16_t*)(ws_ + WS_NRM); const GAS bf16_t* nvt = (const GAS bf16_t*)(ws_ + WS_NVT); GAS bf16_t* y = (GAS bf16_t*)(ws_ + WS_Y);
    LAS unsigned char* kl = lds + LDS_SCR; LAS unsigned char* vl = kl + 8 * 64 * 144; LAS float* tb = (LAS float*)(vl + 64 * 1040);
#pragma unroll 1
    for (int unit = bid; unit < BATCH * 4 * 8; unit += G) {
        int tid_ = tid; LAUNDER_V(tid_);
        const int lane = tid_ & 63, wave = __builtin_amdgcn_readfirstlane(tid_ >> 6), fr = lane & 15, g = lane >> 4;
        const int band = unit & 7, head = (unit >> 3) & 3, b = unit >> 5, r0 = band * 8, rs0 = min(max(r0 - 4, 0), 56);
        const GAS bf16_t* kg = nrm + (size_t)(b * SEQ) * 768 + 256 + head * 64;
        const GAS bf16_t* vg = nvt + (size_t)((b * 4 + head) * 64) * SEQ;
        __syncthreads();
        { const GAS float* rpb = (const GAS float*)(p.na_rpb + ((size_t)l * 4 + head) * 15 * 31);
          float tbv[2];
#pragma unroll
          for (int j = 0; j < 2; ++j) { const int i = tid_ + 512 * j, dcp = (i & 63) - 16; tbv[j] = (i < 15 * 64 && dcp >= 0 && dcp < 31) ? rpb[(i >> 6) * 31 + dcp] : 0.f; }
#pragma unroll
          for (int j = 0; j < 2; ++j) { const int i = tid_ + 512 * j; if (i < 15 * 64) tb[i] = tbv[j]; }
#pragma unroll
          for (int hb = 0; hb < 2; ++hb) { u32x4 tk[4], tv[4];
#pragma unroll
              for (int i = 0; i < 4; ++i) { const int idx = tid_ + 512 * (4 * hb + i), row = idx >> 9, rem = idx & 511, gr = rs0 + row;
                  tk[i] = *(const GAS u32x4*)(kg + (size_t)(gr * 64 + (rem >> 3)) * 768 + (rem & 7) * 8); tv[i] = *(const GAS u32x4*)(vg + (size_t)gr * 4096 + rem * 8); }
#pragma unroll
              for (int i = 0; i < 4; ++i) { const int idx = tid_ + 512 * (4 * hb + i), row = idx >> 9, rem = idx & 511, sl = (rs0 + row) & 7;
                  *(LAS u32x4*)(kl + (sl * 64 + (rem >> 3)) * 144 + (rem & 7) * 16) = tk[i]; *(LAS u32x4*)(vl + (rem >> 3) * 1040 + sl * 128 + (rem & 7) * 16) = tv[i]; } } }
        u32x4 ka_[2], va_[2], kb_[2], vb_[2];
#define NA_NEED(r_) (((r_) + 1 < r0 + 8) && (min(max((r_) - 3, 0), 56) != min(max((r_) - 4, 0), 56)))
#define NA_LOADROW(kk, vv, gn_) do { const int t2 = tid_ - 256; _Pragma("unroll") for (int i = 0; i < 2; ++i) { const int rem = t2 + 256 * i; kk[i] = *(const GAS u32x4*)(kg + (size_t)((gn_) * 64 + (rem >> 3)) * 768 + (rem & 7) * 8); vv[i] = *(const GAS u32x4*)(vg + (size_t)(gn_) * 4096 + rem * 8); } } while (0)
#define NA_STOREROW(kk, vv, gn_) do { const int t2 = tid_ - 256, sl = (gn_) & 7; _Pragma("unroll") for (int i = 0; i < 2; ++i) { const int rem = t2 + 256 * i; *(LAS u32x4*)(kl + (sl * 64 + (rem >> 3)) * 144 + (rem & 7) * 16) = kk[i]; *(LAS u32x4*)(vl + (rem >> 3) * 1040 + sl * 128 + (rem & 7) * 16) = vv[i]; } } while (0)
        if (wave >= 4 && NA_NEED(r0)) NA_LOADROW(ka_, va_, rs0 + 8);
        __syncthreads();
        auto na_row = [&](const int r, u32x4 (&lk)[2], u32x4 (&lv)[2], const u32x4 (&sk)[2], const u32x4 (&sv)[2]) __attribute__((always_inline)) {
            const int rs = min(max(r - 4, 0), 56);
            if (wave >= 4) { const int r1 = r + 1; if (NA_NEED(r1)) { const int gn1 = min(max(r1 - 4, 0), 56) + 8; NA_LOADROW(lk, lv, gn1); } }
            else {
                const int seg = wave, tok0 = b * SEQ + r * 64 + seg * 16, kc0 = min(max(seg * 16 - 8, 0), 32);
                const GAS bf16_t* qp = nrm + (size_t)(tok0 + fr) * 768 + head * 64 + 8 * g;
                const bf16x8 qf0 = *(const GAS bf16x8*)qp, qf1 = *(const GAS bf16x8*)(qp + 32);
                const int jj0 = 8 * (fr >> 2) + (fr & 3);
                f32x4 S[16];
                { bf16x8 kfr[16][2];
#pragma unroll
                  for (int i = 0; i < 16; ++i) { const int sl = (rs + (i >> 1)) & 7; const LAS unsigned char* ka = kl + (sl * 64 + kc0 + jj0 + 4 * (i & 1)) * 144 + 16 * g; kfr[i][0] = *(const LAS bf16x8*)ka; kfr[i][1] = *(const LAS bf16x8*)(ka + 64); }
                  __builtin_amdgcn_sched_barrier(0);
#pragma unroll
                  for (int i = 0; i < 16; ++i) { f32x4 z = {0.f, 0.f, 0.f, 0.f}; z = __builtin_amdgcn_mfma_f32_16x16x32_bf16(kfr[i][0], qf0, z, 0, 0, 0); S[i] = __builtin_amdgcn_mfma_f32_16x16x32_bf16(kfr[i][1], qf1, z, 0, 0, 0); } }
                float mx = -1e30f;
                { const int c = seg * 16 + fr, lo = min(max(c - 8, 0), 48) - c, dc0 = kc0 + 8 * g - c; const LAS float* tbl = tb + (rs - r + 7) * 64 + dc0 + 31;
                  float bvv[16][4];
#pragma unroll
                  for (int i = 0; i < 16; ++i)
#pragma unroll
                      for (int q = 0; q < 4; ++q) bvv[i][q] = tbl[(i >> 1) * 64 + 4 * (i & 1) + q];
                  __builtin_amdgcn_sched_barrier(0);
#pragma unroll
                  for (int i = 0; i < 16; ++i)
#pragma unroll
                      for (int q = 0; q < 4; ++q) { const int dj = 4 * (i & 1) + q, dc = dc0 + dj; const float bv = bvv[i][q];
                          const float mk = (dc >= lo && dc <= lo + 15) ? 0.f : -1e30f; const float v = (S[i][q] + bv) + mk; S[i][q] = v; mx = fmaxf(mx, v); } }
                mx = rows_max4(mx);
                float sum = 0.f; bf16x8 pf[8];
#pragma unroll
                for (int Gk = 0; Gk < 8; ++Gk) { float e[8];
#pragma unroll
                    for (int t = 0; t < 2; ++t)
#pragma unroll
                        for (int q = 0; q < 4; ++q) { e[t * 4 + q] = __expf(S[2 * Gk + t][q] - mx); sum += e[t * 4 + q]; }
                    u32x4 w; w.x = pk2(e[0], e[1]); w.y = pk2(e[2], e[3]); w.z = pk2(e[4], e[5]); w.w = pk2(e[6], e[7]); pf[Gk] = __builtin_bit_cast(bf16x8, w); }
                sum = rows_sum4(sum);
                const bool y8 = l >= Y8_FROM; const float inv = (y8 ? 8.0f : 1.0f) / sum; GAS bf16_t* yo = y + (size_t)(tok0 + fr) * D + 512 + head * 64 + 4 * g; GAS unsigned char* yo8 = (GAS unsigned char*)y + (size_t)(tok0 + fr) * D + 512 + head * 64 + 4 * g;
#pragma unroll
                for (int hv = 0; hv < 2; ++hv) { bf16x8 vfr[16];
#pragma unroll
                    for (int i = 0; i < 16; ++i) vfr[i] = *(const LAS bf16x8*)(vl + (16 * (2 * hv + (i >> 3)) + fr) * 1040 + ((rs + (i & 7)) & 7) * 128 + 2 * (kc0 + 8 * g));
                    __builtin_amdgcn_sched_barrier(0);
#pragma unroll
                    for (int m2 = 0; m2 < 2; ++m2) { f32x4 O = {0.f, 0.f, 0.f, 0.f};
#pragma unroll
                        for (int Gk = 0; Gk < 8; ++Gk) O = __builtin_amdgcn_mfma_f32_16x16x32_bf16(vfr[m2 * 8 + Gk], pf[Gk], O, 0, 0, 0);
                        if (y8) *(GAS unsigned*)(yo8 + 16 * (2 * hv + m2)) = pg8::pk4_fp8(O[0] * inv, O[1] * inv, O[2] * inv, O[3] * inv);
                        else { u32x2 w; w.x = pk2(O[0] * inv, O[1] * inv); w.y = pk2(O[2] * inv, O[3] * inv); *(GAS u32x2*)(yo + 16 * (2 * hv + m2)) = w; } } }
            }
            __syncthreads();
            if (wave >= 4 && NA_NEED(r)) { const int gn = rs + 8; NA_STOREROW(sk, sv, gn); }
            __syncthreads();
        };
#pragma unroll 1
        for (int r = r0; r < r0 + 8; r += 2) { na_row(r, kb_, vb_, ka_, va_); na_row(r + 1, ka_, va_, kb_, vb_); }
    }
}

__device__ __forceinline__ void ph_cross_lds(const Params& p, int l, LAS unsigned char* lds, const int tid, int G, int bid) {
    GAS unsigned char* ws_ = (GAS unsigned char*)p.ws; LAUNDER_S(ws_);
    const GAS bf16_t* nrm = (const GAS bf16_t*)(ws_ + WS_NRM); const GAS bf16_t* kmn = (const GAS bf16_t*)(ws_ + WS_KMN); const GAS bf16_t* vmt = (const GAS bf16_t*)(ws_ + WS_VMT); GAS bf16_t* y = (GAS bf16_t*)(ws_ + WS_Y);
    LAS unsigned char* kl = lds + LDS_SCR; LAS unsigned char* vl = kl + 256 * 144;
#pragma unroll 1
    for (int unit = bid; unit < BATCH * 4 * 8; unit += G) {
        int tid_ = tid; LAUNDER_V(tid_);
        const int lane = tid_ & 63, wave = __builtin_amdgcn_readfirstlane(tid_ >> 6), fr = lane & 15, g = lane >> 4;
        const int qc = unit & 7, head = (unit >> 3) & 3, b = unit >> 5;
        __syncthreads();
        { u32x4 tk[4], tv[4];
#pragma unroll
          for (int i = 0; i < 4; ++i) { const int idx = tid_ + 512 * i, rho = idx >> 3, c = idx & 7, key = (rho & ~31) + 8 * ((rho & 15) >> 2) + 4 * ((rho >> 4) & 1) + (rho & 3);
              tk[i] = *(const GAS u32x4*)(kmn + (size_t)((l * BATCH + b) * NMEM + key) * 256 + head * 64 + c * 8);
              const int dh = idx >> 5, cv = idx & 31; tv[i] = *(const GAS u32x4*)(vmt + ((size_t)(((l * BATCH + b) * 4 + head) * 64 + dh)) * NMEM + cv * 8); }
#pragma unroll
          for (int i = 0; i < 4; ++i) { const int idx = tid_ + 512 * i; *(LAS u32x4*)(kl + (idx >> 3) * 144 + (idx & 7) * 16) = tk[i]; *(LAS u32x4*)(vl + (idx >> 5) * 528 + (idx & 31) * 16) = tv[i]; } }
        __syncthreads();
#pragma unroll 1
        for (int ti = 0; ti < 4; ++ti) {
            const int tok0 = b * SEQ + qc * 512 + (wave * 4 + ti) * 16;
            const GAS bf16_t* qp = nrm + (size_t)(tok0 + fr) * 768 + 512 + head * 64 + 8 * g;
            const bf16x8 qf0 = *(const GAS bf16x8*)qp, qf1 = *(const GAS bf16x8*)(qp + 32);
            f32x4 S[16]; float mx = -1e30f;
            { bf16x8 kfr[16][2];
#pragma unroll
              for (int i = 0; i < 16; ++i) { const LAS unsigned char* ka = kl + (16 * i + fr) * 144 + 16 * g; kfr[i][0] = *(const LAS bf16x8*)ka; kfr[i][1] = *(const LAS bf16x8*)(ka + 64); }
              __builtin_amdgcn_sched_barrier(0);
#pragma unroll
              for (int i = 0; i < 16; ++i) { f32x4 z = {0.f, 0.f, 0.f, 0.f}; z = __builtin_amdgcn_mfma_f32_16x16x32_bf16(kfr[i][0], qf0, z, 0, 0, 0); S[i] = __builtin_amdgcn_mfma_f32_16x16x32_bf16(kfr[i][1], qf1, z, 0, 0, 0); } }
#pragma unroll
            for (int i = 0; i < 16; ++i)
#pragma unroll
                for (int q = 0; q < 4; ++q) mx = fmaxf(mx, S[i][q]);
            mx = rows_max4(mx);
            float sum = 0.f; bf16x8 pf[8];
#pragma unroll
            for (int Gk = 0; Gk < 8; ++Gk) { float e[8];
#pragma unroll
                for (int t = 0; t < 2; ++t)
#pragma unroll
                    for (int q = 0; q < 4; ++q) { e[t * 4 + q] = __expf(S[2 * Gk + t][q] - mx); sum += e[t * 4 + q]; }
                u32x4 w; w.x = pk2(e[0], e[1]); w.y = pk2(e[2], e[3]); w.z = pk2(e[4], e[5]); w.w = pk2(e[6], e[7]); pf[Gk] = __builtin_bit_cast(bf16x8, w); }
            sum = rows_sum4(sum);
            const bool y8 = l >= Y8_FROM; const float inv = (y8 ? 8.0f : 1.0f) / sum; GAS bf16_t* yo = y + (size_t)(tok0 + fr) * D + 768 + head * 64 + 4 * g; GAS unsigned char* yo8 = (GAS unsigned char*)y + (size_t)(tok0 + fr) * D + 768 + head * 64 + 4 * g;
#pragma unroll
            for (int hv = 0; hv < 2; ++hv) { bf16x8 vfr[16];
#pragma unroll
                for (int i = 0; i < 16; ++i) vfr[i] = *(const LAS bf16x8*)(vl + (16 * (2 * hv + (i >> 3)) + fr) * 528 + 16 * (4 * (i & 7) + g));
                __builtin_amdgcn_sched_barrier(0);
#pragma unroll
                for (int m2 = 0; m2 < 2; ++m2) { f32x4 O = {0.f, 0.f, 0.f, 0.f};
#pragma unroll
                    for (int Gk = 0; Gk < 8; ++Gk) O = __builtin_amdgcn_mfma_f32_16x16x32_bf16(vfr[m2 * 8 + Gk], pf[Gk], O, 0, 0, 0);
                    if (y8) *(GAS unsigned*)(yo8 + 16 * (2 * hv + m2)) = pg8::pk4_fp8(O[0] * inv, O[1] * inv, O[2] * inv, O[3] * inv);
                    else { u32x2 w; w.x = pk2(O[0] * inv, O[1] * inv); w.y = pk2(O[2] * inv, O[3] * inv); *(GAS u32x2*)(yo + 16 * (2 * hv + m2)) = w; } } }
        }
    }
    __syncthreads();
}

__device__ __forceinline__ float logsigmoidf_(float x) { return x >= 0.f ? -__logf(1.0f + __expf(-x)) : x - __logf(1.0f + __expf(x)); }
#define DPPS(old_, v_, ctrl_, rmask_, bc_) __int_as_float(__builtin_amdgcn_update_dpp(__float_as_int(old_), __float_as_int(v_), (ctrl_), (rmask_), 0xF, (bc_)))
__device__ __forceinline__ float wave_iscan_add(float v) {
    v += DPPS(0.f, v, 0x111, 0xF, true); v += DPPS(0.f, v, 0x112, 0xF, true); v += DPPS(0.f, v, 0x114, 0xF, true); v += DPPS(0.f, v, 0x118, 0xF, true);
    v += DPPS(0.f, v, 0x142, 0xA, true); v += DPPS(0.f, v, 0x143, 0xC, true); return v; }
__device__ __forceinline__ float wave_iscan_max(float v) {
    const float ninf = -3.0e38f;
    v = fmaxf(v, DPPS(ninf, v, 0x111, 0xF, false)); v = fmaxf(v, DPPS(ninf, v, 0x112, 0xF, false)); v = fmaxf(v, DPPS(ninf, v, 0x114, 0xF, false)); v = fmaxf(v, DPPS(ninf, v, 0x118, 0xF, false));
    v = fmaxf(v, DPPS(ninf, v, 0x142, 0xA, false)); v = fmaxf(v, DPPS(ninf, v, 0x143, 0xC, false)); return v; }
__device__ __forceinline__ void conv8(const bf16_t* proj, const float* cw, int tok, int sg, int c0, float (&a)[8]) {
#pragma unroll
    for (int q = 0; q < 8; ++q) a[q] = 0.f;
#pragma unroll
    for (int j = 0; j < 5; ++j) { const int sj = sg + j - 2; if (sj >= 0 && sj < SEQ) { const u32x4 w = *(const u32x4*)(proj + (size_t)(tok + j - 2) * NPROJ + c0); const f32x4 w0 = *(const f32x4*)(cw + j * 512 + c0), w1 = *(const f32x4*)(cw + j * 512 + c0 + 4);
            a[0] += bflo(w.x) * w0.x; a[1] += bfhi(w.x) * w0.y; a[2] += bflo(w.y) * w0.z; a[3] += bfhi(w.y) * w0.w; a[4] += bflo(w.z) * w1.x; a[5] += bfhi(w.z) * w1.y; a[6] += bflo(w.w) * w1.z; a[7] += bfhi(w.w) * w1.w; } }
#pragma unroll
    for (int q = 0; q < 8; ++q) a[q] = a[q] * sigmoidf_(a[q]);
}
__device__ __forceinline__ void ph_mlstm_a(const Params& p, int l, LAS unsigned char* lds, const int tid, int G, int bid) {
    GAS unsigned char* ws_ = (GAS unsigned char*)p.ws; LAUNDER_S(ws_);
    LAS float* wf = (LAS float*)(lds + LDS_SCR); LAS float* wb = wf + 128; LAS bf16_t* kwt = (LAS bf16_t*)(lds + LDS_SCR + 1024);
    constexpr int NIT = BATCH * 4 * 32;
    u32x4 nxr[8]; bf16x8 nbv[4]; float ngq[8]; f32x4 wq[5][2]; int hw = -1;
#define MA_LOAD(item_, xr_, bv_, gq_) do { int t__ = tid; LAUNDER_V(t__); GAS unsigned char* w__ = ws_; LAUNDER_S(w__); const int itr_ = NIT - 1 - (item_), chunk_ = itr_ & 31, h_ = (itr_ >> 5) & 3, b_ = itr_ >> 7; \
        const int slot_ = t__ & 31, cg_ = t__ >> 5, ch_ = ((cg_ >> 3) ? C_MK : C_MQ) + h_ * 64 + (cg_ & 7) * 8, ln_ = t__ & 63, wv_ = __builtin_amdgcn_readfirstlane(t__ >> 6); \
        const GAS bf16_t* pj_ = (const GAS bf16_t*)(w__ + WS_PROJ); \
        _Pragma("unroll") for (int r = 0; r < 8; ++r) { const int sg = chunk_ * 128 + 4 * slot_ - 2 + r, sc = min(max(sg, 0), SEQ - 1); xr_[r] = *(const GAS u32x4*)(pj_ + (size_t)(b_ * SEQ + sc) * NPROJ + ch_); } \
        { const GAS bf16_t* vp = (const GAS bf16_t*)(w__ + WS_VT) + ((size_t)(((b_ * 4 + h_) * 32 + chunk_) * 128 + 16 * wv_ + (ln_ & 15))) * 128 + 8 * (ln_ >> 4);        \
          _Pragma("unroll") for (int ks = 0; ks < 4; ++ks) bv_[ks] = *(const GAS bf16x8*)(vp + 32 * ks); } \
        if (wv_ == 0) { const GAS float* gp = (const GAS float*)(w__ + WS_GATES) + (size_t)(b_ * SEQ + chunk_ * 128 + 2 * ln_) * 16 + h_; \
          _Pragma("unroll") for (int q = 0; q < 8; ++q) gq_[q] = gp[4 * q]; } } while (0)
    if (bid < NIT) MA_LOAD(bid, nxr, nbv, ngq);
#pragma unroll 1
    for (int item = bid; item < NIT; item += G) {
        GAS unsigned char* wsl = ws_; LAUNDER_S(wsl); int tid_ = tid; LAUNDER_V(tid_);
        const int lane = tid_ & 63, wave = __builtin_amdgcn_readfirstlane(tid_ >> 6), fr = lane & 15, g = lane >> 4;
        GAS bf16_t* qkc = (GAS bf16_t*)(wsl + WS_QKC);
        GAS float* mkv = (GAS float*)(wsl + WS_MKV); GAS float* mn = (GAS float*)(wsl + WS_MN); GAS float* cst = (GAS float*)(wsl + WS_MCST); GAS float* gst = (GAS float*)(wsl + WS_MGST); const GAS float* cw = (const GAS float*)(p.conv_qk + (size_t)l * 5 * 512);
        const int itr = NIT - 1 - item;
        const int chunk = itr & 31, h = (itr >> 5) & 3, b = itr >> 7, tokb = b * SEQ + chunk * 128, ccf = ((b * 4 + h) * 2) * 32 + chunk, ccb = ccf + 32;
        const int slot = tid_ & 31, cg = tid_ >> 5, isk = cg >> 3, ch0 = (isk ? C_MK : C_MQ) + h * 64 + (cg & 7) * 8;
        u32x4 xr[8]; bf16x8 bv[4]; float gq[8];
#pragma unroll
        for (int r = 0; r < 8; ++r) xr[r] = nxr[r];
#pragma unroll
        for (int ks = 0; ks < 4; ++ks) bv[ks] = nbv[ks];
#pragma unroll
        for (int q = 0; q < 8; ++q) gq[q] = ngq[q];
        if (h != hw) { hw = h;
#pragma unroll
            for (int tp = 0; tp < 5; ++tp) { wq[tp][0] = *(const GAS f32x4*)(cw + tp * 512 + ch0); wq[tp][1] = *(const GAS f32x4*)(cw + tp * 512 + ch0 + 4); } }
#pragma unroll
        for (int r = 0; r < 8; ++r) { const int sg = chunk * 128 + 4 * slot - 2 + r; if (sg < 0 || sg >= SEQ) xr[r] = (u32x4){0u, 0u, 0u, 0u}; }
        if (item + G < NIT) MA_LOAD(item + G, nxr, nbv, ngq);
        if (wave == 0) {
            const int t0 = 2 * lane;
            const float if0 = gq[0], ff0 = gq[1], ib0 = gq[2], fb0 = gq[3], if1 = gq[4], ff1 = gq[5], ib1 = gq[6], fb1 = gq[7];
            const float lf0 = logsigmoidf_(ff0), lf1 = logsigmoidf_(ff1), lb0 = logsigmoidf_(fb0), lb1 = logsigmoidf_(fb1);
            const float incf = wave_iscan_add(lf0 + lf1), incb = wave_iscan_add(lb0 + lb1);
            const float totf = __int_as_float(__builtin_amdgcn_readlane(__float_as_int(incf), 63)), totb = __int_as_float(__builtin_amdgcn_readlane(__float_as_int(incb), 63)), basef = incf - (lf0 + lf1), baseb = incb - (lb0 + lb1);
            const float bf0 = basef + lf0, bf1 = basef + lf0 + lf1, bb0 = totb - baseb, bb1 = totb - (baseb + lb0);
            const float uf0 = if0 - bf0, uf1 = if1 - bf1, ub0 = ib0 - bb0, ub1 = ib1 - bb1;
            const float incm = wave_iscan_max(fmaxf(uf0, uf1));
            const float incs = shb(wave_iscan_max(shb(fmaxf(ub0, ub1), 63 - lane)), 63 - lane);
            float exm = shu(incm, 1, lane), exs = shd(incs, 1, lane); if (lane == 0) exm = -3.0e38f; if (lane == 63) exs = -3.0e38f;
            const float pmf0 = fmaxf(exm, uf0), pmf1 = fmaxf(pmf0, uf1), pmb1 = fmaxf(exs, ub1), pmb0 = fmaxf(pmb1, ub0);
            const float maxuf = __int_as_float(__builtin_amdgcn_readlane(__float_as_int(incm), 63)), maxub = __int_as_float(__builtin_amdgcn_readlane(__float_as_int(incs), 0));
            *(LAS f32x2*)(wf + t0) = (f32x2){__expf(uf0 - maxuf), __expf(uf1 - maxuf)}; *(LAS f32x2*)(wb + t0) = (f32x2){__expf(ub0 - maxub), __expf(ub1 - maxub)};
            GAS float* gs = gst + (size_t)itr * 768 + t0;
            *(GAS f32x2*)(gs) = (f32x2){bf0, bf1}; *(GAS f32x2*)(gs + 128) = (f32x2){uf0, uf1}; *(GAS f32x2*)(gs + 256) = (f32x2){pmf0, pmf1};
            *(GAS f32x2*)(gs + 384) = (f32x2){bb0, bb1}; *(GAS f32x2*)(gs + 512) = (f32x2){ub0, ub1}; *(GAS f32x2*)(gs + 640) = (f32x2){pmb0, pmb1};
            if (lane == 0) { *(GAS f32x2*)(cst + 2 * ccf) = (f32x2){totf + maxuf, totf}; *(GAS f32x2*)(cst + 2 * ccb) = (f32x2){totb + maxub, totb}; }
        }
        float cv[4][8];
#pragma unroll
        for (int j = 0; j < 4; ++j) { float a[8];
#pragma unroll
            for (int q = 0; q < 8; ++q) a[q] = 0.f;
#pragma unroll
            for (int tp = 0; tp < 5; ++tp) { const u32x4 w = xr[j + tp]; const f32x4 w0 = wq[tp][0], w1 = wq[tp][1];
                a[0] += bflo(w.x) * w0.x; a[1] += bfhi(w.x) * w0.y; a[2] += bflo(w.y) * w0.z; a[3] += bfhi(w.y) * w0.w; a[4] += bflo(w.z) * w1.x; a[5] += bfhi(w.z) * w1.y; a[6] += bflo(w.w) * w1.z; a[7] += bfhi(w.w) * w1.w; }
            const float sc = isk ? 1.0f : 0.125f;
#pragma unroll
            for (int q = 0; q < 8; ++q) { a[q] = a[q] * sigmoidf_(a[q]); cv[j][q] = a[q]; }
            u32x4 o; o.x = pk2(a[0] * sc, a[1] * sc); o.y = pk2(a[2] * sc, a[3] * sc); o.z = pk2(a[4] * sc, a[5] * sc); o.w = pk2(a[6] * sc, a[7] * sc);
            *(GAS u32x4*)(qkc + (size_t)(tokb + 4 * slot + j) * 512 + isk * 256 + h * 64 + (cg & 7) * 8) = o; }
        __syncthreads();
        if (isk) { const int kc = (cg & 7) * 8; const f32x4 wf4 = *(const LAS f32x4*)(wf + 4 * slot), wb4 = *(const LAS f32x4*)(wb + 4 * slot);
#pragma unroll
            for (int jp = 0; jp < 2; ++jp) { const float wfa = wf4[2 * jp], wfb = wf4[2 * jp + 1], wba = wb4[2 * jp], wbb = wb4[2 * jp + 1];
#pragma unroll
                for (int q = 0; q < 8; ++q) { LAS unsigned* kf = (LAS unsigned*)(kwt + (kc + q) * 136 + 4 * slot + 2 * jp); LAS unsigned* kb = (LAS unsigned*)(kwt + 64 * 136 + (kc + q) * 136 + 4 * slot + 2 * jp);
                    *kf = pk2(cv[2 * jp][q] * wfa, cv[2 * jp + 1][q] * wfb); *kb = pk2(cv[2 * jp][q] * wba, cv[2 * jp + 1][q] * wbb); } } }
        __syncthreads();
        {
#pragma unroll
            for (int dir = 0; dir < 2; ++dir) { GAS bf16_t* outp = (GAS bf16_t*)mkv + ((size_t)(dir ? ccb : ccf) * 128 + 16 * wave + fr) * 64 + 4 * g;
                bf16x8 af[16];
#pragma unroll
                for (int i = 0; i < 16; ++i) af[i] = *(const LAS bf16x8*)(kwt + dir * 64 * 136 + (16 * (i >> 2) + fr) * 136 + 32 * (i & 3) + 8 * g);
                __builtin_amdgcn_sched_barrier(0);
#pragma unroll
                for (int mt = 0; mt < 4; ++mt) { f32x4 acc = {0.f, 0.f, 0.f, 0.f};
#pragma unroll
                    for (int ks = 0; ks < 4; ++ks) acc = __builtin_amdgcn_mfma_f32_16x16x32_bf16(af[mt * 4 + ks], bv[ks], acc, 0, 0, 0);
                    u32x2 w; w.x = pk2c(acc[0], acc[1]); w.y = pk2c(acc[2], acc[3]); *(GAS u32x2*)(outp + 16 * mt) = w; } }
            if (tid_ < 128) { const int dir = tid_ >> 6, dk = tid_ & 63; float sm = 0.f;
#pragma unroll
                for (int c8 = 0; c8 < 16; ++c8) { const u32x4 w4 = *(const LAS u32x4*)(kwt + dir * 64 * 136 + dk * 136 + 8 * c8); sm += (bflo(w4.x) + bfhi(w4.x)) + (bflo(w4.y) + bfhi(w4.y)) + (bflo(w4.z) + bfhi(w4.z)) + (bflo(w4.w) + bfhi(w4.w)); }
                mn[(size_t)(dir ? ccb : ccf) * 64 + dk] = sm; }
        }
        __syncthreads();
    }
}
__device__ __forceinline__ void ph_mlstm_scan(const Params& p, int gtid, int gsz) {
    GAS unsigned char* ws_ = (GAS unsigned char*)p.ws; LAUNDER_S(ws_);
    const GAS bf16_t* mkv = (const GAS bf16_t*)(ws_ + WS_MKV); const GAS float* mn = (const GAS float*)(ws_ + WS_MN); const GAS float* cst = (const GAS float*)(ws_ + WS_MCST);
    GAS bf16_t* mcp = (GAS bf16_t*)(ws_ + WS_MCP); GAS float* mnp = (GAS float*)(ws_ + WS_MNP); GAS float* mmp = (GAS float*)(ws_ + WS_MMP);
    if ((gtid & 511) < 16) {
#pragma unroll 1
        for (int ni = (gtid >> 9) * 16 + (gtid & 511); ni < 64 * 64; ni += (gsz >> 9) * 16) {
            const int chain = ni >> 6, dk = ni & 63, dir = chain & 1; float n = 0.f, m = 0.f;
#pragma unroll 1
            for (int hb = 0; hb < 2; ++hb) { float ncv[16]; f32x2 ag[16];
#pragma unroll
                for (int i = 0; i < 16; ++i) { const int ci = 16 * hb + i, c = dir ? 31 - ci : ci; const size_t cc = (size_t)chain * 32 + c; ncv[i] = mn[cc * 64 + dk]; ag[i] = *(const GAS f32x2*)(cst + 2 * cc); }
#pragma unroll
                for (int i = 0; i < 16; ++i) { const int ci = 16 * hb + i, c = dir ? 31 - ci : ci; const size_t cc = (size_t)chain * 32 + c;
                    mnp[cc * 64 + dk] = n; if (dk == 0) mmp[cc] = m;
                    const float mnew = fmaxf(ag[i].y + m, ag[i].x), sp = __expf(ag[i].y + m - mnew), sc = __expf(ag[i].x - mnew);
                    n = n * sp + ncv[i] * sc; m = mnew; } }
        }
    }
#pragma unroll 1
    for (int idx = gtid; idx < 64 * 128 * 16; idx += gsz) {
        const int dkq = idx & 15, dv = (idx >> 4) & 127, chain = idx >> 11, dir = chain & 1;
        f32x4 C = {0.f, 0.f, 0.f, 0.f}; float m = 0.f;
#pragma unroll 1
        for (int hb = 0; hb < 2; ++hb) {
            u32x2 kvw[16]; f32x2 ag[16];
#pragma unroll
            for (int i = 0; i < 16; ++i) { const int ci = 16 * hb + i, c = dir ? 31 - ci : ci; const size_t cc = (size_t)chain * 32 + c; kvw[i] = *(const GAS u32x2*)(mkv + (cc * 128 + dv) * 64 + dkq * 4); ag[i] = *(const GAS f32x2*)(cst + 2 * cc); }
#pragma unroll
            for (int i = 0; i < 16; ++i) { const int ci = 16 * hb + i, c = dir ? 31 - ci : ci; const size_t cc = (size_t)chain * 32 + c;
                u32x2 w; w.x = pk2(C[0], C[1]); w.y = pk2(C[2], C[3]); *(GAS u32x2*)(mcp + (cc * 128 + dv) * 64 + dkq * 4) = w;
                const float mnew = fmaxf(ag[i].y + m, ag[i].x), sp = __expf(ag[i].y + m - mnew), sc = __expf(ag[i].x - mnew);
                const f32x4 kv = {bflo(kvw[i].x), bfhi(kvw[i].x), bflo(kvw[i].y), bfhi(kvw[i].y)};
                C = C * sp + kv * sc; m = mnew; }
        }
    }
}
__device__ __forceinline__ void ph_mlstm_c(const Params& p, int l, LAS unsigned char* lds, const int tid, int G, int bid) {
    GAS unsigned char* ws_ = (GAS unsigned char*)p.ws; LAUNDER_S(ws_);
    LAS unsigned char* kl = lds + LDS_SCR; LAS unsigned char* vl = kl + 128 * 144; LAS unsigned char* cfl = vl + 128 * 272; LAS unsigned char* cbl = cfl + 128 * 144; LAS float* ugl = (LAS float*)(cbl + 128 * 144);
#pragma unroll 1
    for (int item = bid; item < BATCH * 4 * 32; item += G) {
        GAS unsigned char* wsl = ws_; LAUNDER_S(wsl);
        int tid_ = tid; LAUNDER_V(tid_);
        const int lane = tid_ & 63, wave = __builtin_amdgcn_readfirstlane(tid_ >> 6), fr = lane & 15, g = lane >> 4;
        const GAS bf16_t* proj = (const GAS bf16_t*)(wsl + WS_PROJ); const GAS bf16_t* qkc = (const GAS bf16_t*)(wsl + WS_QKC); const GAS bf16_t* vt = (const GAS bf16_t*)(wsl + WS_VT); const GAS bf16_t* mcp = (const GAS bf16_t*)(wsl + WS_MCP);
        const GAS float* mnp = (const GAS float*)(wsl + WS_MNP); const GAS float* mmp = (const GAS float*)(wsl + WS_MMP); const GAS float* gst = (const GAS float*)(wsl + WS_MGST); GAS bf16_t* y = (GAS bf16_t*)(wsl + WS_Y);
        const int chunk = item & 31, h = (item >> 5) & 3, b = item >> 7, tokb = b * SEQ + chunk * 128, t = 16 * wave + fr, tq = tokb + t;
        const size_t ccf = (size_t)((b * 4 + h) * 2) * 32 + chunk, ccb = ccf + 32;
        const GAS bf16_t* qp = qkc + (size_t)tq * 512 + h * 64 + 8 * g;
        const u32x4 q0 = *(const GAS u32x4*)qp, q1 = *(const GAS u32x4*)(qp + 32);
        const GAS float* gs = gst + (size_t)item * 768;
        const float bfw = gs[t], pmf = gs[256 + t], bbw = gs[384 + t], pmb = gs[640 + t], mpf = mmp[ccf], mpb = mmp[ccb];
        f32x4 npf[4], npb[4];
#pragma unroll
        for (int i = 0; i < 4; ++i) { npf[i] = *(const GAS f32x4*)(mnp + ccf * 64 + 32 * (i >> 1) + 8 * g + 4 * (i & 1)); npb[i] = *(const GAS f32x4*)(mnp + ccb * 64 + 32 * (i >> 1) + 8 * g + 4 * (i & 1)); }
        unsigned ogw[8];
        { const GAS unsigned char* op = (const GAS unsigned char*)(wsl + WS_OG) + (size_t)tq * 512 + h * 128 + 4 * g;
#pragma unroll
          for (int mt = 0; mt < 8; ++mt) ogw[mt] = *(const GAS unsigned*)(op + 16 * mt); }
        __syncthreads();
        { u32x4 tk[2], tv[4], tf[2], tb[2];
#pragma unroll
          for (int i = 0; i < 2; ++i) { const int idx = tid_ + 512 * i, rho = idx >> 3, c = idx & 7, key = (rho & ~31) + 8 * ((rho & 15) >> 2) + 4 * ((rho >> 4) & 1) + (rho & 3);
              tk[i] = *(const GAS u32x4*)(qkc + (size_t)(tokb + key) * 512 + 256 + h * 64 + c * 8);
              tf[i] = *(const GAS u32x4*)(mcp + (ccf * 128 + rho) * 64 + c * 8); tb[i] = *(const GAS u32x4*)(mcp + (ccb * 128 + rho) * 64 + c * 8); }
#pragma unroll
          for (int i = 0; i < 4; ++i) { const int idx = tid_ + 512 * i, dv = idx >> 4, c = idx & 15; tv[i] = *(const GAS u32x4*)(vt + ((size_t)(((b * 4 + h) * 32 + chunk) * 128 + dv)) * 128 + c * 8); }
          f32x4 ugv = {0.f, 0.f, 0.f, 0.f};
          if (tid_ < 64) { const GAS float* gsu = gst + (size_t)item * 768 + (tid_ < 32 ? 128 : 512 - 128) + 4 * tid_; ugv = *(const GAS f32x4*)gsu; }
#pragma unroll
          for (int i = 0; i < 2; ++i) { const int idx = tid_ + 512 * i, rho = idx >> 3, c = idx & 7; *(LAS u32x4*)(kl + rho * 144 + c * 16) = tk[i]; *(LAS u32x4*)(cfl + rho * 144 + c * 16) = tf[i]; *(LAS u32x4*)(cbl + rho * 144 + c * 16) = tb[i]; }
#pragma unroll
          for (int i = 0; i < 4; ++i) { const int idx = tid_ + 512 * i; *(LAS u32x4*)(vl + (idx >> 4) * 272 + (idx & 15) * 16) = tv[i]; }
          if (tid_ < 64) *(LAS f32x4*)(ugl + 4 * tid_) = ugv; }
        const float Mf = fmaxf(mpf, pmf), Mb = fmaxf(mpb, pmb), sif = __expf(mpf - Mf), sib = __expf(mpb - Mb), flf = __expf(-bfw - Mf), flb = __expf(-bbw - Mb);
        const float qv[16] = {bflo(q0.x), bfhi(q0.x), bflo(q0.y), bfhi(q0.y), bflo(q0.z), bfhi(q0.z), bflo(q0.w), bfhi(q0.w), bflo(q1.x), bfhi(q1.x), bflo(q1.y), bfhi(q1.y), bflo(q1.z), bfhi(q1.z), bflo(q1.w), bfhi(q1.w)};
        float qnf = 0.f, qnb = 0.f;
#pragma unroll
        for (int ks = 0; ks < 2; ++ks)
#pragma unroll
            for (int hf = 0; hf < 2; ++hf) { const f32x4 nf = npf[ks * 2 + hf], nb = npb[ks * 2 + hf];
#pragma unroll
                for (int q = 0; q < 4; ++q) { qnf += qv[ks * 8 + hf * 4 + q] * nf[q]; qnb += qv[ks * 8 + hf * 4 + q] * nb[q]; } }
        qnf = rows_sum4(qnf); qnb = rows_sum4(qnb);
        const bf16x8 qf0 = __builtin_bit_cast(bf16x8, q0), qf1 = __builtin_bit_cast(bf16x8, q1);
        __syncthreads();
        f32x4 scf[4][2], scb[4][2]; float rsf = 0.f, rsb = 0.f;
        bf16x8 kfr[8][2];
#pragma unroll
        for (int i = 0; i < 8; ++i) { const LAS unsigned char* ka = kl + (16 * i + fr) * 144 + 16 * g; kfr[i][0] = *(const LAS bf16x8*)ka; kfr[i][1] = *(const LAS bf16x8*)(ka + 64); }
        __builtin_amdgcn_sched_barrier(0);
#pragma unroll
        for (int Gk = 0; Gk < 4; ++Gk)
#pragma unroll
            for (int tt = 0; tt < 2; ++tt) {
                f32x4 z = {0.f, 0.f, 0.f, 0.f};
                z = __builtin_amdgcn_mfma_f32_16x16x32_bf16(kfr[2 * Gk + tt][0], qf0, z, 0, 0, 0); z = __builtin_amdgcn_mfma_f32_16x16x32_bf16(kfr[2 * Gk + tt][1], qf1, z, 0, 0, 0);
                const int s0 = 32 * Gk + 8 * g + 4 * tt; const f32x4 uf = *(const LAS f32x4*)(ugl + s0), ub = *(const LAS f32x4*)(ugl + 128 + s0);
#pragma unroll
                for (int q = 0; q < 4; ++q) { const int s = s0 + q; const float ef = __expf(s <= t ? uf[q] - Mf : -1e30f), eb = __expf(s >= t ? ub[q] - Mb : -1e30f);
                    scf[Gk][tt][q] = z[q] * ef; scb[Gk][tt][q] = z[q] * eb; rsf += scf[Gk][tt][q]; rsb += scb[Gk][tt][q]; } }
        rsf = rows_sum4(rsf); rsb = rows_sum4(rsb);
        const float invf = 1.0f / fmaxf(fabsf(sif * qnf + rsf), flf), invb = 1.0f / fmaxf(fabsf(sib * qnb + rsb), flb), cf = sif * invf, cb = sib * invb;
        bf16x8 pf[4], qff[2], qfb[2];
#pragma unroll
        for (int Gk = 0; Gk < 4; ++Gk) { float e[8];
#pragma unroll
            for (int tt = 0; tt < 2; ++tt)
#pragma unroll
                for (int q = 0; q < 4; ++q) e[tt * 4 + q] = scf[Gk][tt][q] * invf + scb[Gk][tt][q] * invb;
            u32x4 w; w.x = pk2(e[0], e[1]); w.y = pk2(e[2], e[3]); w.z = pk2(e[4], e[5]); w.w = pk2(e[6], e[7]); pf[Gk] = __builtin_bit_cast(bf16x8, w); }
#pragma unroll
        for (int ks = 0; ks < 2; ++ks) { u32x4 w;
            w.x = pk2(qv[ks * 8 + 0] * cf, qv[ks * 8 + 1] * cf); w.y = pk2(qv[ks * 8 + 2] * cf, qv[ks * 8 + 3] * cf); w.z = pk2(qv[ks * 8 + 4] * cf, qv[ks * 8 + 5] * cf); w.w = pk2(qv[ks * 8 + 6] * cf, qv[ks * 8 + 7] * cf); qff[ks] = __builtin_bit_cast(bf16x8, w);
            w.x = pk2(qv[ks * 8 + 0] * cb, qv[ks * 8 + 1] * cb); w.y = pk2(qv[ks * 8 + 2] * cb, qv[ks * 8 + 3] * cb); w.z = pk2(qv[ks * 8 + 4] * cb, qv[ks * 8 + 5] * cb); w.w = pk2(qv[ks * 8 + 6] * cb, qv[ks * 8 + 7] * cb); qfb[ks] = __builtin_bit_cast(bf16x8, w); }
        f32x4 O[8]; float ss = 0.f;
#pragma unroll
        for (int hv = 0; hv < 2; ++hv) {
            bf16x8 fa[4][8];
#pragma unroll
            for (int m2 = 0; m2 < 4; ++m2) { const int mt = 4 * hv + m2; const LAS unsigned char* va = vl + (16 * mt + fr) * 272 + 16 * g; const LAS unsigned char* fp = cfl + (16 * mt + fr) * 144 + 16 * g; const LAS unsigned char* bp = cbl + (16 * mt + fr) * 144 + 16 * g;
#pragma unroll
                for (int Gk = 0; Gk < 4; ++Gk) fa[m2][Gk] = *(const LAS bf16x8*)(va + 64 * Gk);
                fa[m2][4] = *(const LAS bf16x8*)fp; fa[m2][5] = *(const LAS bf16x8*)(fp + 64); fa[m2][6] = *(const LAS bf16x8*)bp; fa[m2][7] = *(const LAS bf16x8*)(bp + 64); }
            __builtin_amdgcn_sched_barrier(0);
#pragma unroll
            for (int m2 = 0; m2 < 4; ++m2) { f32x4 acc = {0.f, 0.f, 0.f, 0.f};
#pragma unroll
                for (int Gk = 0; Gk < 4; ++Gk) acc = __builtin_amdgcn_mfma_f32_16x16x32_bf16(fa[m2][Gk], pf[Gk], acc, 0, 0, 0);
                acc = __builtin_amdgcn_mfma_f32_16x16x32_bf16(fa[m2][4], qff[0], acc, 0, 0, 0); acc = __builtin_amdgcn_mfma_f32_16x16x32_bf16(fa[m2][5], qff[1], acc, 0, 0, 0);
                acc = __builtin_amdgcn_mfma_f32_16x16x32_bf16(fa[m2][6], qfb[0], acc, 0, 0, 0); acc = __builtin_amdgcn_mfma_f32_16x16x32_bf16(fa[m2][7], qfb[1], acc, 0, 0, 0);
                O[4 * hv + m2] = acc; ss += acc[0] * acc[0] + acc[1] * acc[1] + acc[2] * acc[2] + acc[3] * acc[3]; }
        }
        ss = rows_sum4(ss);
        const float rr = rsqrtf(ss * (1.0f / 128.0f) + EPS);
        const GAS float* gm = (const GAS float*)(p.g_mh + l * 512 + h * 128 + 4 * g); GAS bf16_t* yo = y + (size_t)tq * D + h * 128 + 4 * g; GAS unsigned char* yo8 = (GAS unsigned char*)y + (size_t)tq * D + h * 128 + 4 * g; const bool y8 = l >= Y8_FROM; const float rrs = y8 ? 8.0f * rr : rr;
        f32x4 gmv[8];
#pragma unroll
        for (int mt = 0; mt < 8; ++mt) gmv[mt] = *(const GAS f32x4*)(gm + 16 * mt);
#pragma unroll
        for (int mt = 0; mt < 8; ++mt) { const unsigned ow = ogw[mt]; const f32x4 gv = gmv[mt];
            const float o0 = sigmoidf_(0.125f * __builtin_amdgcn_cvt_f32_fp8(ow, 0)) * O[mt][0] * rrs * gv.x, o1 = sigmoidf_(0.125f * __builtin_amdgcn_cvt_f32_fp8(ow, 1)) * O[mt][1] * rrs * gv.y, o2 = sigmoidf_(0.125f * __builtin_amdgcn_cvt_f32_fp8(ow, 2)) * O[mt][2] * rrs * gv.z, o3 = sigmoidf_(0.125f * __builtin_amdgcn_cvt_f32_fp8(ow, 3)) * O[mt][3] * rrs * gv.w;
            if (y8) *(GAS unsigned*)(yo8 + 16 * mt) = pg8::pk4_fp8(o0, o1, o2, o3);
            else { u32x2 w; w.x = pk2(o0, o1); w.y = pk2(o2, o3); *(GAS u32x2*)(yo + 16 * mt) = w; } }
    }
    __syncthreads();
}

__device__ __forceinline__ unsigned block_excl_scan(unsigned val, LAS unsigned* wtot, int lane, int wave) {
    unsigned inc = val;
#pragma unroll
    for (int o = 1; o < 64; o <<= 1) { const unsigned t = shuu(inc, o, lane); if (lane >= o) inc += t; }
    if (lane == 63) wtot[wave] = inc;
    __syncthreads();
    unsigned base = 0;
    for (int w = 0; w < wave; ++w) base += wtot[w];
    __syncthreads();
    return base + inc - val;
}
__device__ __forceinline__ void ph_topk(const Params& p, LAS unsigned char* lds, const int tid, int G, int bid) {
    GAS unsigned char* ws_ = (GAS unsigned char*)p.ws; LAUNDER_S(ws_);
    const int lane = tid & 63, wave = __builtin_amdgcn_readfirstlane(tid >> 6);
    LAS unsigned* hist = (LAS unsigned*)(lds + LDS_SCR); LAS unsigned* sel = hist + 256; LAS unsigned* wtot = hist + 272;
    const GAS float* aff = (const GAS float*)(ws_ + WS_AFF); GAS int* slot_tok = (GAS int*)(ws_ + WS_ROUTE + RT_SLOTTOK); GAS float* gate_slot = (GAS float*)(ws_ + WS_ROUTE + RT_GATE); GAS int* slotmap = (GAS int*)(ws_ + WS_ROUTE + RT_SLOTMAP);
    for (int item = bid; item < BATCH * NE; item += G) {
        const int b = item >> 4, e = item & 15; const GAS float* av = aff + (size_t)item * SEQ + tid * 8;
        const f32x4 v0 = *(const GAS f32x4*)av, v1 = *(const GAS f32x4*)(av + 4);
        const float vals[8] = {v0.x, v0.y, v0.z, v0.w, v1.x, v1.y, v1.z, v1.w}; unsigned key[8];
#pragma unroll
        for (int i = 0; i < 8; ++i) key[i] = __float_as_uint(vals[i]);
        unsigned prefix = 0u, mask = 0u, remaining = CAP;
        for (int pass = 0; pass < 4; ++pass) { const int shift = 24 - 8 * pass;
            if (tid < 256) hist[tid] = 0u;
            __syncthreads();
#pragma unroll
            for (int i = 0; i < 8; ++i) if ((key[i] & mask) == prefix) atomicAdd((unsigned*)&hist[(key[i] >> shift) & 255u], 1u);
            __syncthreads();
            if (wave == 0) { const unsigned c0 = hist[255 - 4 * lane], c1 = hist[254 - 4 * lane], c2 = hist[253 - 4 * lane], c3 = hist[252 - 4 * lane]; const unsigned sm = c0 + c1 + c2 + c3; unsigned inc = sm;
#pragma unroll
                for (int o = 1; o < 64; o <<= 1) { const unsigned t = shuu(inc, o, lane); if (lane >= o) inc += t; }
                const unsigned before = inc - sm;
                if (before < remaining && remaining <= inc) { unsigned r = remaining - before; unsigned d;
                    if (r <= c0) d = 255 - 4 * lane; else if (r <= c0 + c1) { d = 254 - 4 * lane; r -= c0; } else if (r <= c0 + c1 + c2) { d = 253 - 4 * lane; r -= c0 + c1; } else { d = 252 - 4 * lane; r -= c0 + c1 + c2; }
                    sel[0] = prefix | (d << shift); sel[1] = r; } }
            __syncthreads();
            prefix = sel[0]; remaining = sel[1]; mask |= 0xffu << shift;
        }
        unsigned ceq = 0;
#pragma unroll
        for (int i = 0; i < 8; ++i) ceq += (key[i] == prefix) ? 1u : 0u;
        unsigned eqb = block_excl_scan(ceq, wtot, lane, wave);
        bool sl[8]; unsigned csel = 0;
#pragma unroll
        for (int i = 0; i < 8; ++i) { const bool eq = key[i] == prefix; sl[i] = key[i] > prefix || (eq && eqb < remaining); eqb += eq ? 1u : 0u; csel += sl[i] ? 1u : 0u; }
        unsigned pos = block_excl_scan(csel, wtot, lane, wave);
#pragma unroll
        for (int i = 0; i < 8; ++i) { const int s = tid * 8 + i; int c = -1;
            if (sl[i]) { c = (int)pos++; const int slot = (e * BATCH + b) * CAP + c; slot_tok[slot] = b * SEQ + s; gate_slot[slot] = vals[i]; }
            slotmap[(size_t)(b * SEQ + s) * NE + e] = c; }
        __syncthreads();
    }
}
__device__ __forceinline__ void ph_gather(const Params& p, const int tid, int G, int bid) {
    unsigned char* ws_ = p.ws; LAUNDER_S(ws_);
    const int lane = tid & 63, gw = bid * 8 + __builtin_amdgcn_readfirstlane(tid >> 6), NGW = G * 8;
    const bf16_t* hb = (const bf16_t*)(ws_ + WS_H); bf16_t* xe = (bf16_t*)(ws_ + WS_XE); const int* slot_tok = (const int*)(ws_ + WS_ROUTE + RT_SLOTTOK);
    for (int r = gw; r < NSLOT; r += NGW) { const int tok = slot_tok[r]; const u32x4* s = (const u32x4*)((const unsigned char*)hb + (size_t)tok * D) + lane; u32x4* d = (u32x4*)((unsigned char*)xe + (size_t)r * D) + lane; d[0] = s[0]; }
}

__global__ void __launch_bounds__(512, 2) fwd(Params p) {
    extern __shared__ __attribute__((aligned(16))) unsigned char lds_raw[];
    LAS unsigned char* lds = (LAS unsigned char*)lds_raw;
    const int G = gridDim.x, bid = blockIdx.x, wave0 = __builtin_amdgcn_readfirstlane((int)threadIdx.x >> 6);
    { const int t = FRESH_TID(); if (t < 64) ((LAS unsigned*)lds)[t] = 0u; }
    __syncthreads();
    unsigned* ctl = (unsigned*)(p.ws + WS_CTL);
    XcdBarrier bar = xcd_barrier_post(ctl + CW_BAR + p.li * XCD_BAR_WORDS, (volatile LAS unsigned*)(lds + 16), wave0);
    const int lo = p.ph_lo, hi = p.ph_hi;
#define IN(k) (lo <= (k) && (k) < hi)
#define SEAM(k) do { if (IN(k) && IN((k) + 1)) xcd_barrier(bar); } while (0)
#define GTID(t) (bid * 512 + (t))
    LAS unsigned char* ring = lds + LDS_SCR;

    if (IN(0)) REPEAT(11) ph_convert(p, lds, FRESH_TID(), G, bid);
    SEAM(0);
    if (IN(1)) {
        unsigned char* ws_ = p.ws; LAUNDER_S(ws_);
        pg8::Gemm g{(const bf16_t*)(ws_ + WS_MEMH), (const bf16_t*)(ws_ + WS_WKV), DEPTH * BATCH * NMEM, DEPTH * 512, D}; pg8::KvOrder S{G, bid};
        pg8::EpiKvMem E{ws_, p.mem_gk};
        pg8::gemm_phase<pg8::EpiKvMem, pg8::KvOrder, true, true>(ring, g, S, E, FRESH_TID());
        __syncthreads();
        ph_cvt_experts(p, lds, FRESH_TID(), G, bid);
    }
    SEAM(1);
#pragma unroll 1
    for (int l = 0; l < DEPTH; ++l) {
        const int pb = 2 + 11 * l;
        if (IN(pb + 0)) { if (l == 0) ph_norm<0, true>(p, l, false, lds, FRESH_TID(), G, bid, p.x); else ph_norm<0, false>(p, l, true, lds, FRESH_TID(), G, bid, p.ws + WS_XB); }
        SEAM(pb + 0);
        if (IN(pb + 1)) REPEAT(1) {
            unsigned char* ws_ = p.ws; LAUNDER_S(ws_);
            pg8::Gemm g{(const bf16_t*)(ws_ + WS_XB), (const bf16_t*)(ws_ + WS_WIN) + (size_t)l * NPROJ * D, NTOK, NPROJ, D}; pg8::StaticOrder S; S.init(NTOK, NPROJ, G, bid);
            pg8::EpiProj E{ws_, (const float*)(ws_ + WS_GT) + l * 192, (const float*)(ws_ + WS_RR)};
            pg8::gemm_phase<pg8::EpiProj, pg8::StaticOrder, true, true>(ring, g, S, E, FRESH_TID());
        }
        SEAM(pb + 1);
        if (IN(pb + 2)) REPEAT(2) {
            REPEAT(13) ph_mlstm_a(p, l, lds, FRESH_TID(), G, bid);

            REPEAT(12) ph_na_lds(p, l, lds, FRESH_TID(), G, bid); REPEAT(14) ph_cross_lds(p, l, lds, FRESH_TID(), G, bid);
        }
        SEAM(pb + 2);
        if (IN(pb + 3)) REPEAT(3) { const int t = FRESH_TID(); ph_mlstm_scan(p, GTID(t), G * 512); }
        SEAM(pb + 3);
        if (IN(pb + 4)) REPEAT(4) ph_mlstm_c(p, l, lds, FRESH_TID(), G, bid);
        SEAM(pb + 4);
        if (IN(pb + 5)) REPEAT(5) {
            unsigned char* ws_ = p.ws; LAUNDER_S(ws_);
            pg8::Gemm g{(const bf16_t*)(ws_ + WS_Y), (const bf16_t*)(ws_ + WS_WOUT) + (size_t)l * D * D, NTOK, D, D}; pg8::StaticOrder S; S.init(NTOK, D, G, bid);
            pg8::EpiResid E{(bf16_t*)(ws_ + WS_XB)};
            if (l >= Y8_FROM) { pg8::Gemm g8{(const bf16_t*)(ws_ + WS_Y), (const bf16_t*)(ws_ + WS_WOUT) + (size_t)l * D * D, NTOK, D, D / 2};
                pg8::gemm_phase_f8<pg8::EpiResid, pg8::StaticOrder, true, true, 124, 119>(ring, g8, S, E, FRESH_TID()); }
            else pg8::gemm_phase<pg8::EpiResid, pg8::StaticOrder, true, true>(ring, g, S, E, FRESH_TID());
        }
        SEAM(pb + 5);
        if (IN(pb + 6)) ph_norm1_t4(p, l, lds, FRESH_TID(), G, bid);
        SEAM(pb + 6);
        if (IN(pb + 7)) REPEAT(7) ph_topk(p, lds, FRESH_TID(), G, bid);
        SEAM(pb + 7);
        if (IN(pb + 9)) REPEAT(9) {
            unsigned char* ws_ = p.ws; LAUNDER_S(ws_);
            pg8::Gemm g{(const bf16_t*)(ws_ + WS_H), (const bf16_t*)(ws_ + WS_W13 + (size_t)l * NE * 4096 * D), NSLOT, NE * 4096, D / 2}; pg8::MoeOrder S{G, bid, 16, 256};
            pg8::EpiSwiGLU8 E{ws_ + WS_HID};
            pg8::gemm_phase_f8g<pg8::EpiSwiGLU8, pg8::MoeOrder, true, true, 124, 119>(ring, g, S, E, FRESH_TID(), (const int*)(ws_ + WS_ROUTE + RT_SLOTTOK));
        }
        SEAM(pb + 9);
        if (IN(pb + 10)) REPEAT(10) {
            unsigned char* ws_ = p.ws; LAUNDER_S(ws_);
            pg8::Gemm g{(const bf16_t*)(ws_ + WS_HID), (const bf16_t*)(ws_ + WS_W2 + (size_t)l * NE * D * DFF), NSLOT, NE * D, DFF / 2}; pg8::MoeOrder S{G, bid, 4, 64};
            pg8::EpiGate E{(bf16_t*)(ws_ + WS_YBUF), (const float*)(ws_ + WS_ROUTE + RT_GATE)};
            pg8::gemm_phase_f8<pg8::EpiGate, pg8::MoeOrder, true, true, 124, 119>(ring, g, S, E, FRESH_TID());
        }
        SEAM(pb + 10);
    }
    if (IN(NPHASE - 1)) ph_norm<2, false>(p, 0, true, lds, FRESH_TID(), G, bid, p.ws + WS_XB);
#undef GTID
#undef IN
#undef SEAM
}

#ifndef ATTN_NAIVE
#define ATTN_NAIVE 0
#endif
#ifndef MK_PER_PHASE
#define MK_PER_PHASE 0
#endif
extern "C" void kernel_launch(void* const* d_in, const int* in_sizes, int n_in, void* d_out, int out_size, void* d_ws, size_t ws_size, hipStream_t stream) {
    static int grid = 0;
    if (grid == 0) {
        if (n_in != 20 || out_size != NTOK * D || ws_size < WS_END) { fprintf(stderr, "kernel_launch: unexpected shapes (n_in %d, out %d, ws %zu < %zu)\n", n_in, out_size, ws_size, (size_t)WS_END); grid = -1; return; }
        int dev = 0, cus = 0, per_cu = 0;
        if (hipGetDevice(&dev) != hipSuccess || hipDeviceGetAttribute(&cus, hipDeviceAttributeMultiprocessorCount, dev) != hipSuccess) { grid = -1; return; }
        if (hipFuncSetAttribute((const void*)fwd, hipFuncAttributeMaxDynamicSharedMemorySize, LDS_BYTES) != hipSuccess) { fprintf(stderr, "kernel_launch: hipFuncSetAttribute failed\n"); grid = -1; return; }
        if (hipOccupancyMaxActiveBlocksPerMultiprocessor(&per_cu, (const void*)fwd, 512, LDS_BYTES) != hipSuccess || per_cu < 1) { fprintf(stderr, "kernel_launch: occupancy query says %d\n", per_cu); per_cu = 1; }
        (void)hipGetLastError();
        grid = cus;
    }
    if (grid < 0) return;
    (void)hipMemsetAsync((char*)d_ws + WS_CTL, 0, CTL_BYTES, stream);
    Params P{};
    const float** pp = (const float**)&P;
    for (int i = 0; i < 20; ++i) pp[i] = (const float*)d_in[i];
    P.out = (float*)d_out; P.ws = (unsigned char*)d_ws; P.pad = 0;
#if MK_PER_PHASE
    for (int ph = 0; ph < NPHASE; ++ph) { P.ph_lo = ph; P.ph_hi = ph + 1; P.li = ph; hipLaunchKernelGGL(fwd, dim3(grid), dim3(512), LDS_BYTES, stream, P); }
#else
    P.ph_lo = 0; P.ph_hi = NPHASE; P.li = 0;
    hipLaunchKernelGGL(fwd, dim3(grid), dim3(512), LDS_BYTES, stream, P);
#endif
}
```

```cpp
#include <hip/hip_runtime.h>
#include <cstdio>
#include <cstdint>

constexpr size_t MiB = (size_t)1 << 20;
constexpr size_t WS_CTL = 0, CTL_BYTES = 1 * MiB;
constexpr size_t WS_WIN = 1 * MiB, WS_WKV = 21 * MiB, WS_WOUT = 25 * MiB, WS_W13 = 33 * MiB, WS_W2 = 545 * MiB;
constexpr size_t WS_H = 801 * MiB, WS_MEMH = 865 * MiB, WS_PROJ = 881 * MiB, WS_GATES = 1041 * MiB, WS_KVMEM = 1043 * MiB, WS_Y = 1051 * MiB;
constexpr size_t WS_AFF = 1115 * MiB, WS_ROUTE = 1117 * MiB, WS_XE = 1121 * MiB, WS_XB = WS_XE, WS_RR = WS_ROUTE + 3 * MiB, WS_OG = WS_H + 32 * MiB, WS_HID = 1249 * MiB, WS_YBUF = 1505 * MiB, WS_QKC = 1633 * MiB, WS_HDIR = 1665 * MiB, WS_VT = 1793 * MiB, WS_NVT = 1825 * MiB, WS_NRM = 1841 * MiB, WS_KMN = 1889 * MiB, WS_VMT = 1893 * MiB, WS_GT = 1897 * MiB, WS_END = 1898 * MiB;
constexpr size_t WS_MKV = WS_HID, WS_MCP = WS_HID + 64 * MiB, WS_MN = WS_HID + 96 * MiB, WS_MNP = WS_HID + 97 * MiB, WS_MCST = WS_HID + 98 * MiB, WS_MMP = WS_HID + 98 * MiB + 512 * 1024, WS_MGST = WS_HID + 99 * MiB;
constexpr size_t RT_SLOTTOK = 0, RT_GATE = 256 * 1024, RT_SLOTMAP = 1 * MiB;
constexpr int CW_BAR = 1024;


__device__ __forceinline__ float shx(float v, int mask, int lane) { return __int_as_float(__builtin_amdgcn_ds_bpermute((lane ^ mask) << 2, __float_as_int(v))); }
__device__ __forceinline__ float shu(float v, int o, int lane) { return __int_as_float(__builtin_amdgcn_ds_bpermute(((lane - o) & 63) << 2, __float_as_int(v))); }
__device__ __forceinline__ float shd(float v, int o, int lane) { return __int_as_float(__builtin_amdgcn_ds_bpermute(((lane + o) & 63) << 2, __float_as_int(v))); }
__device__ __forceinline__ float shb(float v, int src) { return __int_as_float(__builtin_amdgcn_ds_bpermute(src << 2, __float_as_int(v))); }
__device__ __forceinline__ unsigned shuu(unsigned v, int o, int lane) { return (unsigned)__builtin_amdgcn_ds_bpermute(((lane - o) & 63) << 2, (int)v); }

typedef unsigned u32x2s __attribute__((ext_vector_type(2)));
__device__ __forceinline__ float rows_sum4(float v) {
    u32x2s r = __builtin_amdgcn_permlane16_swap(__float_as_uint(v), __float_as_uint(v), false, false); v = __uint_as_float(r.x) + __uint_as_float(r.y);
    r = __builtin_amdgcn_permlane32_swap(__float_as_uint(v), __float_as_uint(v), false, false); return __uint_as_float(r.x) + __uint_as_float(r.y); }
__device__ __forceinline__ float rows_max4(float v) {
    u32x2s r = __builtin_amdgcn_permlane16_swap(__float_as_uint(v), __float_as_uint(v), false, false); v = fmaxf(__uint_as_float(r.x), __uint_as_float(r.y));
    r = __builtin_amdgcn_permlane32_swap(__float_as_uint(v), __float_as_uint(v), false, false); return fmaxf(__uint_as_float(r.x), __uint_as_float(r.y)); }
namespace pg8 {
#define PG8_LAS __attribute__((address_space(3)))
typedef unsigned short bf16_t;
typedef short bf16x8 __attribute__((ext_vector_type(8)));
typedef float f32x4 __attribute__((ext_vector_type(4)));
typedef unsigned u32x4 __attribute__((ext_vector_type(4)));
constexpr int BM = 256, BK = 64, HALF = 128, HTB = HALF * BK * 2  , STAGE_BYTES = 8 * HTB, NXCD = 8, WGM = 8;

__host__ __device__ __forceinline__ int lds_byte(int r, int c) { const int st = (r >> 4) * 2 + (c >> 5), rr = r & 15, cc = c & 31, ob = rr * 64 + cc * 2; return st * 1024 + (ob ^ (((ob >> 9) & 1) << 5)); }
__host__ __device__ __forceinline__ void stage_rc(int b, int& R, int& C) { const int st = b / 1024, sb = b % 1024, swz = sb ^ (((sb >> 9) & 1) << 5); R = (st >> 1) * 16 + swz / 64; C = (st & 1) * 32 + (swz % 64) / 2; }
__host__ __device__ __forceinline__ int perm32(int rho) { const int n = rho >> 4, i = rho & 15; return 8 * (i >> 2) + 4 * n + (i & 3); }

struct Unit { int pm, pn; };
struct Gemm { const bf16_t* A; const bf16_t* Bt; int M, N, K; };

struct StaticOrder {
    int nM, nN, nwg, G, c;
    __host__ __device__ void init(int M, int N, int G_, int c_) { nM = M / BM; nN = N / BM; nwg = nM * nN; G = G_; c = c_; }
    __host__ __device__ bool next(int i, Unit& u) const {
        const long L = (long)i * G + c; if (L >= nwg) return false;
        int wgid = (int)L; { const int q = nwg / NXCD, r = nwg % NXCD, xcd = wgid % NXCD, off = wgid / NXCD; wgid = (xcd < r ? xcd * (q + 1) : r * (q + 1) + (xcd - r) * q) + off; }
        const int nig = WGM * nN, gid = wgid / nig, fm = gid * WGM, gsz = (nM - fm) < WGM ? (nM - fm) : WGM;
        u.pm = fm + ((wgid % nig) % gsz); u.pn = (wgid % nig) / gsz; return true;
    }
    __device__ __forceinline__ void a_ready(const Unit&) const {}
    __device__ __forceinline__ void done(const Unit&) const {}
};

__device__ __forceinline__ unsigned cvt_pk_bf16(float lo, float hi) { unsigned r; asm volatile("v_cvt_pk_bf16_f32 %0, %1, %2" : "=v"(r) : "v"(lo), "v"(hi)); return r; }
typedef float f32x2 __attribute__((ext_vector_type(2)));

struct EpiStoreBf16 {
    static constexpr bool PERM = true, AFTER_DRAIN = false;
    bf16_t* O; int ldc; int ncolt;
    __device__ __forceinline__ void operator()(const f32x4 (&acc)[2][2][4][2], const Unit& u, int wr, int wc, int fr, int fq) const {
        const int row0 = u.pm * BM + wr * 64 + fr, col0 = (u.pn % ncolt) * BM + wc * 32 + 8 * fq;
#pragma unroll
        for (int ai = 0; ai < 2; ++ai)
#pragma unroll
            for (int m = 0; m < 4; ++m) { bf16_t* rowp = O + (size_t)(row0 + ai * HALF + m * 16) * ldc + col0;
#pragma unroll
                for (int bj = 0; bj < 2; ++bj) { const f32x4 v0 = acc[ai][bj][m][0], v1 = acc[ai][bj][m][1];
                    u32x4 w; w.x = cvt_pk_bf16(v0[0], v0[1]); w.y = cvt_pk_bf16(v0[2], v0[3]); w.z = cvt_pk_bf16(v1[0], v1[1]); w.w = cvt_pk_bf16(v1[2], v1[3]);
                    *(u32x4*)(rowp + bj * HALF) = w; } }
    }
};
struct EpiResid {
    static constexpr bool PERM = true, AFTER_DRAIN = false;
    bf16_t* X;
    __device__ __forceinline__ void operator()(const f32x4 (&acc)[2][2][4][2], const Unit& u, int wr, int wc, int fr, int fq) const {
        const int row0 = u.pm * BM + wr * 64 + fr, col0 = u.pn * BM + wc * 32 + 8 * fq;
        u32x4 t[2][4][2];
#pragma unroll
        for (int ai = 0; ai < 2; ++ai)
#pragma unroll
            for (int m = 0; m < 4; ++m) { const bf16_t* rowp = X + (size_t)(row0 + ai * HALF + m * 16) * 1024 + col0;
#pragma unroll
                for (int bj = 0; bj < 2; ++bj) t[ai][m][bj] = *(const u32x4*)(rowp + bj * HALF); }
#pragma unroll
        for (int ai = 0; ai < 2; ++ai)
#pragma unroll
            for (int m = 0; m < 4; ++m) { bf16_t* rowp = X + (size_t)(row0 + ai * HALF + m * 16) * 1024 + col0;
#pragma unroll
                for (int bj = 0; bj < 2; ++bj) { const f32x4 v0 = acc[ai][bj][m][0], v1 = acc[ai][bj][m][1]; const u32x4 x = t[ai][m][bj];
                    u32x4 w; w.x = cvt_pk_bf16(v0[0] + __uint_as_float(x.x << 16), v0[1] + __uint_as_float(x.x & 0xffff0000u)); w.y = cvt_pk_bf16(v0[2] + __uint_as_float(x.y << 16), v0[3] + __uint_as_float(x.y & 0xffff0000u));
                    w.z = cvt_pk_bf16(v1[0] + __uint_as_float(x.z << 16), v1[1] + __uint_as_float(x.z & 0xffff0000u)); w.w = cvt_pk_bf16(v1[2] + __uint_as_float(x.w << 16), v1[3] + __uint_as_float(x.w & 0xffff0000u));
                    *(u32x4*)(rowp + bj * HALF) = w; } }
    }
};
struct EpiSwiGLU {
    static constexpr bool PERM = true, AFTER_DRAIN = false;
    bf16_t* Hd;
    __device__ __forceinline__ void operator()(const f32x4 (&acc)[2][2][4][2], const Unit& u, int wr, int wc, int fr, int fq) const {
        const int row0 = u.pm * BM + wr * 64 + fr, col0 = (u.pn & 15) * HALF + wc * 32 + 8 * fq;
#pragma unroll
        for (int ai = 0; ai < 2; ++ai)
#pragma unroll
            for (int m = 0; m < 4; ++m) { bf16_t* rowp = Hd + (size_t)(row0 + ai * HALF + m * 16) * 2048 + col0;
                float h[8];
#pragma unroll
                for (int n = 0; n < 2; ++n)
#pragma unroll
                    for (int j = 0; j < 4; ++j) { const float a = acc[ai][0][m][n][j], b = acc[ai][1][m][n][j]; h[n * 4 + j] = a * __builtin_amdgcn_rcpf(1.0f + __expf(-a)) * b; }
                u32x4 w; w.x = cvt_pk_bf16(h[0], h[1]); w.y = cvt_pk_bf16(h[2], h[3]); w.z = cvt_pk_bf16(h[4], h[5]); w.w = cvt_pk_bf16(h[6], h[7]);
                *(u32x4*)rowp = w; }
    }
};

typedef unsigned u32x2v __attribute__((ext_vector_type(2)));
__device__ __forceinline__ unsigned pk4_fp8(float a, float b, float c, float d) {
    a = fminf(fmaxf(a, -448.f), 448.f); b = fminf(fmaxf(b, -448.f), 448.f); c = fminf(fmaxf(c, -448.f), 448.f); d = fminf(fmaxf(d, -448.f), 448.f);
    int w = 0; w = __builtin_amdgcn_cvt_pk_fp8_f32(a, b, w, false); w = __builtin_amdgcn_cvt_pk_fp8_f32(c, d, w, true); return (unsigned)w; }
typedef short v2s16 __attribute__((ext_vector_type(2)));
__device__ __forceinline__ unsigned pk4_fp8s(float a, float b, float c, float d, float scale) {
    v2s16 r = {0, 0}; r = __builtin_amdgcn_cvt_scalef32_pk_fp8_f32(r, a, b, scale, false); r = __builtin_amdgcn_cvt_scalef32_pk_fp8_f32(r, c, d, scale, true); return __builtin_bit_cast(unsigned, r); }
struct EpiSwiGLU8 {
    static constexpr bool PERM = true, AFTER_DRAIN = false;
    unsigned char* Hd;
    __device__ __forceinline__ void operator()(const f32x4 (&acc)[2][2][4][2], const Unit& u, int wr, int wc, int fr, int fq) const {
        const int row0 = u.pm * BM + wr * 64 + fr, col0 = (u.pn & 15) * HALF + wc * 32 + 8 * fq;
#pragma unroll
        for (int ai = 0; ai < 2; ++ai)
#pragma unroll
            for (int m = 0; m < 4; ++m) { unsigned char* rowp = Hd + (size_t)(row0 + ai * HALF + m * 16) * 2048 + col0;
                float h[8];
#pragma unroll
                for (int n = 0; n < 2; ++n)
#pragma unroll
                    for (int j = 0; j < 4; ++j) { const float a = acc[ai][0][m][n][j], b = acc[ai][1][m][n][j]; h[n * 4 + j] = 8.0f * a * __builtin_amdgcn_rcpf(1.0f + __expf(-a)) * b; }
                u32x2v w; w.x = pk4_fp8(h[0], h[1], h[2], h[3]); w.y = pk4_fp8(h[4], h[5], h[6], h[7]);
                *(u32x2v*)rowp = w; }
    }
};
struct EpiGate {
    static constexpr bool PERM = true, AFTER_DRAIN = false;
    bf16_t* Y; const float* gate;
    __device__ __forceinline__ void operator()(const f32x4 (&acc)[2][2][4][2], const Unit& u, int wr, int wc, int fr, int fq) const {
        const int row0 = u.pm * BM + wr * 64 + fr, col0 = (u.pn & 3) * BM + wc * 32 + 8 * fq;
        float gs[2][4];
#pragma unroll
        for (int ai = 0; ai < 2; ++ai)
#pragma unroll
            for (int m = 0; m < 4; ++m) gs[ai][m] = gate[row0 + ai * HALF + m * 16];
#pragma unroll
        for (int ai = 0; ai < 2; ++ai)
#pragma unroll
            for (int m = 0; m < 4; ++m) { const int row = row0 + ai * HALF + m * 16; const float g = gs[ai][m]; unsigned char* rowp = (unsigned char*)Y + (size_t)row * 1024 + col0;
#pragma unroll
                for (int bj = 0; bj < 2; ++bj) { const f32x4 v0 = acc[ai][bj][m][0] * g, v1 = acc[ai][bj][m][1] * g;
                    u32x2v w; w.x = pk4_fp8s(v0[0], v0[1], v0[2], v0[3], 0.125f); w.y = pk4_fp8s(v1[0], v1[1], v1[2], v1[3], 0.125f);
                    *(u32x2v*)(rowp + bj * HALF) = w; } }
    }
};

__device__ __forceinline__ void st_bf16(bf16_t* p, unsigned w, bool hi) { *p = (bf16_t)(hi ? (w >> 16) : (w & 0xffffu)); }
struct EpiProj {
    static constexpr bool PERM = true, AFTER_DRAIN = false;
    unsigned char* ws; const float* gt; const float* rrow;
    __device__ __forceinline__ void operator()(const f32x4 (&acc)[2][2][4][2], const Unit& u, int wr, int wc, int fr, int fq) const {
        const int pn = u.pn, row0 = u.pm * BM + wr * 64 + fr, lane = fq * 16 + fr;
        float rs[2][4];
#pragma unroll
        for (int ai = 0; ai < 2; ++ai)
#pragma unroll
            for (int m = 0; m < 4; ++m) rs[ai][m] = rrow[row0 + ai * HALF + m * 16];
        bf16_t* P = (bf16_t*)(ws + WS_PROJ); bf16_t* VT = (bf16_t*)(ws + WS_VT); bf16_t* NVT = (bf16_t*)(ws + WS_NVT); bf16_t* NRM = (bf16_t*)(ws + WS_NRM);
        if (pn == 6 || pn == 7 || pn == 9) {
            const int sel = pn == 6 ? 0 : (pn == 7 ? 1 : 2); const float* gsrc = gt + sel * 64; const float qs = pn == 7 ? 1.0f : 0.125f;
            f32x4 gv[2][2];
#pragma unroll
            for (int bj = 0; bj < 2; ++bj)
#pragma unroll
                for (int n = 0; n < 2; ++n) gv[bj][n] = *(const f32x4*)(gsrc + 32 * bj + 8 * fq + 4 * n);
            const int nb = (pn == 6 ? 0 : (pn == 7 ? 256 : 512)) + 64 * wc + 8 * fq, pb = pn * BM + 64 * wc + 8 * fq;
#pragma unroll
            for (int ai = 0; ai < 2; ++ai)
#pragma unroll
                for (int m = 0; m < 4; ++m) { const size_t row = (size_t)(row0 + ai * HALF + m * 16); float ss = 0.f;
#pragma unroll
                    for (int bj = 0; bj < 2; ++bj)
#pragma unroll
                        for (int n = 0; n < 2; ++n) { const f32x4 v = acc[ai][bj][m][n]; ss += v[0] * v[0] + v[1] * v[1] + v[2] * v[2] + v[3] * v[3]; }
                    ss = rows_sum4(ss) * rs[ai][m] * rs[ai][m];
                    const float rr = rsqrtf(ss * (1.0f / 64.0f) + 1e-6f) * qs * rs[ai][m];
#pragma unroll
                    for (int bj = 0; bj < 2; ++bj) { const f32x4 v0 = acc[ai][bj][m][0], v1 = acc[ai][bj][m][1];
                        const f32x4 n0 = v0 * gv[bj][0] * rr, n1 = v1 * gv[bj][1] * rr; u32x4 w;
                        w.x = cvt_pk_bf16(n0[0], n0[1]); w.y = cvt_pk_bf16(n0[2], n0[3]); w.z = cvt_pk_bf16(n1[0], n1[1]); w.w = cvt_pk_bf16(n1[2], n1[3]);
                        *(u32x4*)(NRM + row * 768 + nb + 32 * bj) = w; } }
            return;
        }
        const int col0 = pn * BM + wc * 32 + 8 * fq;
        if (pn == 4 || pn == 5) {
            unsigned char* OG = ws + WS_OG;
#pragma unroll
            for (int ai = 0; ai < 2; ++ai)
#pragma unroll
                for (int m = 0; m < 4; ++m) { unsigned char* rowp = OG + (size_t)(row0 + ai * HALF + m * 16) * 512 + (pn - 4) * BM + wc * 32 + 8 * fq;
#pragma unroll
                    for (int bj = 0; bj < 2; ++bj) { const f32x4 v0 = acc[ai][bj][m][0] * rs[ai][m], v1 = acc[ai][bj][m][1] * rs[ai][m];
                        u32x2v w; w.x = pk4_fp8(8.f * v0[0], 8.f * v0[1], 8.f * v0[2], 8.f * v0[3]); w.y = pk4_fp8(8.f * v1[0], 8.f * v1[1], 8.f * v1[2], 8.f * v1[3]);
                        *(u32x2v*)(rowp + bj * HALF) = w; } }
            return;
        }
        if (!(pn == 2 || pn == 3 || pn == 8))
#pragma unroll
        for (int ai = 0; ai < 2; ++ai)
#pragma unroll
            for (int m = 0; m < 4; ++m) { bf16_t* rowp = P + (size_t)(row0 + ai * HALF + m * 16) * 2560 + col0;
#pragma unroll
                for (int bj = 0; bj < 2; ++bj) { const f32x4 v0 = acc[ai][bj][m][0] * rs[ai][m], v1 = acc[ai][bj][m][1] * rs[ai][m];
                    u32x4 w; w.x = cvt_pk_bf16(v0[0], v0[1]); w.y = cvt_pk_bf16(v0[2], v0[3]); w.z = cvt_pk_bf16(v1[0], v1[1]); w.w = cvt_pk_bf16(v1[2], v1[3]);
                    *(u32x4*)(rowp + bj * HALF) = w; } }
        if (pn == 2 || pn == 3 || pn == 8) {
            const int b = u.pm >> 4, s0 = (u.pm & 15) * BM + wr * 64 + fr;
#pragma unroll
            for (int bj = 0; bj < 2; ++bj) {
                bf16_t* base;
                if (pn == 8) base = NVT + ((size_t)((b * 4 + 2 * bj + (wc >> 1)) * 64 + 32 * (wc & 1) + 8 * fq)) * 4096 + s0;
                else base = VT + ((size_t)((b * 4 + (pn - 2) * 2 + bj) * 128 + 32 * wc + 8 * fq)) * 4096 + s0;
#pragma unroll
                for (int ai = 0; ai < 2; ++ai)
#pragma unroll
                    for (int m = 0; m < 4; ++m)
#pragma unroll
                        for (int n = 0; n < 2; ++n) { const f32x4 v = acc[ai][bj][m][n] * rs[ai][m]; const unsigned w0 = cvt_pk_bf16(v[0], v[1]), w1 = cvt_pk_bf16(v[2], v[3]);
                            if (pn == 8) {
                                const int head = 2 * bj + (wc >> 1), dim = 32 * (wc & 1) + 8 * fq + 4 * n, gr = (u.pm & 15) * 4 + wr + 2 * ai, colq = m * 16 + fr;
                                bf16_t* q = NVT + ((size_t)(((b * 4 + head) * 64 + gr) * 64 + dim)) * 64 + colq;
                                st_bf16(q, w0, false); st_bf16(q + 64, w0, true); st_bf16(q + 128, w1, false); st_bf16(q + 192, w1, true); }
                            else { bf16_t* q = base + (size_t)(4 * n) * 4096 + ai * HALF + m * 16;
                                st_bf16(q, w0, false); st_bf16(q + 4096, w0, true); st_bf16(q + 2 * 4096, w1, false); st_bf16(q + 3 * 4096, w1, true); } }
            }
        }
    }
};
struct EpiKvMem {
    static constexpr bool PERM = true, AFTER_DRAIN = false;
    unsigned char* ws; const float* gk;
    __device__ __forceinline__ void operator()(const f32x4 (&acc)[2][2][4][2], const Unit& u, int wr, int wc, int fr, int fq) const {
        const int row0 = u.pm * BM + wr * 64 + fr, l = u.pn >> 1, lane = fq * 16 + fr;
        bf16_t* KMN = (bf16_t*)(ws + WS_KMN); bf16_t* VMT = (bf16_t*)(ws + WS_VMT);
        if ((u.pn & 1) == 0) {
            f32x4 gv[2][2];
#pragma unroll
            for (int bj = 0; bj < 2; ++bj)
#pragma unroll
                for (int n = 0; n < 2; ++n) gv[bj][n] = *(const f32x4*)(gk + l * 64 + 32 * bj + 8 * fq + 4 * n);
#pragma unroll
            for (int ai = 0; ai < 2; ++ai)
#pragma unroll
                for (int m = 0; m < 4; ++m) { const size_t row = (size_t)(row0 + ai * HALF + m * 16); float ss = 0.f;
#pragma unroll
                    for (int bj = 0; bj < 2; ++bj)
#pragma unroll
                        for (int n = 0; n < 2; ++n) { const f32x4 v = acc[ai][bj][m][n]; ss += v[0] * v[0] + v[1] * v[1] + v[2] * v[2] + v[3] * v[3]; }
                    ss = rows_sum4(ss);
                    const float rr = rsqrtf(ss * (1.0f / 64.0f) + 1e-6f);
#pragma unroll
                    for (int bj = 0; bj < 2; ++bj) { const f32x4 v0 = acc[ai][bj][m][0], v1 = acc[ai][bj][m][1];
                        const f32x4 n0 = v0 * gv[bj][0] * rr, n1 = v1 * gv[bj][1] * rr; u32x4 w;
                        w.x = cvt_pk_bf16(n0[0], n0[1]); w.y = cvt_pk_bf16(n0[2], n0[3]); w.z = cvt_pk_bf16(n1[0], n1[1]); w.w = cvt_pk_bf16(n1[2], n1[3]);
                        *(u32x4*)(KMN + row * 256 + 64 * wc + 32 * bj + 8 * fq) = w; } }
            return;
        }
        const int lb = u.pm;
#pragma unroll
        for (int bj = 0; bj < 2; ++bj) { bf16_t* base = VMT + ((size_t)((lb * 4 + 2 * bj + (wc >> 1)) * 64 + 32 * (wc & 1) + 8 * fq)) * 256 + wr * 64 + fr;
#pragma unroll
            for (int ai = 0; ai < 2; ++ai)
#pragma unroll
                for (int m = 0; m < 4; ++m)
#pragma unroll
                    for (int n = 0; n < 2; ++n) { const f32x4 v = acc[ai][bj][m][n]; const unsigned w0 = cvt_pk_bf16(v[0], v[1]), w1 = cvt_pk_bf16(v[2], v[3]);
                        bf16_t* q = base + (size_t)(4 * n) * 256 + ai * HALF + m * 16;
                        st_bf16(q, w0, false); st_bf16(q + 256, w0, true); st_bf16(q + 512, w1, false); st_bf16(q + 768, w1, true); } }
    }
};
struct KvOrder {
    int G, c;
    __device__ bool next(int i, Unit& u) const { const int L = i * G + c; if (L >= 64) return false; const int l = L >> 4, w = L & 15; u.pm = l * 8 + (w & 7); u.pn = l * 2 + (w >> 3); return true; }
    __device__ __forceinline__ void a_ready(const Unit&) const {}
    __device__ __forceinline__ void done(const Unit&) const {}
};
struct MoeOrder {
    int G, c, nN, upe;
    __device__ bool next(int i, Unit& u) const {
        const int L = i * G + c; if (L >= 16 * upe) return false;
        const int e = L / upe, w = L % upe, q = upe / NXCD, wgid = (w % NXCD) * q + w / NXCD;
        int nig = WGM * nN, gid = wgid / nig, pml = gid * WGM + (wgid % nig) % WGM, pnl = (wgid % nig) / WGM;
        if (nN == 4) { pml = 2 * (w % NXCD) + ((w / NXCD) & 1); pnl = (w / NXCD) >> 1; }
        const int ee = (nN == 4) ? 15 - e : e;
        u.pm = ee * 16 + pml; u.pn = ee * nN + pnl; return true;
    }
    __device__ __forceinline__ void a_ready(const Unit&) const {}
    __device__ __forceinline__ void done(const Unit&) const {}
};

template <class Epi, class Sched, bool ALIGN_EPI = false, bool SP2 = false>
__device__ __forceinline__ void gemm_phase(PG8_LAS unsigned char* lds, const Gemm g, const Sched& S, const Epi& E, const int tid) {
    const int wid = __builtin_amdgcn_readfirstlane(tid >> 6), lane = tid & 63, wr = wid >> 2, wc = wid & 3, fr = lane & 15, fq = lane >> 4;
    const int K = g.K, nt = K / BK;
    unsigned voffA[2], voffB[2];
#pragma unroll
    for (int i = 0; i < 2; ++i) { int R, C; stage_rc(tid * 16 + i * 8192, R, C); const int Rb = Epi::PERM ? ((R & ~31) + perm32(R & 31)) : R;
        voffA[i] = (unsigned)(R * K + C) * 2u; voffB[i] = (unsigned)(Rb * K + C) * 2u; }
    const size_t kstep = (size_t)(BK * 2);
    const size_t hstep = (size_t)HALF * K * 2;
    const size_t tstep = 2 * hstep;
    const unsigned ldsw = (unsigned)wid * 1024u;
    const int aoff = lds_byte(wr * 64 + fr, fq * 8), boff = lds_byte(wc * 32 + fr, fq * 8);
#define PG8_SA(b, h) (((b) * 2 + (h)) * HTB)
#define PG8_SB(b, h) ((4 + (b) * 2 + (h)) * HTB)
#define PG8_STAGE(bufoff, gbase, voff) do { _Pragma("unroll") for (int _i = 0; _i < 2; ++_i) \
        __builtin_amdgcn_global_load_lds((const unsigned*)((const char*)(gbase) + (voff)[_i]), (PG8_LAS unsigned*)(lds + (bufoff) + ldsw + _i * 8192), 16, 0, 0); } while (0)
#define PG8_LDA(dst, b, h) do { _Pragma("unroll") for (int m = 0; m < 4; ++m) _Pragma("unroll") for (int k = 0; k < 2; ++k) dst[m][k] = *(const PG8_LAS bf16x8*)(lds + PG8_SA(b, h) + aoff + m * 2048 + k * 1024); } while (0)
#define PG8_LDB(dst, b, h) do { _Pragma("unroll") for (int n = 0; n < 2; ++n) _Pragma("unroll") for (int k = 0; k < 2; ++k) dst[n][k] = *(const PG8_LAS bf16x8*)(lds + PG8_SB(b, h) + boff + n * 2048 + k * 1024); } while (0)
#define PG8_MMA(ai, bj, At, Bt) do { __builtin_amdgcn_s_setprio(1); _Pragma("unroll") for (int m = 0; m < 4; ++m) _Pragma("unroll") for (int n = 0; n < 2; ++n) _Pragma("unroll") for (int k = 0; k < 2; ++k) \
        acc[ai][bj][m][n] = __builtin_amdgcn_mfma_f32_16x16x32_bf16(Bt[n][k], At[m][k], acc[ai][bj][m][n], 0, 0, 0); __builtin_amdgcn_s_setprio(0); } while (0)
#define PG8_WAIT_V(n) asm volatile("s_waitcnt vmcnt(" #n ")" ::: "memory")
#define PG8_WAIT_L(n) asm volatile("s_waitcnt lgkmcnt(" #n ")" ::: "memory")
#define PG8_BAR __builtin_amdgcn_s_barrier()
#define PG8_SCHED __builtin_amdgcn_sched_barrier(0)
    Unit cur, nxt; int ui = 0;
    if (!S.next(0, cur)) return;
    f32x4 acc[2][2][4][2];
#pragma unroll
    for (int a = 0; a < 2; ++a)
#pragma unroll
        for (int b = 0; b < 2; ++b)
#pragma unroll
            for (int m = 0; m < 4; ++m)
#pragma unroll
                for (int n = 0; n < 2; ++n) acc[a][b][m][n] = (f32x4){0.f, 0.f, 0.f, 0.f};
    bf16x8 At[4][2], B0[2][2], B1[2][2];
    const char* cA = (const char*)g.A + (size_t)cur.pm * tstep; const char* cB = (const char*)g.Bt + (size_t)cur.pn * tstep;
    S.a_ready(cur);
    if constexpr (SP2) {
        PG8_STAGE(PG8_SB(0, 0), cB, voffB); PG8_STAGE(PG8_SB(0, 1), cB + hstep, voffB); PG8_STAGE(PG8_SA(0, 0), cA, voffA); PG8_STAGE(PG8_SA(0, 1), cA + hstep, voffA);
        if (wr == 1) PG8_BAR;
        PG8_WAIT_V(2); PG8_BAR;
        PG8_STAGE(PG8_SB(1, 0), cB + kstep, voffB); PG8_STAGE(PG8_SA(1, 0), cA + kstep, voffA); PG8_STAGE(PG8_SB(1, 1), cB + hstep + kstep, voffB);
        PG8_WAIT_V(6); PG8_BAR;
    } else {
        PG8_STAGE(PG8_SB(0, 0), cB, voffB); PG8_STAGE(PG8_SA(0, 0), cA, voffA); PG8_STAGE(PG8_SB(0, 1), cB + hstep, voffB); PG8_STAGE(PG8_SA(0, 1), cA + hstep, voffA);
        if (wr == 1) PG8_BAR;
        PG8_WAIT_V(4); PG8_BAR;
        PG8_STAGE(PG8_SB(1, 0), cB + kstep, voffB); PG8_STAGE(PG8_SA(1, 0), cA + kstep, voffA); PG8_STAGE(PG8_SB(1, 1), cB + hstep + kstep, voffB);
        PG8_WAIT_V(6); PG8_BAR;
    }
    for (;;) {
        const bool has_next = S.next(ui + 1, nxt);
        const char* nA = has_next ? (const char*)g.A + (size_t)nxt.pm * tstep : cA; const char* nB = has_next ? (const char*)g.Bt + (size_t)nxt.pn * tstep : cB;
        for (int t = 0; t < nt; t += 2) {
            const bool last = (t == nt - 2);
            const char* a1 = cA + (size_t)(t + 1) * kstep;
            const char* a2 = last ? nA : cA + (size_t)(t + 2) * kstep; const char* b2 = last ? nB : cB + (size_t)(t + 2) * kstep;
            const char* a3 = a2 + kstep; const char* b3 = b2 + kstep;
            if (last && has_next) S.a_ready(nxt);
            if constexpr (SP2) {
            PG8_LDB(B0, 0, 0); PG8_LDB(B1, 0, 1); PG8_SCHED; PG8_LDA(At, 0, 0); PG8_STAGE(PG8_SA(1, 1), a1 + hstep, voffA);
            PG8_WAIT_V(8); PG8_WAIT_L(0); PG8_BAR; PG8_MMA(0, 0, At, B0); PG8_MMA(0, 1, At, B1); PG8_BAR; PG8_SCHED;
            PG8_LDA(At, 0, 1); PG8_STAGE(PG8_SB(0, 0), b2, voffB); PG8_STAGE(PG8_SB(0, 1), b2 + hstep, voffB); PG8_STAGE(PG8_SA(0, 0), a2, voffA);
            PG8_WAIT_V(8); PG8_WAIT_L(0); PG8_BAR; PG8_MMA(1, 0, At, B0); PG8_MMA(1, 1, At, B1); PG8_BAR; PG8_SCHED;
            PG8_LDB(B0, 1, 0); PG8_LDB(B1, 1, 1); PG8_SCHED; PG8_LDA(At, 1, 0); PG8_STAGE(PG8_SA(0, 1), a2 + hstep, voffA);
            PG8_WAIT_V(8); PG8_WAIT_L(0); PG8_BAR; PG8_MMA(0, 0, At, B0); PG8_MMA(0, 1, At, B1); PG8_BAR; PG8_SCHED;
            PG8_LDA(At, 1, 1); PG8_STAGE(PG8_SB(1, 0), b3, voffB); PG8_STAGE(PG8_SB(1, 1), b3 + hstep, voffB); PG8_STAGE(PG8_SA(1, 0), a3, voffA);
            PG8_WAIT_V(8); PG8_WAIT_L(0); PG8_BAR; PG8_MMA(1, 0, At, B0); PG8_MMA(1, 1, At, B1); PG8_BAR; PG8_SCHED;
            } else {
            PG8_LDB(B0, 0, 0); PG8_SCHED; PG8_LDA(At, 0, 0); PG8_STAGE(PG8_SA(1, 1), a1 + hstep, voffA);
            PG8_WAIT_L(8); PG8_BAR; PG8_WAIT_L(0); PG8_MMA(0, 0, At, B0); PG8_BAR; PG8_SCHED;
            PG8_LDB(B1, 0, 1); PG8_STAGE(PG8_SB(0, 0), b2, voffB);
            PG8_BAR; PG8_WAIT_L(0); PG8_MMA(0, 1, At, B1); PG8_BAR;
            PG8_LDA(At, 0, 1); PG8_STAGE(PG8_SA(0, 0), a2, voffA);
            PG8_BAR; PG8_WAIT_L(0); PG8_MMA(1, 0, At, B0); PG8_BAR; PG8_SCHED;
            PG8_STAGE(PG8_SB(0, 1), b2 + hstep, voffB);
            PG8_WAIT_V(6); PG8_BAR; PG8_MMA(1, 1, At, B1); PG8_BAR;
            PG8_LDB(B0, 1, 0); PG8_SCHED; PG8_LDA(At, 1, 0); PG8_STAGE(PG8_SA(0, 1), a2 + hstep, voffA);
            PG8_WAIT_L(8); PG8_BAR; PG8_WAIT_L(0); PG8_MMA(0, 0, At, B0); PG8_BAR; PG8_SCHED;
            PG8_LDB(B1, 1, 1); PG8_STAGE(PG8_SB(1, 0), b3, voffB);
            PG8_BAR; PG8_WAIT_L(0); PG8_MMA(0, 1, At, B1); PG8_BAR;
            PG8_LDA(At, 1, 1); PG8_STAGE(PG8_SA(1, 0), a3, voffA);
            PG8_BAR; PG8_WAIT_L(0); PG8_MMA(1, 0, At, B0); PG8_BAR; PG8_SCHED;
            PG8_STAGE(PG8_SB(1, 1), b3 + hstep, voffB);
            PG8_WAIT_V(6); PG8_BAR; PG8_MMA(1, 1, At, B1); PG8_BAR;
            }
        }
        if constexpr (ALIGN_EPI) { if (wr == 0) PG8_BAR; }
        asm volatile("s_nop 15\n\ts_nop 15" ::: "memory");
        if constexpr (!Epi::AFTER_DRAIN) { E(acc, cur, wr, wc, fr, fq); S.done(cur); }
        if (!has_next) break;
#pragma unroll
        for (int a = 0; a < 2; ++a)
#pragma unroll
            for (int b = 0; b < 2; ++b)
#pragma unroll
                for (int m = 0; m < 4; ++m)
#pragma unroll
                    for (int n = 0; n < 2; ++n) acc[a][b][m][n] = (f32x4){0.f, 0.f, 0.f, 0.f};
        cur = nxt; cA = nA; cB = nB; ++ui;
        if constexpr (ALIGN_EPI) { if (wr == 1) PG8_BAR; }
    }
    PG8_WAIT_V(0);
    if constexpr (!ALIGN_EPI) { if (wr == 0) PG8_BAR; }
    PG8_BAR;
    if constexpr (Epi::AFTER_DRAIN) { E.fused(acc, cur, wr, wc, fr, fq, lds, wid, lane); S.done(cur); }
#undef PG8_SA
#undef PG8_SB
#undef PG8_STAGE
#undef PG8_LDA
#undef PG8_LDB
#undef PG8_MMA
#undef PG8_WAIT_V
#undef PG8_WAIT_L
#undef PG8_BAR
#undef PG8_SCHED
}

typedef int v8i __attribute__((ext_vector_type(8)));
typedef int v4i __attribute__((ext_vector_type(4)));
__host__ __device__ __forceinline__ int lds_byte8(int r, int c) { const int st = (r >> 4) * 2 + (c >> 5), rr = r & 15, cc = c & 31, ob = rr * 64 + cc * 2; return st * 1024 + (ob ^ (((ob >> 9) & 1) << 4)); }
__host__ __device__ __forceinline__ void stage_rc8(int b, int& R, int& C) { const int st = b / 1024, sb = b % 1024, swz = sb ^ (((sb >> 9) & 1) << 4); R = (st >> 1) * 16 + swz / 64; C = (st & 1) * 32 + (swz % 64) / 2; }
template <class Epi, class Sched, bool ALIGN_EPI, bool SP2, int SCA  , int SCB  >
__device__ __forceinline__ void gemm_phase_f8(PG8_LAS unsigned char* lds, const Gemm g, const Sched& S, const Epi& E, const int tid) {
    const int wid = __builtin_amdgcn_readfirstlane(tid >> 6), lane = tid & 63, wr = wid >> 2, wc = wid & 3, fr = lane & 15, fq = lane >> 4;
    const int K = g.K, nt = K / BK;
    unsigned voffA[2], voffB[2];
#pragma unroll
    for (int i = 0; i < 2; ++i) { int R, C; stage_rc8(tid * 16 + i * 8192, R, C); const int Rb = Epi::PERM ? ((R & ~31) + perm32(R & 31)) : R;
        voffA[i] = (unsigned)(R * K + C) * 2u; voffB[i] = (unsigned)(Rb * K + C) * 2u; }
    const size_t kstep = (size_t)(BK * 2);
    const size_t hstep = (size_t)HALF * K * 2;
    const size_t tstep = 2 * hstep;
    const unsigned ldsw = (unsigned)wid * 1024u;
    const int aoff = lds_byte8(wr * 64 + fr, fq * 16), boff = lds_byte8(wc * 32 + fr, fq * 16);
#define PG8_SA(b, h) (((b) * 2 + (h)) * HTB)
#define PG8_SB(b, h) ((4 + (b) * 2 + (h)) * HTB)
#define PG8_STAGE(bufoff, gbase, voff) do { _Pragma("unroll") for (int _i = 0; _i < 2; ++_i) \
        __builtin_amdgcn_global_load_lds((const unsigned*)((const char*)(gbase) + (voff)[_i]), (PG8_LAS unsigned*)(lds + (bufoff) + ldsw + _i * 8192), 16, 0, 0); } while (0)
#define PG8_LDA(dst, b, h) do { _Pragma("unroll") for (int m = 0; m < 4; ++m) { const u32x4 lo_ = *(const PG8_LAS u32x4*)(lds + PG8_SA(b, h) + aoff + m * 2048), hi_ = *(const PG8_LAS u32x4*)(lds + PG8_SA(b, h) + (aoff ^ 16) + m * 2048); \
        dst[m] = __builtin_shufflevector(__builtin_bit_cast(v4i, lo_), __builtin_bit_cast(v4i, hi_), 0, 1, 2, 3, 4, 5, 6, 7); } } while (0)
#define PG8_LDB(dst, b, h) do { _Pragma("unroll") for (int n = 0; n < 2; ++n) { const u32x4 lo_ = *(const PG8_LAS u32x4*)(lds + PG8_SB(b, h) + boff + n * 2048), hi_ = *(const PG8_LAS u32x4*)(lds + PG8_SB(b, h) + (boff ^ 16) + n * 2048); \
        dst[n] = __builtin_shufflevector(__builtin_bit_cast(v4i, lo_), __builtin_bit_cast(v4i, hi_), 0, 1, 2, 3, 4, 5, 6, 7); } } while (0)
#define PG8_MMA(ai, bj, At, Bt) do { __builtin_amdgcn_s_setprio(1); _Pragma("unroll") for (int m = 0; m < 4; ++m) _Pragma("unroll") for (int n = 0; n < 2; ++n) \
        asm volatile("v_mfma_scale_f32_16x16x128_f8f6f4 %0, %1, %2, %0, %3, %4 op_sel_hi:[0,0,0]" : "+v"(acc[ai][bj][m][n]) : "v"(Bt[n]), "v"(At[m]), "v"(scb_), "v"(sca_)); __builtin_amdgcn_s_setprio(0); } while (0)
#define PG8_WAIT_V(n) asm volatile("s_waitcnt vmcnt(" #n ")" ::: "memory")
#define PG8_WAIT_L(n) asm volatile("s_waitcnt lgkmcnt(" #n ")" ::: "memory")
#define PG8_BAR __builtin_amdgcn_s_barrier()
#define PG8_SCHED __builtin_amdgcn_sched_barrier(0)
    Unit cur, nxt; int ui = 0;
    if (!S.next(0, cur)) return;
    f32x4 acc[2][2][4][2];
#pragma unroll
    for (int a = 0; a < 2; ++a)
#pragma unroll
        for (int b = 0; b < 2; ++b)
#pragma unroll
            for (int m = 0; m < 4; ++m)
#pragma unroll
                for (int n = 0; n < 2; ++n) acc[a][b][m][n] = (f32x4){0.f, 0.f, 0.f, 0.f};
    v8i At[4], B0[2], B1[2]; const int scb_ = SCB, sca_ = SCA;
    const char* cA = (const char*)g.A + (size_t)cur.pm * tstep; const char* cB = (const char*)g.Bt + (size_t)cur.pn * tstep;
    S.a_ready(cur);
    if constexpr (SP2) {
        PG8_STAGE(PG8_SB(0, 0), cB, voffB); PG8_STAGE(PG8_SB(0, 1), cB + hstep, voffB); PG8_STAGE(PG8_SA(0, 0), cA, voffA); PG8_STAGE(PG8_SA(0, 1), cA + hstep, voffA);
        if (wr == 1) PG8_BAR;
        PG8_WAIT_V(2); PG8_BAR;
        PG8_STAGE(PG8_SB(1, 0), cB + kstep, voffB); PG8_STAGE(PG8_SA(1, 0), cA + kstep, voffA); PG8_STAGE(PG8_SB(1, 1), cB + hstep + kstep, voffB);
        PG8_WAIT_V(6); PG8_BAR;
    } else {
        PG8_STAGE(PG8_SB(0, 0), cB, voffB); PG8_STAGE(PG8_SA(0, 0), cA, voffA); PG8_STAGE(PG8_SB(0, 1), cB + hstep, voffB); PG8_STAGE(PG8_SA(0, 1), cA + hstep, voffA);
        if (wr == 1) PG8_BAR;
        PG8_WAIT_V(4); PG8_BAR;
        PG8_STAGE(PG8_SB(1, 0), cB + kstep, voffB); PG8_STAGE(PG8_SA(1, 0), cA + kstep, voffA); PG8_STAGE(PG8_SB(1, 1), cB + hstep + kstep, voffB);
        PG8_WAIT_V(6); PG8_BAR;
    }
    for (;;) {
        const bool has_next = S.next(ui + 1, nxt);
        const char* nA = has_next ? (const char*)g.A + (size_t)nxt.pm * tstep : cA; const char* nB = has_next ? (const char*)g.Bt + (size_t)nxt.pn * tstep : cB;
        for (int t = 0; t < nt; t += 2) {
            const bool last = (t == nt - 2);
            const char* a1 = cA + (size_t)(t + 1) * kstep;
            const char* a2 = last ? nA : cA + (size_t)(t + 2) * kstep; const char* b2 = last ? nB : cB + (size_t)(t + 2) * kstep;
            const char* a3 = a2 + kstep; const char* b3 = b2 + kstep;
            if (last && has_next) S.a_ready(nxt);
            if constexpr (SP2) {
            PG8_LDB(B0, 0, 0); PG8_LDB(B1, 0, 1); PG8_SCHED; PG8_LDA(At, 0, 0); PG8_STAGE(PG8_SA(1, 1), a1 + hstep, voffA);
            PG8_WAIT_V(8); PG8_WAIT_L(0); PG8_BAR; PG8_MMA(0, 0, At, B0); PG8_MMA(0, 1, At, B1); PG8_BAR; PG8_SCHED;
            PG8_LDA(At, 0, 1); PG8_STAGE(PG8_SB(0, 0), b2, voffB); PG8_STAGE(PG8_SB(0, 1), b2 + hstep, voffB); PG8_STAGE(PG8_SA(0, 0), a2, voffA);
            PG8_WAIT_V(8); PG8_WAIT_L(0); PG8_BAR; PG8_MMA(1, 0, At, B0); PG8_MMA(1, 1, At, B1); PG8_BAR; PG8_SCHED;
            PG8_LDB(B0, 1, 0); PG8_LDB(B1, 1, 1); PG8_SCHED; PG8_LDA(At, 1, 0); PG8_STAGE(PG8_SA(0, 1), a2 + hstep, voffA);
            PG8_WAIT_V(8); PG8_WAIT_L(0); PG8_BAR; PG8_MMA(0, 0, At, B0); PG8_MMA(0, 1, At, B1); PG8_BAR; PG8_SCHED;
            PG8_LDA(At, 1, 1); PG8_STAGE(PG8_SB(1, 0), b3, voffB); PG8_STAGE(PG8_SB(1, 1), b3 + hstep, voffB); PG8_STAGE(PG8_SA(1, 0), a3, voffA);
            PG8_WAIT_V(8); PG8_WAIT_L(0); PG8_BAR; PG8_MMA(1, 0, At, B0); PG8_MMA(1, 1, At, B1); PG8_BAR; PG8_SCHED;
            } else {
            PG8_LDB(B0, 0, 0); PG8_SCHED; PG8_LDA(At, 0, 0); PG8_STAGE(PG8_SA(1, 1), a1 + hstep, voffA);
            PG8_WAIT_L(8); PG8_BAR; PG8_WAIT_L(0); PG8_MMA(0, 0, At, B0); PG8_BAR; PG8_SCHED;
            PG8_LDB(B1, 0, 1); PG8_STAGE(PG8_SB(0, 0), b2, voffB);
            PG8_BAR; PG8_WAIT_L(0); PG8_MMA(0, 1, At, B1); PG8_BAR;
            PG8_LDA(At, 0, 1); PG8_STAGE(PG8_SA(0, 0), a2, voffA);
            PG8_BAR; PG8_WAIT_L(0); PG8_MMA(1, 0, At, B0); PG8_BAR; PG8_SCHED;
            PG8_STAGE(PG8_SB(0, 1), b2 + hstep, voffB);
            PG8_WAIT_V(6); PG8_BAR; PG8_MMA(1, 1, At, B1); PG8_BAR;
            PG8_LDB(B0, 1, 0); PG8_SCHED; PG8_LDA(At, 1, 0); PG8_STAGE(PG8_SA(0, 1), a2 + hstep, voffA);
            PG8_WAIT_L(8); PG8_BAR; PG8_WAIT_L(0); PG8_MMA(0, 0, At, B0); PG8_BAR; PG8_SCHED;
            PG8_LDB(B1, 1, 1); PG8_STAGE(PG8_SB(1, 0), b3, voffB);
            PG8_BAR; PG8_WAIT_L(0); PG8_MMA(0, 1, At, B1); PG8_BAR;
            PG8_LDA(At, 1, 1); PG8_STAGE(PG8_SA(1, 0), a3, voffA);
            PG8_BAR; PG8_WAIT_L(0); PG8_MMA(1, 0, At, B0); PG8_BAR; PG8_SCHED;
            PG8_STAGE(PG8_SB(1, 1), b3 + hstep, voffB);
            PG8_WAIT_V(6); PG8_BAR; PG8_MMA(1, 1, At, B1); PG8_BAR;
            }
        }
        if constexpr (ALIGN_EPI) { if (wr == 0) PG8_BAR; }
        asm volatile("s_nop 15\n\ts_nop 15" ::: "memory");
        if constexpr (!Epi::AFTER_DRAIN) { E(acc, cur, wr, wc, fr, fq); S.done(cur); }
        if (!has_next) break;
#pragma unroll
        for (int a = 0; a < 2; ++a)
#pragma unroll
            for (int b = 0; b < 2; ++b)
#pragma unroll
                for (int m = 0; m < 4; ++m)
#pragma unroll
                    for (int n = 0; n < 2; ++n) acc[a][b][m][n] = (f32x4){0.f, 0.f, 0.f, 0.f};
        cur = nxt; cA = nA; cB = nB; ++ui;
        if constexpr (ALIGN_EPI) { if (wr == 1) PG8_BAR; }
    }
    PG8_WAIT_V(0);
    if constexpr (!ALIGN_EPI) { if (wr == 0) PG8_BAR; }
    PG8_BAR;
    if constexpr (Epi::AFTER_DRAIN) { E.fused(acc, cur, wr, wc, fr, fq, lds, wid, lane); S.done(cur); }
#undef PG8_SA
#undef PG8_SB
#undef PG8_STAGE
#undef PG8_LDA
#undef PG8_LDB
#undef PG8_MMA
#undef PG8_WAIT_V
#undef PG8_WAIT_L
#undef PG8_BAR
#undef PG8_SCHED
}


template <class Epi, class Sched, bool ALIGN_EPI, bool SP2, int SCA  , int SCB  >
__device__ __forceinline__ void gemm_phase_f8g(PG8_LAS unsigned char* lds, const Gemm g, const Sched& S, const Epi& E, const int tid, const int* rowtab) {
    const int wid = __builtin_amdgcn_readfirstlane(tid >> 6), lane = tid & 63, wr = wid >> 2, wc = wid & 3, fr = lane & 15, fq = lane >> 4;
    const int K = g.K, nt = K / BK;
    unsigned voffA[2], voffB[2]; int gR0 = 0; unsigned gCb = 0;
#pragma unroll
    for (int i = 0; i < 2; ++i) { int R, C; stage_rc8(tid * 16 + i * 8192, R, C); const int Rb = Epi::PERM ? ((R & ~31) + perm32(R & 31)) : R;
        voffA[i] = (unsigned)(R * K + C) * 2u; voffB[i] = (unsigned)(Rb * K + C) * 2u; if (i == 0) { gR0 = R; gCb = (unsigned)C * 2u; } }
    const size_t kstep = (size_t)(BK * 2);
    const size_t hstep = (size_t)HALF * K * 2;
    const size_t tstep = 2 * hstep;
    const unsigned ldsw = (unsigned)wid * 1024u;
    const int aoff = lds_byte8(wr * 64 + fr, fq * 16), boff = lds_byte8(wc * 32 + fr, fq * 16);
#define PG8_SA(b, h) (((b) * 2 + (h)) * HTB)
#define PG8_SB(b, h) ((4 + (b) * 2 + (h)) * HTB)
#define PG8_STAGE(bufoff, gbase, voff) do { _Pragma("unroll") for (int _i = 0; _i < 2; ++_i) \
        __builtin_amdgcn_global_load_lds((const unsigned*)((const char*)(gbase) + (voff)[_i]), (PG8_LAS unsigned*)(lds + (bufoff) + ldsw + _i * 8192), 16, 0, 0); } while (0)
#define PG8_STAGE_G(bufoff, o0, o1, kb) do { __builtin_amdgcn_global_load_lds((const unsigned*)((const char*)g.A + (o0) + (kb)), (PG8_LAS unsigned*)(lds + (bufoff) + ldsw), 16, 0, 0); \
        __builtin_amdgcn_global_load_lds((const unsigned*)((const char*)g.A + (o1) + (kb)), (PG8_LAS unsigned*)(lds + (bufoff) + ldsw + 8192), 16, 0, 0); } while (0)
#define PG8_ROWOFF(dst, pm_) do { const int* rt_ = rowtab + (pm_) * 256 + gR0; const unsigned kb_ = 2u * (unsigned)K; \
        dst[0][0] = (unsigned)rt_[0] * kb_ + gCb; dst[0][1] = (unsigned)rt_[64] * kb_ + gCb; dst[1][0] = (unsigned)rt_[128] * kb_ + gCb; dst[1][1] = (unsigned)rt_[192] * kb_ + gCb; } while (0)
#define PG8_LDA(dst, b, h) do { _Pragma("unroll") for (int m = 0; m < 4; ++m) { const u32x4 lo_ = *(const PG8_LAS u32x4*)(lds + PG8_SA(b, h) + aoff + m * 2048), hi_ = *(const PG8_LAS u32x4*)(lds + PG8_SA(b, h) + (aoff ^ 16) + m * 2048); \
        dst[m] = __builtin_shufflevector(__builtin_bit_cast(v4i, lo_), __builtin_bit_cast(v4i, hi_), 0, 1, 2, 3, 4, 5, 6, 7); } } while (0)
#define PG8_LDB(dst, b, h) do { _Pragma("unroll") for (int n = 0; n < 2; ++n) { const u32x4 lo_ = *(const PG8_LAS u32x4*)(lds + PG8_SB(b, h) + boff + n * 2048), hi_ = *(const PG8_LAS u32x4*)(lds + PG8_SB(b, h) + (boff ^ 16) + n * 2048); \
        dst[n] = __builtin_shufflevector(__builtin_bit_cast(v4i, lo_), __builtin_bit_cast(v4i, hi_), 0, 1, 2, 3, 4, 5, 6, 7); } } while (0)
#define PG8_MMA(ai, bj, At, Bt) do { __builtin_amdgcn_s_setprio(1); _Pragma("unroll") for (int m = 0; m < 4; ++m) _Pragma("unroll") for (int n = 0; n < 2; ++n) \
        asm volatile("v_mfma_scale_f32_16x16x128_f8f6f4 %0, %1, %2, %0, %3, %4 op_sel_hi:[0,0,0]" : "+v"(acc[ai][bj][m][n]) : "v"(Bt[n]), "v"(At[m]), "v"(scb_), "v"(sca_)); __builtin_amdgcn_s_setprio(0); } while (0)
#define PG8_WAIT_V(n) asm volatile("s_waitcnt vmcnt(" #n ")" ::: "memory")
#define PG8_WAIT_L(n) asm volatile("s_waitcnt lgkmcnt(" #n ")" ::: "memory")
#define PG8_BAR __builtin_amdgcn_s_barrier()
#define PG8_SCHED __builtin_amdgcn_sched_barrier(0)
    Unit cur, nxt; int ui = 0;
    if (!S.next(0, cur)) return;
    f32x4 acc[2][2][4][2];
#pragma unroll
    for (int a = 0; a < 2; ++a)
#pragma unroll
        for (int b = 0; b < 2; ++b)
#pragma unroll
            for (int m = 0; m < 4; ++m)
#pragma unroll
                for (int n = 0; n < 2; ++n) acc[a][b][m][n] = (f32x4){0.f, 0.f, 0.f, 0.f};
    v8i At[4], B0[2], B1[2]; const int scb_ = SCB, sca_ = SCA;
    const char* cA = (const char*)g.A + (size_t)cur.pm * tstep; const char* cB = (const char*)g.Bt + (size_t)cur.pn * tstep;
    S.a_ready(cur);
    unsigned co[2][2], no[2][2]; PG8_ROWOFF(co, cur.pm);
    if constexpr (SP2) {
        PG8_STAGE(PG8_SB(0, 0), cB, voffB); PG8_STAGE(PG8_SB(0, 1), cB + hstep, voffB); PG8_STAGE_G(PG8_SA(0, 0), co[0][0], co[0][1], 0); PG8_STAGE_G(PG8_SA(0, 1), co[1][0], co[1][1], 0);
        if (wr == 1) PG8_BAR;
        PG8_WAIT_V(2); PG8_BAR;
        PG8_STAGE(PG8_SB(1, 0), cB + kstep, voffB); PG8_STAGE_G(PG8_SA(1, 0), co[0][0], co[0][1], kstep); PG8_STAGE(PG8_SB(1, 1), cB + hstep + kstep, voffB);
        PG8_WAIT_V(6); PG8_BAR;
    } else {
        PG8_STAGE(PG8_SB(0, 0), cB, voffB); PG8_STAGE(PG8_SA(0, 0), cA, voffA); PG8_STAGE(PG8_SB(0, 1), cB + hstep, voffB); PG8_STAGE(PG8_SA(0, 1), cA + hstep, voffA);
        if (wr == 1) PG8_BAR;
        PG8_WAIT_V(4); PG8_BAR;
        PG8_STAGE(PG8_SB(1, 0), cB + kstep, voffB); PG8_STAGE(PG8_SA(1, 0), cA + kstep, voffA); PG8_STAGE(PG8_SB(1, 1), cB + hstep + kstep, voffB);
        PG8_WAIT_V(6); PG8_BAR;
    }
    for (;;) {
        const bool has_next = S.next(ui + 1, nxt);
        const char* nA = cA; const char* nB = has_next ? (const char*)g.Bt + (size_t)nxt.pn * tstep : cB;
        if (has_next) PG8_ROWOFF(no, nxt.pm); else { no[0][0] = co[0][0]; no[0][1] = co[0][1]; no[1][0] = co[1][0]; no[1][1] = co[1][1]; }
        for (int t = 0; t < nt; t += 2) {
            const bool last = (t == nt - 2);
            const char* a1 = cA + (size_t)(t + 1) * kstep;
            const char* a2 = last ? nA : cA + (size_t)(t + 2) * kstep; const char* b2 = last ? nB : cB + (size_t)(t + 2) * kstep;
            const char* a3 = a2 + kstep; const char* b3 = b2 + kstep;
            if (last && has_next) S.a_ready(nxt);
            const unsigned s00 = last ? no[0][0] : co[0][0], s01 = last ? no[0][1] : co[0][1], s10 = last ? no[1][0] : co[1][0], s11 = last ? no[1][1] : co[1][1];
            const size_t k1 = (size_t)(t + 1) * kstep, k2 = last ? (size_t)0 : (size_t)(t + 2) * kstep;
            if constexpr (SP2) {
            PG8_LDB(B0, 0, 0); PG8_LDB(B1, 0, 1); PG8_SCHED; PG8_LDA(At, 0, 0); PG8_STAGE_G(PG8_SA(1, 1), co[1][0], co[1][1], k1);
            PG8_WAIT_V(8); PG8_WAIT_L(0); PG8_BAR; PG8_MMA(0, 0, At, B0); PG8_MMA(0, 1, At, B1); PG8_BAR; PG8_SCHED;
            PG8_LDA(At, 0, 1); PG8_STAGE(PG8_SB(0, 0), b2, voffB); PG8_STAGE(PG8_SB(0, 1), b2 + hstep, voffB); PG8_STAGE_G(PG8_SA(0, 0), s00, s01, k2);
            PG8_WAIT_V(8); PG8_WAIT_L(0); PG8_BAR; PG8_MMA(1, 0, At, B0); PG8_MMA(1, 1, At, B1); PG8_BAR; PG8_SCHED;
            PG8_LDB(B0, 1, 0); PG8_LDB(B1, 1, 1); PG8_SCHED; PG8_LDA(At, 1, 0); PG8_STAGE_G(PG8_SA(0, 1), s10, s11, k2);
            PG8_WAIT_V(8); PG8_WAIT_L(0); PG8_BAR; PG8_MMA(0, 0, At, B0); PG8_MMA(0, 1, At, B1); PG8_BAR; PG8_SCHED;
            PG8_LDA(At, 1, 1); PG8_STAGE(PG8_SB(1, 0), b3, voffB); PG8_STAGE(PG8_SB(1, 1), b3 + hstep, voffB); PG8_STAGE_G(PG8_SA(1, 0), s00, s01, k2 + kstep);
            PG8_WAIT_V(8); PG8_WAIT_L(0); PG8_BAR; PG8_MMA(1, 0, At, B0); PG8_MMA(1, 1, At, B1); PG8_BAR; PG8_SCHED;
            } else {
            PG8_LDB(B0, 0, 0); PG8_SCHED; PG8_LDA(At, 0, 0); PG8_STAGE(PG8_SA(1, 1), a1 + hstep, voffA);
            PG8_WAIT_L(8); PG8_BAR; PG8_WAIT_L(0); PG8_MMA(0, 0, At, B0); PG8_BAR; PG8_SCHED;
            PG8_LDB(B1, 0, 1); PG8_STAGE(PG8_SB(0, 0), b2, voffB);
            PG8_BAR; PG8_WAIT_L(0); PG8_MMA(0, 1, At, B1); PG8_BAR;
            PG8_LDA(At, 0, 1); PG8_STAGE(PG8_SA(0, 0), a2, voffA);
            PG8_BAR; PG8_WAIT_L(0); PG8_MMA(1, 0, At, B0); PG8_BAR; PG8_SCHED;
            PG8_STAGE(PG8_SB(0, 1), b2 + hstep, voffB);
            PG8_WAIT_V(6); PG8_BAR; PG8_MMA(1, 1, At, B1); PG8_BAR;
            PG8_LDB(B0, 1, 0); PG8_SCHED; PG8_LDA(At, 1, 0); PG8_STAGE(PG8_SA(0, 1), a2 + hstep, voffA);
            PG8_WAIT_L(8); PG8_BAR; PG8_WAIT_L(0); PG8_MMA(0, 0, At, B0); PG8_BAR; PG8_SCHED;
            PG8_LDB(B1, 1, 1); PG8_STAGE(PG8_SB(1, 0), b3, voffB);
            PG8_BAR; PG8_WAIT_L(0); PG8_MMA(0, 1, At, B1); PG8_BAR;
            PG8_LDA(At, 1, 1); PG8_STAGE(PG8_SA(1, 0), a3, voffA);
            PG8_BAR; PG8_WAIT_L(0); PG8_MMA(1, 0, At, B0); PG8_BAR; PG8_SCHED;
            PG8_STAGE(PG8_SB(1, 1), b3 + hstep, voffB);
            PG8_WAIT_V(6); PG8_BAR; PG8_MMA(1, 1, At, B1); PG8_BAR;
            }
        }
        if constexpr (ALIGN_EPI) { if (wr == 0) PG8_BAR; }
        asm volatile("s_nop 15\n\ts_nop 15" ::: "memory");
        if constexpr (!Epi::AFTER_DRAIN) { E(acc, cur, wr, wc, fr, fq); S.done(cur); }
        if (!has_next) break;
#pragma unroll
        for (int a = 0; a < 2; ++a)
#pragma unroll
            for (int b = 0; b < 2; ++b)
#pragma unroll
                for (int m = 0; m < 4; ++m)
#pragma unroll
                    for (int n = 0; n < 2; ++n) acc[a][b][m][n] = (f32x4){0.f, 0.f, 0.f, 0.f};
        cur = nxt; cA = nA; cB = nB; ++ui; co[0][0] = no[0][0]; co[0][1] = no[0][1]; co[1][0] = no[1][0]; co[1][1] = no[1][1];
        if constexpr (ALIGN_EPI) { if (wr == 1) PG8_BAR; }
    }
    PG8_WAIT_V(0);
    if constexpr (!ALIGN_EPI) { if (wr == 0) PG8_BAR; }
    PG8_BAR;
    if constexpr (Epi::AFTER_DRAIN) { E.fused(acc, cur, wr, wc, fr, fq, lds, wid, lane); S.done(cur); }
#undef PG8_SA
#undef PG8_SB
#undef PG8_STAGE
#undef PG8_STAGE_G
#undef PG8_ROWOFF
#undef PG8_LDA
#undef PG8_LDB
#undef PG8_MMA
#undef PG8_WAIT_V
#undef PG8_WAIT_L
#undef PG8_BAR
#undef PG8_SCHED
}


}

#ifndef ATTN_NAIVE
#define ATTN_NAIVE 0
#endif
#ifndef REP_MASK
#define REP_MASK 0
#endif
#define REPEAT(j) for (int rep_ = 0; rep_ < ((REP_MASK >> (j)) & 1) + 1; ++rep_)
#ifndef MLSTM_NAIVE
#define MLSTM_NAIVE 0
#endif
constexpr int D = 1024, BATCH = 8, SEQ = 4096, DEPTH = 4, NTOK = BATCH * SEQ, NMEM = 256, NE = 16, CAP = 512, DFF = 2048, NSLOT = BATCH * NE * CAP;
constexpr int DIN = 2576, NPROJ = 2560;
constexpr int C_MQ = 0, C_MK = 256, C_MV = 512, C_MO = 1024, C_NQ = 1536, C_NK = 1792, C_NV = 2048, C_CQ = 2304;
constexpr int GATE_COL = 1536;
constexpr float EPS = 1e-6f;
constexpr int NPHASE = 2 + 11 * DEPTH + 1;

constexpr int LDS_BYTES = 147456;
constexpr int LDS_SCR = 256;

#define LAS __attribute__((address_space(3)))
typedef pg8::bf16_t bf16_t;
typedef pg8::f32x4 f32x4;
typedef pg8::u32x4 u32x4;
typedef unsigned u32x2 __attribute__((ext_vector_type(2)));
typedef float f32x2 __attribute__((ext_vector_type(2)));
#define LDS_WAIT() asm volatile("s_waitcnt lgkmcnt(0)" ::: "memory")
#ifndef Y8_FROM
#define Y8_FROM 1
#endif
#define GAS __attribute__((address_space(1)))
#define LAUNDER_V(x) asm volatile("" : "+v"(x))
#define LAUNDER_S(x) asm volatile("" : "+s"(x))
__device__ __forceinline__ int fresh_tid(int wave0) { int t_; asm volatile("v_mbcnt_lo_u32_b32 %0, -1, 0\n\tv_mbcnt_hi_u32_b32 %0, -1, %0" : "=v"(t_)); return (wave0 << 6) | t_; }
#define FRESH_TID() fresh_tid(wave0)
__device__ __forceinline__ float bflo(unsigned w) { return __uint_as_float(w << 16); }
__device__ __forceinline__ float bfhi(unsigned w) { return __uint_as_float(w & 0xffff0000u); }
__device__ __forceinline__ float bf1(bf16_t h) { return __uint_as_float(((unsigned)h) << 16); }
__device__ __forceinline__ unsigned pk2(float lo, float hi) { return pg8::cvt_pk_bf16(lo, hi); }
__device__ __forceinline__ unsigned f2bf_c(float f) { const unsigned u = __float_as_uint(f); return (u + 0x7fffu + ((u >> 16) & 1u)) >> 16; }
__device__ __forceinline__ unsigned pk2c(float lo, float hi) { return f2bf_c(lo) | (f2bf_c(hi) << 16); }
__device__ __forceinline__ float wave_sum(float v, int lane) {
#pragma unroll
    for (int o = 1; o < 64; o <<= 1) v += shx(v, o, lane);
    return v;
}
#define DPPF(v, ctrl) __int_as_float(__builtin_amdgcn_update_dpp(0, __float_as_int(v), (ctrl), 0xF, 0xF, true))
__device__ __forceinline__ float row_sum16(float v) { v += DPPF(v, 0xB1); v += DPPF(v, 0x4E); v += DPPF(v, 0x141); v += DPPF(v, 0x140); return v; }
__device__ __forceinline__ float row_max16(float v) { v = fmaxf(v, DPPF(v, 0xB1)); v = fmaxf(v, DPPF(v, 0x4E)); v = fmaxf(v, DPPF(v, 0x141)); v = fmaxf(v, DPPF(v, 0x140)); return v; }
__device__ __forceinline__ float wave_sum_fast(float v) { return rows_sum4(row_sum16(v)); }
#define SWZF(v, pat) __int_as_float(__builtin_amdgcn_ds_swizzle(__float_as_int(v), (pat)))
__device__ __forceinline__ float sigmoidf_(float x) { return __builtin_amdgcn_rcpf(1.0f + __expf(-x)); }

#define XB_TMO      128
#define XB_XCNT(j)  (256  + 64 * (j))
#define XB_XSUB(j)  (1280 + 64 * (j))
#define XB_XGEN(j)  (2304 + 64 * (j))
#define XB_TOP      3328
#define XB_TOPGEN   3392
#define XCD_BAR_WORDS 3456
#define XB_SPIN_CAP (1u << 18)
__device__ __forceinline__ unsigned xb_ld(unsigned* p)              { return __hip_atomic_load(p, __ATOMIC_RELAXED, __HIP_MEMORY_SCOPE_AGENT); }
__device__ __forceinline__ unsigned xb_add(unsigned* p, unsigned v) { return __hip_atomic_fetch_add(p, v, __ATOMIC_RELAXED, __HIP_MEMORY_SCOPE_AGENT); }
__device__ __forceinline__ unsigned xb_xcc_id() { return (unsigned)__builtin_amdgcn_s_getreg((3 << 11) | 20) & 0xFu; }
#define XB_SPIN(cond, bar) do { unsigned _sp = 0; while (cond) { __builtin_amdgcn_s_sleep(1); \
    if ((++_sp & 255u) == 0u) { if (xb_ld(&(bar)[XB_TMO])) break; if (_sp > XB_SPIN_CAP) { atomicAdd(&(bar)[XB_TMO], 1u); break; } } } } while (0)
struct XcdBarrier { unsigned* bar; unsigned x; volatile LAS unsigned* st; int w0; };
__device__ __forceinline__ XcdBarrier xcd_barrier_post(unsigned* bar, volatile LAS unsigned* st, int w0) {
    XcdBarrier b; b.bar = bar; b.x = xb_xcc_id(); b.st = st; b.w0 = w0;
    if (fresh_tid(w0) == 0) (void)xb_add(&bar[XB_XCNT(b.x)], 1u);
    return b;
}
__device__ __forceinline__ void xcd_barrier_complete(unsigned* bar, unsigned x, unsigned& nloc, unsigned& nx) {
    const unsigned G = gridDim.x * gridDim.y * gridDim.z;
    unsigned sum, cnt, mine, sp = 0u;
    for (;;) {
        sum = 0u; cnt = 0u; mine = 0u;
#pragma unroll
        for (unsigned j = 0; j < 16; ++j) { const unsigned c = xb_ld(&bar[XB_XCNT(j)]); sum += c; cnt += (c > 0u) ? 1u : 0u; mine = (j == x) ? c : mine; }
        if (sum == G) break;
        __builtin_amdgcn_s_sleep(1);
        if ((++sp & 255u) == 0u) { if (xb_ld(&bar[XB_TMO])) break; if (sp > XB_SPIN_CAP) { atomicAdd(&bar[XB_TMO], 1u); break; } }
    }
    nloc = mine > 0u ? mine : 1u; nx = cnt > 0u ? cnt : 1u;
}
__device__ __forceinline__ void xcd_barrier(const XcdBarrier& b) {
    asm volatile("s_waitcnt vmcnt(0)" ::: "memory");
    __syncthreads();
    if (fresh_tid(b.w0) == 0) {
        unsigned* bar = b.bar;
        __builtin_amdgcn_s_waitcnt(0);
        unsigned nloc = b.st[0], nx = b.st[1];
        if (nloc == 0u) { xcd_barrier_complete(bar, b.x, nloc, nx); b.st[0] = nloc; b.st[1] = nx; }
        const unsigned old = xb_add(&bar[XB_XSUB(b.x)], 1u);
        const unsigned gen = old / nloc;
        if (old + 1u == (gen + 1u) * nloc) {
            __builtin_amdgcn_fence(__ATOMIC_RELEASE, "agent");
            asm volatile("s_waitcnt vmcnt(0)" ::: "memory");
            const unsigned og = xb_add(&bar[XB_TOP], 1u);
            const unsigned tg = og / nx;
            if (og + 1u == (tg + 1u) * nx) xb_add(&bar[XB_TOPGEN], 1u);
            else XB_SPIN(xb_ld(&bar[XB_TOPGEN]) == tg, bar);
            __builtin_amdgcn_fence(__ATOMIC_ACQUIRE, "agent");
            xb_add(&bar[XB_XGEN(b.x)], 1u);
            asm volatile("s_waitcnt vmcnt(0)" ::: "memory");
        } else {
            XB_SPIN(xb_ld(&bar[XB_XGEN(b.x)]) == gen, bar);
            __builtin_amdgcn_fence(__ATOMIC_ACQUIRE, "agent");
            asm volatile("s_waitcnt vmcnt(0)" ::: "memory");
        }
    }
    __syncthreads();
}

struct Params {
    const float *x, *mem, *g_mix, *w_in, *b_gates, *conv_qk, *g_mh, *na_gq, *na_gk, *na_rpb, *g_mem, *w_mem_kv, *mem_gq, *mem_gk, *w_out, *g_ffn, *w_router, *w1, *w3, *w2;
    float* out; unsigned char* ws; int ph_lo, ph_hi, li, pad;
};

__device__ __forceinline__ void tr_tile(const float* src, int ldw, bf16_t* dst, int K, LAS float* scr, int lane, int jump = 0, const float* ksc = nullptr) {
    f32x4 v[16]; const int c = lane & 7;
    f32x4 g0 = {1.f, 1.f, 1.f, 1.f}, g1 = g0;
#pragma unroll
    for (int i = 0; i < 16; ++i) v[i] = *(const f32x4*)(src + (size_t)(4 * i + (lane >> 4)) * ldw + 4 * (lane & 15));
    if (ksc) { g0 = *(const f32x4*)(ksc + 8 * c); g1 = *(const f32x4*)(ksc + 8 * c + 4); }
#pragma unroll
    for (int i = 0; i < 16; ++i) { LAS float* s = scr + (4 * i + (lane >> 4)) * 65 + 4 * (lane & 15); s[0] = v[i].x; s[1] = v[i].y; s[2] = v[i].z; s[3] = v[i].w; }
    LDS_WAIT();
#pragma unroll
    for (int j = 0; j < 8; ++j) { const int n = (lane >> 3) + 8 * j; const LAS float* s = scr + (8 * c) * 65 + n;
        u32x4 o; o.x = pk2(s[0] * g0.x, s[65] * g0.y); o.y = pk2(s[130] * g0.z, s[195] * g0.w); o.z = pk2(s[260] * g1.x, s[325] * g1.y); o.w = pk2(s[390] * g1.z, s[455] * g1.w);
        *(u32x4*)(dst + (size_t)(n + (n >= 32 ? jump : 0)) * K + 8 * c) = o; }
    LDS_WAIT();
}
__device__ __forceinline__ void tr8_load(const float* src, int ldw, int lane, f32x4 (&v)[16]) {
#pragma unroll
    for (int i = 0; i < 16; ++i) v[i] = *(const f32x4*)(src + (size_t)(4 * i + (lane >> 4)) * ldw + 4 * (lane & 15));
}
__device__ __forceinline__ void tr8_finish(const f32x4 (&v)[16], unsigned char* dst, int K, LAS float* scr, int lane) {
#pragma unroll
    for (int i = 0; i < 16; ++i) { LAS float* s = scr + (4 * i + (lane >> 4)) * 65 + 4 * (lane & 15); s[0] = v[i].x; s[1] = v[i].y; s[2] = v[i].z; s[3] = v[i].w; }
    LDS_WAIT();
    const int c = lane & 7;
#pragma unroll
    for (int j = 0; j < 8; ++j) { const int n = (lane >> 3) + 8 * j; const LAS float* s = scr + (8 * c) * 65 + n;
        u32x2 o; o.x = pg8::pk4_fp8(256.f * s[0], 256.f * s[65], 256.f * s[130], 256.f * s[195]); o.y = pg8::pk4_fp8(256.f * s[260], 256.f * s[325], 256.f * s[390], 256.f * s[455]);
        *(u32x2*)(dst + (size_t)n * K + 8 * c) = o; }
    LDS_WAIT();
}
__device__ __forceinline__ void f8_tile(const Params& p, unsigned char* ws_, int it, const float*& src, int& ldw, unsigned char*& dst, int& K) {
    constexpr int T_W1 = 64 * 512;
    if (it < 2 * T_W1) { const int which = it / T_W1, r = it - which * T_W1, le = r >> 9, q = r & 511, kb = q >> 5, nb = q & 31, n0 = nb * 64, drow = (n0 >> 7) * 256 + (n0 & 127) + which * 128;
        src = (which ? p.w3 : p.w1) + (size_t)le * D * DFF + (size_t)kb * 64 * DFF + n0; ldw = DFF; dst = ws_ + WS_W13 + ((size_t)le * 4096 + drow) * D + kb * 64; K = D; }
    else { const int r = it - 2 * T_W1, le = r >> 9, q = r & 511, kb = q >> 4, nb = q & 15;
        src = p.w2 + (size_t)le * DFF * D + (size_t)kb * 64 * D + nb * 64; ldw = D; dst = ws_ + WS_W2 + ((size_t)le * D + nb * 64) * DFF + kb * 64; K = DFF; }
}
__device__ __forceinline__ void tr_tile8(const float* src, int ldw, unsigned char* dst, int K, LAS float* scr, int lane) {
#pragma unroll 4
    for (int i = 0; i < 16; ++i) { const int kk = 4 * i + (lane >> 4); const f32x4 v = *(const f32x4*)(src + (size_t)kk * ldw + 4 * (lane & 15));
        LAS float* s = scr + kk * 65 + 4 * (lane & 15); s[0] = v.x; s[1] = v.y; s[2] = v.z; s[3] = v.w; }
    LDS_WAIT();
    const int c = lane & 7;
#pragma unroll
    for (int j = 0; j < 8; ++j) { const int n = (lane >> 3) + 8 * j; const LAS float* s = scr + (8 * c) * 65 + n;
        u32x2 o; o.x = pg8::pk4_fp8(256.f * s[0], 256.f * s[65], 256.f * s[130], 256.f * s[195]); o.y = pg8::pk4_fp8(256.f * s[260], 256.f * s[325], 256.f * s[390], 256.f * s[455]);
        *(u32x2*)(dst + (size_t)n * K + 8 * c) = o; }
    LDS_WAIT();
}
__device__ __forceinline__ void ph_cvt_experts(const Params& p, LAS unsigned char* lds, const int tid, int G, int bid) {
    unsigned char* ws_ = p.ws; LAUNDER_S(ws_);
    const int lane = tid & 63, wave = __builtin_amdgcn_readfirstlane(tid >> 6);
    constexpr int NB = 3 * 4096;
    const bool shift = (G == 256);
    const int nmine = (NB - bid + G - 1) / G, nown = shift && bid < 64 ? 45 : nmine, n = shift && bid >= 64 ? nmine + 1 : nown;
    {
        LAS float* tile = (LAS float*)(lds + LDS_SCR);
        f32x4 cur[16]; const float* src = nullptr; int ldw = 0; unsigned char* dst = nullptr; int Kd = 0, hi = 0;
#define CVT_DECODE(I, src_, ldw_, dst_, K_, hi_) do { const int mtx = (I) >> 12, r_ = (I) & 4095, le = r_ >> 6, q_ = r_ & 63; \
            if (mtx < 2) { const int kb = q_ >> 3, nb = q_ & 7; \
                src_ = (mtx ? p.w3 : p.w1) + (size_t)le * D * DFF + (size_t)kb * 128 * DFF + nb * 256; ldw_ = DFF; dst_ = ws_ + WS_W13 + ((size_t)le * 4096 + nb * 512 + mtx * 128) * D + kb * 128; K_ = D; hi_ = 128; } \
            else { const int kb = q_ >> 2, nb = q_ & 3; \
                src_ = p.w2 + (size_t)le * DFF * D + (size_t)kb * 128 * D + nb * 256; ldw_ = D; dst_ = ws_ + WS_W2 + ((size_t)le * D + nb * 256) * DFF + kb * 128; K_ = DFF; hi_ = 0; } } while (0)
#define CVT_LOAD(v, src_, ldw_) do { _Pragma("unroll") for (int i = 0; i < 16; ++i) v[i] = *(const f32x4*)((src_) + (size_t)(16 * wave + i) * (ldw_) + 4 * lane); } while (0)
#define CVT_PROC(v, dst_, K_, hi_) do { \
            _Pragma("unroll") for (int i = 0; i < 16; ++i) { const int k = 16 * wave + i; *(LAS f32x4*)(tile + k * 256 + ((4 * lane) ^ ((k >> 3) << 2))) = v[i]; } \
            __syncthreads(); \
            { const int c = lane & 15; \
              _Pragma("unroll") for (int j = 0; j < 8; ++j) { const int n = 32 * wave + 4 * j + (lane >> 4); const LAS float* t1 = tile + (8 * c) * 256 + (n ^ (c << 2)); \
                  u32x2 o; o.x = pg8::pk4_fp8s(t1[0], t1[256], t1[512], t1[768], 0.00390625f); o.y = pg8::pk4_fp8s(t1[1024], t1[1280], t1[1536], t1[1792], 0.00390625f); \
                  *(u32x2*)((dst_) + (size_t)(n + (n >> 7) * (hi_)) * (K_) + 8 * c) = o; } } \
            __syncthreads(); } while (0)
        f32x4 vb[16]; const float* srcb = nullptr; int ldwb = 0; unsigned char* dstb = nullptr; int Kb = 0, hib = 0;
#define CVT_BLK(t_) ((t_) < nown ? bid + (t_) * G : ((bid - 64) & 63) + (45 + ((bid - 64) >> 6)) * G)
        int t = 0;
        if (t < n) { const int I = CVT_BLK(t); CVT_DECODE(I, src, ldw, dst, Kd, hi); CVT_LOAD(cur, src, ldw); }
#pragma unroll 1
        while (t < n) {
            if (t + 1 < n) { const int I2 = CVT_BLK(t + 1); CVT_DECODE(I2, srcb, ldwb, dstb, Kb, hib); CVT_LOAD(vb, srcb, ldwb); }
            CVT_PROC(cur, dst, Kd, hi);
            if (t + 1 >= n) break;
            if (t + 2 < n) { const int I3 = CVT_BLK(t + 2); CVT_DECODE(I3, src, ldw, dst, Kd, hi); CVT_LOAD(cur, src, ldw); }
            CVT_PROC(vb, dstb, Kb, hib);
            t += 2; }
#undef CVT_BLK
#undef CVT_PROC
#undef CVT_DECODE
#undef CVT_LOAD
    }
}
__device__ __forceinline__ void ph_convert(const Params& p, LAS unsigned char* lds, const int tid, int G, int bid) {
    unsigned char* ws_ = p.ws; LAUNDER_S(ws_);
    const int lane = tid & 63, wave = __builtin_amdgcn_readfirstlane(tid >> 6);
    LAS float* scr = (LAS float*)(lds + LDS_SCR + wave * 16640);
    const int gw = bid * 8 + wave, NGW = G * 8;
    bf16_t* w13t = (bf16_t*)(ws_ + WS_W13); bf16_t* w2t = (bf16_t*)(ws_ + WS_W2); bf16_t* wint = (bf16_t*)(ws_ + WS_WIN); bf16_t* wkvt = (bf16_t*)(ws_ + WS_WKV); bf16_t* woutt = (bf16_t*)(ws_ + WS_WOUT);
    constexpr int T_IN = 4 * 16 * 40, T_KV = 4 * 16 * 8, T_OUT = 4 * 16 * 16;
    for (int it = gw; it < T_IN + T_KV + T_OUT; it += NGW) {
        int r = it;
        if (r < T_IN) { const int l = r / 640, q = r % 640, kb = q / 40, nb = q % 40, n0 = nb * 64, sc = n0 < GATE_COL ? n0 : n0 + 16;
            const int tile = n0 >> 8; const bool hp = (tile == 6 || tile == 7 || tile == 9); const int drow = hp ? (tile * 256 + 32 * ((n0 & 255) >> 6)) : n0;
            tr_tile(p.w_in + (size_t)l * D * DIN + (size_t)kb * 64 * DIN + sc, DIN, wint + ((size_t)l * NPROJ + drow) * D + kb * 64, D, scr, lane, hp ? 96 : 0, p.g_mix + l * D + kb * 64); continue; }
        r -= T_IN;
        if (r < T_KV) { const int l = r >> 7, q = r & 127, kb = q >> 3, nb = q & 7;
            const bool hp = nb < 4; const int drow = hp ? 32 * nb : nb * 64;
            tr_tile(p.w_mem_kv + (size_t)l * D * 512 + (size_t)kb * 64 * 512 + nb * 64, 512, wkvt + ((size_t)l * 512 + drow) * D + kb * 64, D, scr, lane, hp ? 96 : 0); continue; }
        r -= T_KV;
        { const int l = r >> 8, q = r & 255, kb = q >> 4, nb = q & 15;
            if (l >= Y8_FROM) tr_tile8(p.w_out + (size_t)l * D * D + (size_t)kb * 64 * D + nb * 64, D, (unsigned char*)(woutt + (size_t)l * D * D) + (size_t)(nb * 64) * D + kb * 64, D, scr, lane);
          else tr_tile(p.w_out + (size_t)l * D * D + (size_t)kb * 64 * D + nb * 64, D, woutt + ((size_t)l * D + nb * 64) * D + kb * 64, D, scr, lane); }
    }
    bf16_t* memh = (bf16_t*)(ws_ + WS_MEMH);
    for (int r = gw; r < BATCH * NMEM; r += NGW) {
        const f32x4* xr = (const f32x4*)(p.mem + (size_t)r * D) + lane; f32x4 v[4]; float ss = 0.f;
#pragma unroll
        for (int j = 0; j < 4; ++j) { v[j] = xr[64 * j]; ss += v[j].x * v[j].x + v[j].y * v[j].y + v[j].z * v[j].z + v[j].w * v[j].w; }
        const float rr = rsqrtf(wave_sum(ss, lane) * (1.f / D) + EPS);
        f32x4 gm[DEPTH][4];
#pragma unroll
        for (int l = 0; l < DEPTH; ++l)
#pragma unroll
            for (int j = 0; j < 4; ++j) gm[l][j] = *((const f32x4*)(p.g_mem + l * D) + lane + 64 * j);
#pragma unroll
        for (int l = 0; l < DEPTH; ++l) { u32x2* o = (u32x2*)(memh + ((size_t)l * BATCH * NMEM + r) * D) + lane;
#pragma unroll
            for (int j = 0; j < 4; ++j) { const f32x4 g = gm[l][j]; u32x2 w; w.x = pk2(v[j].x * rr * g.x, v[j].y * rr * g.y); w.y = pk2(v[j].z * rr * g.z, v[j].w * rr * g.w); o[64 * j] = w; } }
    }
    { float* gt = (float*)(ws_ + WS_GT); const int i = bid * 512 + tid;
      if (i < DEPTH * 192) { const int l = i / 192, q = i % 192, w = q >> 6, d = q & 63; gt[i] = (w == 0 ? p.na_gq : (w == 1 ? p.na_gk : p.mem_gq))[l * 64 + d]; } }
}

__device__ __forceinline__ float reduce16(float (&pv)[16], int lane) {
    float a8[8], a4[4], a2[2];
#pragma unroll
    for (int i = 0; i < 8; ++i) { const bool od = lane & 1; const float keep = od ? pv[2 * i + 1] : pv[2 * i], send = od ? pv[2 * i] : pv[2 * i + 1]; a8[i] = keep + DPPF(send, 0xB1); }
#pragma unroll
    for (int i = 0; i < 4; ++i) { const bool od = lane & 2; const float keep = od ? a8[2 * i + 1] : a8[2 * i], send = od ? a8[2 * i] : a8[2 * i + 1]; a4[i] = keep + DPPF(send, 0x4E); }
#pragma unroll
    for (int i = 0; i < 2; ++i) { const bool od = lane & 4; const float keep = od ? a4[2 * i + 1] : a4[2 * i], send = od ? a4[2 * i] : a4[2 * i + 1]; a2[i] = keep + SWZF(send, 0x101F); }
    const bool od = lane & 8; const float keep = od ? a2[1] : a2[0], send = od ? a2[0] : a2[1];
    return rows_sum4(keep + SWZF(send, 0x201F));
}
template <bool F> struct NormRaw { typedef u32x2 T; };
template <> struct NormRaw<true> { typedef f32x4 T; };
__device__ __forceinline__ void nrm_ld(f32x4& r, const void* base, size_t tok, int idx) { r = *((const f32x4*)((const float*)base + tok * D) + idx); }
__device__ __forceinline__ void nrm_ld(u32x2& r, const void* base, size_t tok, int idx) { r = *((const u32x2*)((const bf16_t*)base + tok * D) + idx); }
__device__ __forceinline__ f32x4 nrm_up(const f32x4& r) { return r; }
__device__ __forceinline__ f32x4 nrm_up(const u32x2& r) { return f32x4{bflo(r.x), bfhi(r.x), bflo(r.y), bfhi(r.y)}; }
template <int MODE, bool XF32>
__device__ __forceinline__ void ph_norm(const Params& p, int l, bool combine, LAS unsigned char* lds, const int tid, int G, int bid, const void* xin) {
    GAS unsigned char* ws_ = (GAS unsigned char*)p.ws; LAUNDER_S(ws_);
    const int lane = tid & 63, wave = __builtin_amdgcn_readfirstlane(tid >> 6);
    LAS unsigned char* wl = lds + LDS_SCR;
    if (MODE != 2) {
        const GAS float* wsrc = (const GAS float*)(MODE == 0 ? p.w_in + (size_t)l * D * DIN + GATE_COL : p.w_router + (size_t)l * D * NE); const int ldw = MODE == 0 ? DIN : NE;
        f32x4 wt[8];
#pragma unroll
        for (int j = 0; j < 8; ++j) { const int i = tid + 512 * j, k = i >> 2, part = i & 3; wt[j] = *(const GAS f32x4*)(wsrc + (size_t)k * ldw + part * 4); }
#pragma unroll
        for (int j = 0; j < 8; ++j) { const int i = tid + 512 * j, k = i >> 2, part = i & 3; *(LAS f32x4*)(wl + k * 64 + (k >> 2) * 16 + part * 16) = wt[j]; }
        __syncthreads();
    }
    const GAS float* gsrc = (const GAS float*)(MODE == 0 ? p.g_mix + l * D : p.g_ffn + l * D);
    f32x4 gv[4];
#pragma unroll
    for (int j = 0; j < 4; ++j) gv[j] = MODE != 2 ? *((const GAS f32x4*)gsrc + lane + 64 * j) : (f32x4){0.f, 0.f, 0.f, 0.f};
    GAS bf16_t* hb = (GAS bf16_t*)(ws_ + WS_H); const GAS bf16_t* ybuf = (const GAS bf16_t*)(ws_ + WS_YBUF); const GAS int* slotmap = (const GAS int*)(ws_ + WS_ROUTE + RT_SLOTMAP);
    GAS float* gates = (GAS float*)(ws_ + WS_GATES); GAS float* aff = (GAS float*)(ws_ + WS_AFF);
    LAS unsigned char* stg = lds + LDS_SCR + 70656 + wave * 8192;
#define NORM_ISSUE(tok, e, c, slot) do { const GAS unsigned char* yr = (const GAS unsigned char*)ybuf + ((size_t)(((e) * BATCH + ((tok) >> 12)) * CAP + (c))) * D + lane * 16; LAS unsigned char* dl = stg + __builtin_amdgcn_readfirstlane(slot) * 1024; \
        __builtin_amdgcn_global_load_lds((const GAS unsigned*)yr, (LAS unsigned*)dl, 16, 0, 0); } while (0)
#define NORM_COMBINE2(va_, tokA_, cva_, vb_, tokB_, cvb_) do { int ca = 0, cb = 0; \
        _Pragma("unroll 1") for (int e = 0; e < NE; ++e) { const int c = __builtin_amdgcn_readlane(cva_, e);        \
            if (c >= 0) { NORM_ISSUE(tokA_, e, c, ca); if (++ca == 8) NORM_FLUSH2(va_, vb_); } } \
        _Pragma("unroll 1") for (int e = 0; e < NE; ++e) { const int c = __builtin_amdgcn_readlane(cvb_, e); \
            if (c >= 0) { NORM_ISSUE(tokB_, e, c, ca + cb); ++cb; if (ca + cb == 8) NORM_FLUSH2(va_, vb_); } } \
        if (ca + cb) NORM_FLUSH2(va_, vb_); \
        NORM_XSTORE(va_, tokA_); NORM_XSTORE(vb_, tokB_); } while (0)
#define NORM_FLUSH2(va_, vb_) do { asm volatile("s_waitcnt vmcnt(0)" ::: "memory"); \
        for (int k = 0; k < ca; ++k) { _Pragma("unroll") for (int j = 0; j < 4; ++j) { const unsigned w = *(const LAS unsigned*)(stg + k * 1024 + j * 256 + lane * 4); \
            va_[j].x += 0.125f * __builtin_amdgcn_cvt_f32_fp8(w, 0); va_[j].y += 0.125f * __builtin_amdgcn_cvt_f32_fp8(w, 1); va_[j].z += 0.125f * __builtin_amdgcn_cvt_f32_fp8(w, 2); va_[j].w += 0.125f * __builtin_amdgcn_cvt_f32_fp8(w, 3); } } \
        for (int k = 0; k < cb; ++k) { _Pragma("unroll") for (int j = 0; j < 4; ++j) { const unsigned w = *(const LAS unsigned*)(stg + (ca + k) * 1024 + j * 256 + lane * 4); \
            vb_[j].x += 0.125f * __builtin_amdgcn_cvt_f32_fp8(w, 0); vb_[j].y += 0.125f * __builtin_amdgcn_cvt_f32_fp8(w, 1); vb_[j].z += 0.125f * __builtin_amdgcn_cvt_f32_fp8(w, 2); vb_[j].w += 0.125f * __builtin_amdgcn_cvt_f32_fp8(w, 3); } } \
        asm volatile("s_waitcnt lgkmcnt(0)" ::: "memory"); ca = 0; cb = 0; } while (0)
#define NORM_XSTORE(v, tok) do { if (MODE == 2) { _Pragma("unroll") for (int j = 0; j < 4; ++j) *((GAS f32x4*)(p.out + (size_t)(tok) * D) + lane + 64 * j) = v[j]; } \
        else { _Pragma("unroll") for (int j = 0; j < 4; ++j) { u32x2 w_; w_.x = pk2(v[j].x, v[j].y); w_.y = pk2(v[j].z, v[j].w); ((GAS u32x2*)(xb + (size_t)(tok) * D))[lane + 64 * j] = w_; } } } while (0)
    GAS bf16_t* xb = (GAS bf16_t*)(ws_ + WS_XB);
    const float bgate = MODE == 0 ? p.b_gates[l * 16 + (lane & 15)] : 0.f;
    int sna_ = -1, snb_ = -1;
    typename NormRaw<XF32>::T na_[4], nb_[4];
    { const int t0 = (bid * 8 + wave) * 2;
      if (t0 < NTOK) {
        if (combine) { sna_ = slotmap[(size_t)t0 * NE + (lane & 15)]; snb_ = slotmap[(size_t)(t0 + 1) * NE + (lane & 15)]; }
#pragma unroll
        for (int j = 0; j < 4; ++j) { nrm_ld(na_[j], xin, (size_t)t0, lane + 64 * j); nrm_ld(nb_[j], xin, (size_t)(t0 + 1), lane + 64 * j); } } }
#pragma unroll 1
    for (int tokA = (bid * 8 + wave) * 2; tokA < NTOK; tokA += G * 8 * 2) {
        const int tokB = tokA + 1;
        f32x4 va[4], vb[4];
#pragma unroll
        for (int j = 0; j < 4; ++j) { va[j] = nrm_up(na_[j]); vb[j] = nrm_up(nb_[j]); }
        const int cva = sna_, cvb = snb_;
        { const int tn = tokA + G * 8 * 2;
          if (tn < NTOK) {
            if (combine) { sna_ = slotmap[(size_t)tn * NE + (lane & 15)]; snb_ = slotmap[(size_t)(tn + 1) * NE + (lane & 15)]; }
#pragma unroll
            for (int j = 0; j < 4; ++j) { nrm_ld(na_[j], xin, (size_t)tn, lane + 64 * j); nrm_ld(nb_[j], xin, (size_t)(tn + 1), lane + 64 * j); } } }
        if (combine) { NORM_COMBINE2(va, tokA, cva, vb, tokB, cvb); }
        else if (XF32) { NORM_XSTORE(va, tokA); NORM_XSTORE(vb, tokB); }
        if (MODE == 2) continue;
        float ssa = 0.f, ssb = 0.f;
#pragma unroll
        for (int j = 0; j < 4; ++j) { ssa += va[j].x * va[j].x + va[j].y * va[j].y + va[j].z * va[j].z + va[j].w * va[j].w; }
#pragma unroll
        for (int j = 0; j < 4; ++j) { ssb += vb[j].x * vb[j].x + vb[j].y * vb[j].y + vb[j].z * vb[j].z + vb[j].w * vb[j].w; }
        const float rra = rsqrtf(wave_sum_fast(ssa) * (1.f / D) + EPS); float rrb = rsqrtf(wave_sum_fast(ssb) * (1.f / D) + EPS); asm volatile("" : "+v"(rrb));
        f32x2 pab[16];
#pragma unroll
        for (int g = 0; g < 16; ++g) pab[g] = (f32x2){0.f, 0.f};
        unsigned lb = (unsigned)lane * 272u + LDS_SCR; LAUNDER_V(lb);
        f32x4 hA[4], hB[4];
#pragma unroll
        for (int j = 0; j < 4; ++j) { const f32x4 gj = gv[j]; hA[j] = va[j] * gj * rra; hB[j] = vb[j] * gj * rrb; }
        f32x4 wc[2][4], wn[2][4];
#pragma unroll
        for (int qq = 0; qq < 2; ++qq) { const LAS f32x4* wr4 = (const LAS f32x4*)(lds + lb + qq * 64);
#pragma unroll
            for (int part = 0; part < 4; ++part) wc[qq][part] = wr4[part]; }
#pragma unroll
        for (int hs = 0; hs < 8; ++hs) {
            if (hs < 7) { const int jn = (hs + 1) >> 1, qb = 2 * ((hs + 1) & 1);
#pragma unroll
                for (int qq = 0; qq < 2; ++qq) { const LAS f32x4* wr4 = (const LAS f32x4*)(lds + lb + jn * 17408 + (qb + qq) * 64);
#pragma unroll
                    for (int part = 0; part < 4; ++part) wn[qq][part] = wr4[part]; } }
            __builtin_amdgcn_sched_barrier(0);
            { const int j = hs >> 1, qb = 2 * (hs & 1);
#pragma unroll
              for (int qq = 0; qq < 2; ++qq) { const f32x2 hq = {hA[j][qb + qq], hB[j][qb + qq]};
#pragma unroll
                  for (int part = 0; part < 4; ++part) { const f32x4 w4 = wc[qq][part];
                      pab[part * 4 + 0] += hq * w4.x; pab[part * 4 + 1] += hq * w4.y; pab[part * 4 + 2] += hq * w4.z; pab[part * 4 + 3] += hq * w4.w; } } }
            __builtin_amdgcn_sched_barrier(0);
            if (hs < 7) {
#pragma unroll
                for (int qq = 0; qq < 2; ++qq)
#pragma unroll
                    for (int part = 0; part < 4; ++part) wc[qq][part] = wn[qq][part]; } }
        float pa[16], pb[16];
#pragma unroll
        for (int g = 0; g < 16; ++g) { pa[g] = pab[g].x; pb[g] = pab[g].y; }
        const int g = lane & 15; const float ta = reduce16(pa, lane); float tb = reduce16(pb, lane);
        if (MODE == 0) { if (lane < 16) { gates[(size_t)tokA * 16 + g] = ta + bgate; gates[(size_t)tokB * 16 + g] = tb + bgate; }
            if (lane == 16) { GAS float* rrow = (GAS float*)(ws_ + WS_RR); rrow[tokA] = rra; rrow[tokB] = rrb; } }
        else { const float mxa = row_max16(ta), exa = __expf(ta - mxa), sma = row_sum16(exa); const float mxb = row_max16(tb), exb = __expf(tb - mxb), smb = row_sum16(exb);
            if (lane < 16) { aff[((size_t)(tokA >> 12) * NE + g) * SEQ + (tokA & (SEQ - 1))] = exa / sma; aff[((size_t)(tokB >> 12) * NE + g) * SEQ + (tokB & (SEQ - 1))] = exb / smb; } }
    }
#undef NORM_COMBINE2
#undef NORM_ISSUE
#undef NORM_XSTORE
#undef NORM_FLUSH2
}


__device__ __forceinline__ float reduce8(float (&pv)[8], int lane) {
    float a4[4], a2[2];
#pragma unroll
    for (int i = 0; i < 4; ++i) { const bool od = lane & 1; const float keep = od ? pv[2 * i + 1] : pv[2 * i], send = od ? pv[2 * i] : pv[2 * i + 1]; a4[i] = keep + DPPF(send, 0xB1); }
#pragma unroll
    for (int i = 0; i < 2; ++i) { const bool od = lane & 2; const float keep = od ? a4[2 * i + 1] : a4[2 * i], send = od ? a4[2 * i] : a4[2 * i + 1]; a2[i] = keep + DPPF(send, 0x4E); }
    const bool od = lane & 4; const float keep = od ? a2[1] : a2[0], send = od ? a2[0] : a2[1];
    float a1 = keep + SWZF(send, 0x101F);
    a1 += SWZF(a1, 0x201F);
    return rows_sum4(a1);
}
__device__ __forceinline__ void ph_norm1_t4(const Params& p, int l, LAS unsigned char* lds, const int tid, int G, int bid) {
    GAS unsigned char* ws_ = (GAS unsigned char*)p.ws; LAUNDER_S(ws_);
    const int lane = tid & 63, wave = __builtin_amdgcn_readfirstlane(tid >> 6);
    LAS unsigned char* wl = lds + LDS_SCR;
    { const GAS float* wsrc = (const GAS float*)(p.w_router + (size_t)l * D * NE);
      f32x4 wt[8];
#pragma unroll
      for (int j = 0; j < 8; ++j) { const int i = tid + 512 * j, k = i >> 2, part = i & 3; wt[j] = *(const GAS f32x4*)(wsrc + (size_t)k * NE + part * 4); }
#pragma unroll
      for (int j = 0; j < 8; ++j) { const int i = tid + 512 * j, k = i >> 2, part = i & 3; *(LAS f32x4*)(wl + k * 64 + (k >> 2) * 16 + part * 16) = wt[j]; }
      __syncthreads(); }
    const GAS float* gsrc = (const GAS float*)(p.g_ffn + l * D);
    f32x4 gv[4];
#pragma unroll
    for (int j = 0; j < 4; ++j) gv[j] = *((const GAS f32x4*)gsrc + lane + 64 * j);
    const GAS bf16_t* xb = (const GAS bf16_t*)(ws_ + WS_XB); GAS unsigned char* hb8 = ws_ + WS_H; GAS float* aff = (GAS float*)(ws_ + WS_AFF);
    u32x2 nr[4][4];
    const int tfirst = (bid * 8 + wave) * 4, tstep = G * 32;
    if (tfirst < NTOK) {
#pragma unroll
        for (int t = 0; t < 4; ++t)
#pragma unroll
            for (int j = 0; j < 4; ++j) nr[t][j] = *((const GAS u32x2*)(xb + (size_t)(tfirst + t) * D) + lane + 64 * j); }
#pragma unroll 1
    for (int tok0 = tfirst; tok0 < NTOK; tok0 += tstep) {
        f32x4 v[4][4]; float rr[4];
#pragma unroll
        for (int t = 0; t < 4; ++t)
#pragma unroll
            for (int j = 0; j < 4; ++j) { const u32x2 r = nr[t][j]; v[t][j] = (f32x4){bflo(r.x), bfhi(r.x), bflo(r.y), bfhi(r.y)}; }
        if (tok0 + tstep < NTOK) {
#pragma unroll
            for (int t = 0; t < 4; ++t)
#pragma unroll
                for (int j = 0; j < 4; ++j) nr[t][j] = *((const GAS u32x2*)(xb + (size_t)(tok0 + tstep + t) * D) + lane + 64 * j); }
#pragma unroll
        for (int t = 0; t < 4; ++t) { float ss = 0.f;
#pragma unroll
            for (int j = 0; j < 4; ++j) ss += v[t][j].x * v[t][j].x + v[t][j].y * v[t][j].y + v[t][j].z * v[t][j].z + v[t][j].w * v[t][j].w;
            rr[t] = rsqrtf(wave_sum_fast(ss) * (1.f / D) + EPS); }
#pragma unroll
        for (int j = 0; j < 4; ++j)
#pragma unroll
            for (int t = 0; t < 4; ++t) { const f32x4 h = v[t][j] * gv[j] * rr[t]; v[t][j] = h;
                ((GAS unsigned*)(hb8 + (size_t)(tok0 + t) * D))[lane + 64 * j] = pg8::pk4_fp8s(h.x, h.y, h.z, h.w, 0.125f); }
        float lg[4];
#pragma unroll
        for (int pass = 0; pass < 2; ++pass) {
            f32x2 pab[8], pcd[8];
#pragma unroll
            for (int e = 0; e < 8; ++e) { pab[e] = (f32x2){0.f, 0.f}; pcd[e] = (f32x2){0.f, 0.f}; }
            unsigned lb = (unsigned)lane * 272u + LDS_SCR + 32u * pass; LAUNDER_V(lb);
            f32x4 wcur[4][2], wnxt[4][2];
#pragma unroll
            for (int q = 0; q < 4; ++q) { const LAS f32x4* wr4 = (const LAS f32x4*)(lds + lb + q * 64); wcur[q][0] = wr4[0]; wcur[q][1] = wr4[1]; }
#pragma unroll
            for (int j = 0; j < 4; ++j) {
                if (j < 3) {
#pragma unroll
                    for (int q = 0; q < 4; ++q) { const LAS f32x4* wr4 = (const LAS f32x4*)(lds + lb + (j + 1) * 17408 + q * 64); wnxt[q][0] = wr4[0]; wnxt[q][1] = wr4[1]; } }
                __builtin_amdgcn_sched_barrier(0);
#pragma unroll
                for (int q = 0; q < 4; ++q) { const f32x2 hab = {v[0][j][q], v[1][j][q]}, hcd = {v[2][j][q], v[3][j][q]};
#pragma unroll
                    for (int pp = 0; pp < 2; ++pp) { const f32x4 w4 = wcur[q][pp];
                        pab[pp * 4 + 0] += hab * w4.x; pab[pp * 4 + 1] += hab * w4.y; pab[pp * 4 + 2] += hab * w4.z; pab[pp * 4 + 3] += hab * w4.w;
                        pcd[pp * 4 + 0] += hcd * w4.x; pcd[pp * 4 + 1] += hcd * w4.y; pcd[pp * 4 + 2] += hcd * w4.z; pcd[pp * 4 + 3] += hcd * w4.w; } }
                __builtin_amdgcn_sched_barrier(0);
                if (j < 3) {
#pragma unroll
                    for (int q = 0; q < 4; ++q) { wcur[q][0] = wnxt[q][0]; wcur[q][1] = wnxt[q][1]; } } }
            float pa[8], pb[8], pc[8], pd[8];
#pragma unroll
            for (int e = 0; e < 8; ++e) { pa[e] = pab[e].x; pb[e] = pab[e].y; pc[e] = pcd[e].x; pd[e] = pcd[e].y; }
            const float ra = reduce8(pa, lane), rb = reduce8(pb, lane), rc = reduce8(pc, lane), rd = reduce8(pd, lane);
            const bool mine = ((lane >> 3) & 1) == pass;
            if (pass == 0) { lg[0] = ra; lg[1] = rb; lg[2] = rc; lg[3] = rd; }
            else { lg[0] = mine ? ra : lg[0]; lg[1] = mine ? rb : lg[1]; lg[2] = mine ? rc : lg[2]; lg[3] = mine ? rd : lg[3]; }
        }
        const int g = lane & 15;
#pragma unroll
        for (int t = 0; t < 4; ++t) { const float mx = row_max16(lg[t]), ex = __expf(lg[t] - mx), sm = row_sum16(ex); const int tok = tok0 + t;
            if (lane < 16) aff[((size_t)(tok >> 12) * NE + g) * SEQ + (tok & (SEQ - 1))] = ex * __builtin_amdgcn_rcpf(sm); }
    }
}

typedef pg8::bf16x8 bf16x8;
template <bool NA>
__device__ __forceinline__ void ph_attn_mfma(const Params& p, int l, LAS unsigned char* lds, const int tid, int G, int bid) {
    unsigned char* ws_ = p.ws; LAUNDER_S(ws_);
    const int lane = tid & 63, gw = bid * 8 + __builtin_amdgcn_readfirstlane(tid >> 6), NGW = G * 8, fr = lane & 15, g = lane >> 4;
    const bf16_t* nrm = (const bf16_t*)(ws_ + WS_NRM); const bf16_t* nvt = (const bf16_t*)(ws_ + WS_NVT); const bf16_t* kmn = (const bf16_t*)(ws_ + WS_KMN); const bf16_t* vmt = (const bf16_t*)(ws_ + WS_VMT);
    bf16_t* y = (bf16_t*)(ws_ + WS_Y);
    LAS float* tb = (LAS float*)(lds + LDS_SCR);
    if (NA) { const float* rpb = p.na_rpb + (size_t)l * 4 * 15 * 31;
        for (int i = tid; i < 4 * 15 * 64; i += 512) { const int dcp = (i & 63) - 16, hr = i >> 6; tb[i] = (dcp >= 0 && dcp < 31) ? rpb[hr * 31 + dcp] : 0.f; }
        __syncthreads(); }
#pragma unroll 1
    for (int it = gw; it < BATCH * 4 * 256; it += NGW) {
        const int qb = it & 255, head = (it >> 8) & 3, b = it >> 10, tok0 = b * SEQ + qb * 16, r = qb >> 2, seg = qb & 3;
        const int rs = min(max(r - 4, 0), 56), kc0 = min(max(seg * 16 - 8, 0), 32);
        const bf16_t* qp = nrm + (size_t)(tok0 + fr) * 768 + (NA ? 0 : 512) + head * 64 + 8 * g;
        const bf16x8 qf0 = *(const bf16x8*)qp, qf1 = *(const bf16x8*)(qp + 32);
        const int jj0 = 8 * (fr >> 2) + (fr & 3);
        const bf16_t* kb = NA ? nrm + (size_t)(b * SEQ + rs * 64 + kc0 + jj0) * 768 + 256 + head * 64 + 8 * g : kmn + (size_t)((l * BATCH + b) * NMEM + jj0) * 256 + head * 64 + 8 * g;
        constexpr int KGS = NA ? 64 * 768 : 32 * 256, KTS = NA ? 4 * 768 : 4 * 256;
        bf16x8 ka[16][2];
#pragma unroll
        for (int i = 0; i < 16; ++i) { const bf16_t* kp = kb + (i >> 1) * KGS + (i & 1) * KTS; ka[i][0] = *(const bf16x8*)kp; ka[i][1] = *(const bf16x8*)(kp + 32); }
        __builtin_amdgcn_sched_barrier(0);
        f32x4 S[16];
#pragma unroll
        for (int i = 0; i < 16; ++i) { f32x4 z = {0.f, 0.f, 0.f, 0.f}; z = __builtin_amdgcn_mfma_f32_16x16x32_bf16(ka[i][0], qf0, z, 0, 0, 0); S[i] = __builtin_amdgcn_mfma_f32_16x16x32_bf16(ka[i][1], qf1, z, 0, 0, 0); }
        const bf16_t* vb = NA ? nvt + ((size_t)((b * 4 + head) * 64 + fr)) * SEQ + rs * 64 + kc0 + 8 * g : vmt + ((size_t)(((l * BATCH + b) * 4 + head) * 64 + fr)) * NMEM + 8 * g;
        constexpr int VMS = NA ? 16 * SEQ : 16 * NMEM, VGS = NA ? 64 : 32;
        bf16x8 va[16];
#pragma unroll
        for (int i = 0; i < 16; ++i) va[i] = *(const bf16x8*)(vb + (i >> 3) * VMS + (i & 7) * VGS);
        __builtin_amdgcn_sched_barrier(0);
        float mx = -1e30f;
        if (NA) { const int c = seg * 16 + fr, lo = min(max(c - 8, 0), 48) - c, dc0 = kc0 + 8 * g - c;
            const LAS float* tbl = tb + (head * 15 + (rs - r + 7)) * 64 + dc0 + 31;
#pragma unroll
            for (int i = 0; i < 16; ++i)
#pragma unroll
                for (int q = 0; q < 4; ++q) { const int dj = 4 * (i & 1) + q, dc = dc0 + dj; const float bv = tbl[(i >> 1) * 64 + dj];
                    const float mk = (dc >= lo && dc <= lo + 15) ? 0.f : -1e30f; const float v = (S[i][q] + bv) + mk; S[i][q] = v; mx = fmaxf(mx, v); } }
        else {
#pragma unroll
            for (int i = 0; i < 16; ++i)
#pragma unroll
                for (int q = 0; q < 4; ++q) mx = fmaxf(mx, S[i][q]); }
        mx = rows_max4(mx);
        float sum = 0.f; bf16x8 pf[8];
#pragma unroll
        for (int Gk = 0; Gk < 8; ++Gk) { float e[8];
#pragma unroll
            for (int t = 0; t < 2; ++t)
#pragma unroll
                for (int q = 0; q < 4; ++q) { e[t * 4 + q] = __expf(S[2 * Gk + t][q] - mx); sum += e[t * 4 + q]; }
            u32x4 w; w.x = pk2(e[0], e[1]); w.y = pk2(e[2], e[3]); w.z = pk2(e[4], e[5]); w.w = pk2(e[6], e[7]);
            pf[Gk] = __builtin_bit_cast(bf16x8, w); }
        sum = rows_sum4(sum);
        bf16x8 vc[16];
#pragma unroll
        for (int i = 0; i < 16; ++i) vc[i] = *(const bf16x8*)(vb + (2 + (i >> 3)) * VMS + (i & 7) * VGS);
        __builtin_amdgcn_sched_barrier(0);
        f32x4 O[4];
#pragma unroll
        for (int mt = 0; mt < 2; ++mt) { O[mt] = (f32x4){0.f, 0.f, 0.f, 0.f};
#pragma unroll
            for (int Gk = 0; Gk < 8; ++Gk) O[mt] = __builtin_amdgcn_mfma_f32_16x16x32_bf16(va[mt * 8 + Gk], pf[Gk], O[mt], 0, 0, 0); }
#pragma unroll
        for (int mt = 0; mt < 2; ++mt) { O[2 + mt] = (f32x4){0.f, 0.f, 0.f, 0.f};
#pragma unroll
            for (int Gk = 0; Gk < 8; ++Gk) O[2 + mt] = __builtin_amdgcn_mfma_f32_16x16x32_bf16(vc[mt * 8 + Gk], pf[Gk], O[2 + mt], 0, 0, 0); }
        const float inv = 1.0f / sum; bf16_t* yo = y + (size_t)(tok0 + fr) * D + (NA ? 512 : 768) + head * 64 + 4 * g;
#pragma unroll
        for (int mt = 0; mt < 4; ++mt) { u32x2 w; w.x = pk2(O[mt][0] * inv, O[mt][1] * inv); w.y = pk2(O[mt][2] * inv, O[mt][3] * inv); *(u32x2*)(yo + 16 * mt) = w; }
    }
    if (NA) __syncthreads();
}


__device__ __forceinline__ void ph_na_lds(const Params& p, int l, LAS unsigned char* lds, const int tid, int G, int bid) {
    GAS unsigned char* ws_ = (GAS unsigned char*)p.ws; LAUNDER_S(ws_);
    const GAS bf16_t* nrm = (const GAS bf16_t*)(ws_ + WS_NRM); const GAS bf16_t* nvt = (const GAS bf16_t*)(ws_ + WS_NVT); GAS bf16_t* y = (GAS bf16_t*)(ws_ + WS_Y);
    LAS unsigned char* kl = lds + LDS_SCR; LAS unsigned char* vl = kl + 8 * 64 * 144; LAS float* tb = (LAS float*)(vl + 64 * 1040);
#pragma unroll 1
    for (int unit = bid; unit < BATCH * 4 * 8; unit += G) {
        int tid_ = tid; LAUNDER_V(tid_);
        const int lane = tid_ & 63, wave = __builtin_amdgcn_readfirstlane(tid_ >> 6), fr = lane & 15, g = lane >> 4;
        const int band = unit & 7, head = (unit >> 3) & 3, b = unit >> 5, r0 = band * 8, rs0 = min(max(r0 - 4, 0), 56);
        const GAS bf16_t* kg = nrm + (size_t)(b * SEQ) * 768 + 256 + head * 64;
        const GAS bf16_t* vg = nvt + (size_t)((b * 4 + head) * 64) * SEQ;
        __syncthreads();
        { const GAS float* rpb = (const GAS float*)(p.na_rpb + ((size_t)l * 4 + head) * 15 * 31);
          float tbv[2];
#pragma unroll
          for (int j = 0; j < 2; ++j) { const int i = tid_ + 512 * j, dcp = (i & 63) - 16; tbv[j] = (i < 15 * 64 && dcp >= 0 && dcp < 31) ? rpb[(i >> 6) * 31 + dcp] : 0.f; }
#pragma unroll
          for (int j = 0; j < 2; ++j) { const int i = tid_ + 512 * j; if (i < 15 * 64) tb[i] = tbv[j]; }
#pragma unroll
          for (int hb = 0; hb < 2; ++hb) { u32x4 tk[4], tv[4];
#pragma unroll
              for (int i = 0; i < 4; ++i) { const int idx = tid_ + 512 * (4 * hb + i), row = idx >> 9, rem = idx & 511, gr = rs0 + row;
                  tk[i] = *(const GAS u32x4*)(kg + (size_t)(gr * 64 + (rem >> 3)) * 768 + (rem & 7) * 8); tv[i] = *(const GAS u32x4*)(vg + (size_t)gr * 4096 + rem * 8); }
#pragma unroll
              for (int i = 0; i < 4; ++i) { const int idx = tid_ + 512 * (4 * hb + i), row = idx >> 9, rem = idx & 511, sl = (rs0 + row) & 7;
                  *(LAS u32x4*)(kl + (sl * 64 + (rem >> 3)) * 144 + (rem & 7) * 16) = tk[i]; *(LAS u32x4*)(vl + (rem >> 3) * 1040 + sl * 128 + (rem & 7) * 16) = tv[i]; } } }
        u32x4 ka_[2], va_[2], kb_[2], vb_[2];
#define NA_NEED(r_) (((r_) + 1 < r0 + 8) && (min(max((r_) - 3, 0), 56) != min(max((r_) - 4, 0), 56)))
#define NA_LOADROW(kk, vv, gn_) do { const int t2 = tid_ - 256; _Pragma("unroll") for (int i = 0; i < 2; ++i) { const int rem = t2 + 256 * i; kk[i] = *(const GAS u32x4*)(kg + (size_t)((gn_) * 64 + (rem >> 3)) * 768 + (rem & 7) * 8); vv[i] = *(const GAS u32x4*)(vg + (size_t)(gn_) * 4096 + rem * 8); } } while (0)
#define NA_STOREROW(kk, vv, gn_) do { const int t2 = tid_ - 256, sl = (gn_) & 7; _Pragma("unroll") for (int i = 0; i < 2; ++i) { const int rem = t2 + 256 * i; *(LAS u32x4*)(kl + (sl * 64 + (rem >> 3)) * 144 + (rem & 7) * 16) = kk[i]; *(LAS u32x4*)(vl + (rem >> 3) * 1040 + sl * 128 + (rem & 7) * 16) = vv[i]; } } while (0)
        if (wave >= 4 && NA_NEED(r0)) NA_LOADROW(ka_, va_, rs0 + 8);
        __syncthreads();
        auto na_row = [&](const int r, u32x4 (&lk)[2], u32x4 (&lv)[2], const u32x4 (&sk)[2], const u32x4 (&sv)[2]) __attribute__((always_inline)) {
            const int rs = min(max(r - 4, 0), 56);
            if (wave >= 4) { const int r1 = r + 1; if (NA_NEED(r1)) { const int gn1 = min(max(r1 - 4, 0), 56) + 8; NA_LOADROW(lk, lv, gn1); } }
            else {
                const int seg = wave, tok0 = b * SEQ + r * 64 + seg * 16, kc0 = min(max(seg * 16 - 8, 0), 32);
                const GAS bf16_t* qp = nrm + (size_t)(tok0 + fr) * 768 + head * 64 + 8 * g;
                const bf16x8 qf0 = *(const GAS bf16x8*)qp, qf1 = *(const GAS bf16x8*)(qp + 32);
                const int jj0 = 8 * (fr >> 2) + (fr & 3);
                f32x4 S[16];
                { bf16x8 kfr[16][2];
#pragma unroll
                  for (int i = 0; i < 16; ++i) { const int sl = (rs + (i >> 1)) & 7; const LAS unsigned char* ka = kl + (sl * 64 + kc0 + jj0 + 4 * (i & 1)) * 144 + 16 * g; kfr[i][0] = *(const LAS bf16x8*)ka; kfr[i][1] = *(const LAS bf16x8*)(ka + 64); }
                  __builtin_amdgcn_sched_barrier(0);
#pragma unroll
                  for (int i = 0; i < 16; ++i) { f32x4 z = {0.f, 0.f, 0.f, 0.f}; z = __builtin_amdgcn_mfma_f32_16x16x32_bf16(kfr[i][0], qf0, z, 0, 0, 0); S[i] = __builtin_amdgcn_mfma_f32_16x16x32_bf16(kfr[i][1], qf1, z, 0, 0, 0); } }
                float mx = -1e30f;
                { const int c = seg * 16 + fr, lo = min(max(c - 8, 0), 48) - c, dc0 = kc0 + 8 * g - c; const LAS float* tbl = tb + (rs - r + 7) * 64 + dc0 + 31;
                  float bvv[16][4];
#pragma unroll
                  for (int i = 0; i < 16; ++i)
#pragma unroll
                      for (int q = 0; q < 4; ++q) bvv[i][q] = tbl[(i >> 1) * 64 + 4 * (i & 1) + q];
                  __builtin_amdgcn_sched_barrier(0);
#pragma unroll
                  for (int i = 0; i < 16; ++i)
#pragma unroll
                      for (int q = 0; q < 4; ++q) { const int dj = 4 * (i & 1) + q, dc = dc0 + dj; const float bv = bvv[i][q];
                          const float mk = (dc >= lo && dc <= lo + 15) ? 0.f : -1e30f; const float v = (S[i][q] + bv) + mk; S[i][q] = v; mx = fmaxf(mx, v); } }
                mx = rows_max4(mx);
                float sum = 0.f; bf16x8 pf[8];
#pragma unroll
                for (int Gk = 0; Gk < 8; ++Gk) { float e[8];
#pragma unroll
                    for (int t = 0; t < 2; ++t)
#pragma unroll
                        for (int q = 0; q < 4; ++q) { e[t * 4 + q] = __expf(S[2 * Gk + t][q] - mx); sum += e[t * 4 + q]; }
                    u32x4 w; w.x = pk2(e[0], e[1]); w.y = pk2(e[2], e[3]); w.z = pk2(e[4], e[5]); w.w = pk2(e[6], e[7]); pf[Gk] = __builtin_bit_cast(bf16x8, w); }
                sum = rows_sum4(sum);
                const bool y8 = l >= Y8_FROM; const float inv = (y8 ? 8.0f : 1.0f) / sum; GAS bf16_t* yo = y + (size_t)(tok0 + fr) * D + 512 + head * 64 + 4 * g; GAS unsigned char* yo8 = (GAS unsigned char*)y + (size_t)(tok0 + fr) * D + 512 + head * 64 + 4 * g;
#pragma unroll
                for (int hv = 0; hv < 2; ++hv) { bf16x8 vfr[16];
#pragma unroll
                    for (int i = 0; i < 16; ++i) vfr[i] = *(const LAS bf16x8*)(vl + (16 * (2 * hv + (i >> 3)) + fr) * 1040 + ((rs + (i & 7)) & 7) * 128 + 2 * (kc0 + 8 * g));
                    __builtin_amdgcn_sched_barrier(0);
#pragma unroll
                    for (int m2 = 0; m2 < 2; ++m2) { f32x4 O = {0.f, 0.f, 0.f, 0.f};
#pragma unroll
                        for (int Gk = 0; Gk < 8; ++Gk) O = __builtin_amdgcn_mfma_f32_16x16x32_bf16(vfr[m2 * 8 + Gk], pf[Gk], O, 0, 0, 0);
                        if (y8) *(GAS unsigned*)(yo8 + 16 * (2 * hv + m2)) = pg8::pk4_fp8(O[0] * inv, O[1] * inv, O[2] * inv, O[3] * inv);
                        else { u32x2 w; w.x = pk2(O[0] * inv, O[1] * inv); w.y = pk2(O[2] * inv, O[3] * inv); *(GAS u32x2*)(yo + 16 * (2 * hv + m2)) = w; } } }
            }
            __syncthreads();
            if (wave >= 4 && NA_NEED(r)) { const int gn = rs + 8; NA_STOREROW(sk, sv, gn); }
            __syncthreads();
        };
#pragma unroll 1
        for (int r = r0; r < r0 + 8; r += 2) { na_row(r, kb_, vb_, ka_, va_); na_row(r + 1, ka_, va_, kb_, vb_); }
    }
}

__device__ __forceinline__ void ph_cross_lds(const Params& p, int l, LAS unsigned char* lds, const int tid, int G, int bid) {
    GAS unsigned char* ws_ = (GAS unsigned char*)p.ws; LAUNDER_S(ws_);
    const GAS bf16_t* nrm = (const GAS bf16_t*)(ws_ + WS_NRM); const GAS bf16_t* kmn = (const GAS bf16_t*)(ws_ + WS_KMN); const GAS bf16_t* vmt = (const GAS bf16_t*)(ws_ + WS_VMT); GAS bf16_t* y = (GAS bf16_t*)(ws_ + WS_Y);
    LAS unsigned char* kl = lds + LDS_SCR; LAS unsigned char* vl = kl + 256 * 144;
#pragma unroll 1
    for (int unit = bid; unit < BATCH * 4 * 8; unit += G) {
        int tid_ = tid; LAUNDER_V(tid_);
        const int lane = tid_ & 63, wave = __builtin_amdgcn_readfirstlane(tid_ >> 6), fr = lane & 15, g = lane >> 4;
        const int qc = unit & 7, head = (unit >> 3) & 3, b = unit >> 5;
        __syncthreads();
        { u32x4 tk[4], tv[4];
#pragma unroll
          for (int i = 0; i < 4; ++i) { const int idx = tid_ + 512 * i, rho = idx >> 3, c = idx & 7, key = (rho & ~31) + 8 * ((rho & 15) >> 2) + 4 * ((rho >> 4) & 1) + (rho & 3);
              tk[i] = *(const GAS u32x4*)(kmn + (size_t)((l * BATCH + b) * NMEM + key) * 256 + head * 64 + c * 8);
              const int dh = idx >> 5, cv = idx & 31; tv[i] = *(const GAS u32x4*)(vmt + ((size_t)(((l * BATCH + b) * 4 + head) * 64 + dh)) * NMEM + cv * 8); }
#pragma unroll
          for (int i = 0; i < 4; ++i) { const int idx = tid_ + 512 * i; *(LAS u32x4*)(kl + (idx >> 3) * 144 + (idx & 7) * 16) = tk[i]; *(LAS u32x4*)(vl + (idx >> 5) * 528 + (idx & 31) * 16) = tv[i]; } }
        __syncthreads();
#pragma unroll 1
        for (int ti = 0; ti < 4; ++ti) {
            const int tok0 = b * SEQ + qc * 512 + (wave * 4 + ti) * 16;
            const GAS bf16_t* qp = nrm + (size_t)(tok0 + fr) * 768 + 512 + head * 64 + 8 * g;
            const bf16x8 qf0 = *(const GAS bf16x8*)qp, qf1 = *(const GAS bf16x8*)(qp + 32);
            f32x4 S[16]; float mx = -1e30f;
            { bf16x8 kfr[16][2];
#pragma unroll
              for (int i = 0; i < 16; ++i) { const LAS unsigned char* ka = kl + (16 * i + fr) * 144 + 16 * g; kfr[i][0] = *(const LAS bf16x8*)ka; kfr[i][1] = *(const LAS bf16x8*)(ka + 64); }
              __builtin_amdgcn_sched_barrier(0);
#pragma unroll
              for (int i = 0; i < 16; ++i) { f32x4 z = {0.f, 0.f, 0.f, 0.f}; z = __builtin_amdgcn_mfma_f32_16x16x32_bf16(kfr[i][0], qf0, z, 0, 0, 0); S[i] = __builtin_amdgcn_mfma_f32_16x16x32_bf16(kfr[i][1], qf1, z, 0, 0, 0); } }
#pragma unroll
            for (int i = 0; i < 16; ++i)
#pragma unroll
                for (int q = 0; q < 4; ++q) mx = fmaxf(mx, S[i][q]);
            mx = rows_max4(mx);
            float sum = 0.f; bf16x8 pf[8];
#pragma unroll
            for (int Gk = 0; Gk < 8; ++Gk) { float e[8];
#pragma unroll
                for (int t = 0; t < 2; ++t)
#pragma unroll
                    for (int q = 0; q < 4; ++q) { e[t * 4 + q] = __expf(S[2 * Gk + t][q] - mx); sum += e[t * 4 + q]; }
                u32x4 w; w.x = pk2(e[0], e[1]); w.y = pk2(e[2], e[3]); w.z = pk2(e[4], e[5]); w.w = pk2(e[6], e[7]); pf[Gk] = __builtin_bit_cast(bf16x8, w); }
            sum = rows_sum4(sum);
            const bool y8 = l >= Y8_FROM; const float inv = (y8 ? 8.0f : 1.0f) / sum; GAS bf16_t* yo = y + (size_t)(tok0 + fr) * D + 768 + head * 64 + 4 * g; GAS unsigned char* yo8 = (GAS unsigned char*)y + (size_t)(tok0 + fr) * D + 768 + head * 64 + 4 * g;
#pragma unroll
            for (int hv = 0; hv < 2; ++hv) { bf16x8 vfr[16];
#pragma unroll
                for (int i = 0; i < 16; ++i) vfr[i] = *(const LAS bf16x8*)(vl + (16 * (2 * hv + (i >> 3)) + fr) * 528 + 16 * (4 * (i & 7) + g));
                __builtin_amdgcn_sched_barrier(0);
#pragma unroll
                for (int m2 = 0; m2 < 2; ++m2) { f32x4 O = {0.f, 0.f, 0.f, 0.f};
#pragma unroll
                    for (int Gk = 0; Gk < 8; ++Gk) O = __builtin_amdgcn_mfma_f32_16x16x32_bf16(vfr[m2 * 8 + Gk], pf[Gk], O, 0, 0, 0);
                    if (y8) *(GAS unsigned*)(yo8 + 16 * (2 * hv + m2)) = pg8::pk4_fp8(O[0] * inv, O[1] * inv, O[2] * inv, O[3] * inv);
                    else { u32x2 w; w.x = pk2(O[0] * inv, O[1] * inv); w.y = pk2(O[2] * inv, O[3] * inv); *(GAS u32x2*)(yo + 16 * (2 * hv + m2)) = w; } } }
        }
    }
    __syncthreads();
}

__device__ __forceinline__ float logsigmoidf_(float x) { return x >= 0.f ? -__logf(1.0f + __expf(-x)) : x - __logf(1.0f + __expf(x)); }
#define DPPS(old_, v_, ctrl_, rmask_, bc_) __int_as_float(__builtin_amdgcn_update_dpp(__float_as_int(old_), __float_as_int(v_), (ctrl_), (rmask_), 0xF, (bc_)))
__device__ __forceinline__ float wave_iscan_add(float v) {
    v += DPPS(0.f, v, 0x111, 0xF, true); v += DPPS(0.f, v, 0x112, 0xF, true); v += DPPS(0.f, v, 0x114, 0xF, true); v += DPPS(0.f, v, 0x118, 0xF, true);
    v += DPPS(0.f, v, 0x142, 0xA, true); v += DPPS(0.f, v, 0x143, 0xC, true); return v; }
__device__ __forceinline__ float wave_iscan_max(float v) {
    const float ninf = -3.0e38f;
    v = fmaxf(v, DPPS(ninf, v, 0x111, 0xF, false)); v = fmaxf(v, DPPS(ninf, v, 0x112, 0xF, false)); v = fmaxf(v, DPPS(ninf, v, 0x114, 0xF, false)); v = fmaxf(v, DPPS(ninf, v, 0x118, 0xF, false));
    v = fmaxf(v, DPPS(ninf, v, 0x142, 0xA, false)); v = fmaxf(v, DPPS(ninf, v, 0x143, 0xC, false)); return v; }
__device__ __forceinline__ void conv8(const bf16_t* proj, const float* cw, int tok, int sg, int c0, float (&a)[8]) {
#pragma unroll
    for (int q = 0; q < 8; ++q) a[q] = 0.f;
#pragma unroll
    for (int j = 0; j < 5; ++j) { const int sj = sg + j - 2; if (sj >= 0 && sj < SEQ) { const u32x4 w = *(const u32x4*)(proj + (size_t)(tok + j - 2) * NPROJ + c0); const f32x4 w0 = *(const f32x4*)(cw + j * 512 + c0), w1 = *(const f32x4*)(cw + j * 512 + c0 + 4);
            a[0] += bflo(w.x) * w0.x; a[1] += bfhi(w.x) * w0.y; a[2] += bflo(w.y) * w0.z; a[3] += bfhi(w.y) * w0.w; a[4] += bflo(w.z) * w1.x; a[5] += bfhi(w.z) * w1.y; a[6] += bflo(w.w) * w1.z; a[7] += bfhi(w.w) * w1.w; } }
#pragma unroll
    for (int q = 0; q < 8; ++q) a[q] = a[q] * sigmoidf_(a[q]);
}
__device__ __forceinline__ void ph_mlstm_a(const Params& p, int l, LAS unsigned char* lds, const int tid, int G, int bid) {
    GAS unsigned char* ws_ = (GAS unsigned char*)p.ws; LAUNDER_S(ws_);
    LAS float* wf = (LAS float*)(lds + LDS_SCR); LAS float* wb = wf + 128; LAS bf16_t* kwt = (LAS bf16_t*)(lds + LDS_SCR + 1024);
    constexpr int NIT = BATCH * 4 * 32;
    u32x4 nxr[8]; bf16x8 nbv[4]; float ngq[8]; f32x4 wq[5][2]; int hw = -1;
#define MA_LOAD(item_, xr_, bv_, gq_) do { int t__ = tid; LAUNDER_V(t__); GAS unsigned char* w__ = ws_; LAUNDER_S(w__); const int itr_ = NIT - 1 - (item_), chunk_ = itr_ & 31, h_ = (itr_ >> 5) & 3, b_ = itr_ >> 7; \
        const int slot_ = t__ & 31, cg_ = t__ >> 5, ch_ = ((cg_ >> 3) ? C_MK : C_MQ) + h_ * 64 + (cg_ & 7) * 8, ln_ = t__ & 63, wv_ = __builtin_amdgcn_readfirstlane(t__ >> 6); \
        const GAS bf16_t* pj_ = (const GAS bf16_t*)(w__ + WS_PROJ); \
        _Pragma("unroll") for (int r = 0; r < 8; ++r) { const int sg = chunk_ * 128 + 4 * slot_ - 2 + r, sc = min(max(sg, 0), SEQ - 1); xr_[r] = *(const GAS u32x4*)(pj_ + (size_t)(b_ * SEQ + sc) * NPROJ + ch_); } \
        { const GAS bf16_t* vp = (const GAS bf16_t*)(w__ + WS_VT) + ((size_t)((b_ * 4 + h_) * 128 + 16 * wv_ + (ln_ & 15))) * SEQ + chunk_ * 128 + 8 * (ln_ >> 4); \
          _Pragma("unroll") for (int ks = 0; ks < 4; ++ks) bv_[ks] = *(const GAS bf16x8*)(vp + 32 * ks); } \
        if (wv_ == 0) { const GAS float* gp = (const GAS float*)(w__ + WS_GATES) + (size_t)(b_ * SEQ + chunk_ * 128 + 2 * ln_) * 16 + h_; \
          _Pragma("unroll") for (int q = 0; q < 8; ++q) gq_[q] = gp[4 * q]; } } while (0)
    if (bid < NIT) MA_LOAD(bid, nxr, nbv, ngq);
#pragma unroll 1
    for (int item = bid; item < NIT; item += G) {
        GAS unsigned char* wsl = ws_; LAUNDER_S(wsl); int tid_ = tid; LAUNDER_V(tid_);
        const int lane = tid_ & 63, wave = __builtin_amdgcn_readfirstlane(tid_ >> 6), fr = lane & 15, g = lane >> 4;
        GAS bf16_t* qkc = (GAS bf16_t*)(wsl + WS_QKC);
        GAS float* mkv = (GAS float*)(wsl + WS_MKV); GAS float* mn = (GAS float*)(wsl + WS_MN); GAS float* cst = (GAS float*)(wsl + WS_MCST); GAS float* gst = (GAS float*)(wsl + WS_MGST); const GAS float* cw = (const GAS float*)(p.conv_qk + (size_t)l * 5 * 512);
        const int itr = NIT - 1 - item;
        const int chunk = itr & 31, h = (itr >> 5) & 3, b = itr >> 7, tokb = b * SEQ + chunk * 128, ccf = ((b * 4 + h) * 2) * 32 + chunk, ccb = ccf + 32;
        const int slot = tid_ & 31, cg = tid_ >> 5, isk = cg >> 3, ch0 = (isk ? C_MK : C_MQ) + h * 64 + (cg & 7) * 8;
        u32x4 xr[8]; bf16x8 bv[4]; float gq[8];
#pragma unroll
        for (int r = 0; r < 8; ++r) xr[r] = nxr[r];
#pragma unroll
        for (int ks = 0; ks < 4; ++ks) bv[ks] = nbv[ks];
#pragma unroll
        for (int q = 0; q < 8; ++q) gq[q] = ngq[q];
        if (h != hw) { hw = h;
#pragma unroll
            for (int tp = 0; tp < 5; ++tp) { wq[tp][0] = *(const GAS f32x4*)(cw + tp * 512 + ch0); wq[tp][1] = *(const GAS f32x4*)(cw + tp * 512 + ch0 + 4); } }
#pragma unroll
        for (int r = 0; r < 8; ++r) { const int sg = chunk * 128 + 4 * slot - 2 + r; if (sg < 0 || sg >= SEQ) xr[r] = (u32x4){0u, 0u, 0u, 0u}; }
        if (item + G < NIT) MA_LOAD(item + G, nxr, nbv, ngq);
        if (wave == 0) {
            const int t0 = 2 * lane;
            const float if0 = gq[0], ff0 = gq[1], ib0 = gq[2], fb0 = gq[3], if1 = gq[4], ff1 = gq[5], ib1 = gq[6], fb1 = gq[7];
            const float lf0 = logsigmoidf_(ff0), lf1 = logsigmoidf_(ff1), lb0 = logsigmoidf_(fb0), lb1 = logsigmoidf_(fb1);
            const float incf = wave_iscan_add(lf0 + lf1), incb = wave_iscan_add(lb0 + lb1);
            const float totf = __int_as_float(__builtin_amdgcn_readlane(__float_as_int(incf), 63)), totb = __int_as_float(__builtin_amdgcn_readlane(__float_as_int(incb), 63)), basef = incf - (lf0 + lf1), baseb = incb - (lb0 + lb1);
            const float bf0 = basef + lf0, bf1 = basef + lf0 + lf1, bb0 = totb - baseb, bb1 = totb - (baseb + lb0);
            const float uf0 = if0 - bf0, uf1 = if1 - bf1, ub0 = ib0 - bb0, ub1 = ib1 - bb1;
            const float incm = wave_iscan_max(fmaxf(uf0, uf1));
            const float incs = shb(wave_iscan_max(shb(fmaxf(ub0, ub1), 63 - lane)), 63 - lane);
            float exm = shu(incm, 1, lane), exs = shd(incs, 1, lane); if (lane == 0) exm = -3.0e38f; if (lane == 63) exs = -3.0e38f;
            const float pmf0 = fmaxf(exm, uf0), pmf1 = fmaxf(pmf0, uf1), pmb1 = fmaxf(exs, ub1), pmb0 = fmaxf(pmb1, ub0);
            const float maxuf = __int_as_float(__builtin_amdgcn_readlane(__float_as_int(incm), 63)), maxub = __int_as_float(__builtin_amdgcn_readlane(__float_as_int(incs), 0));
            *(LAS f32x2*)(wf + t0) = (f32x2){__expf(uf0 - maxuf), __expf(uf1 - maxuf)}; *(LAS f32x2*)(wb + t0) = (f32x2){__expf(ub0 - maxub), __expf(ub1 - maxub)};
            GAS float* gs = gst + (size_t)itr * 768 + t0;
            *(GAS f32x2*)(gs) = (f32x2){bf0, bf1}; *(GAS f32x2*)(gs + 128) = (f32x2){uf0, uf1}; *(GAS f32x2*)(gs + 256) = (f32x2){pmf0, pmf1};
            *(GAS f32x2*)(gs + 384) = (f32x2){bb0, bb1}; *(GAS f32x2*)(gs + 512) = (f32x2){ub0, ub1}; *(GAS f32x2*)(gs + 640) = (f32x2){pmb0, pmb1};
            if (lane == 0) { *(GAS f32x2*)(cst + 2 * ccf) = (f32x2){totf + maxuf, totf}; *(GAS f32x2*)(cst + 2 * ccb) = (f32x2){totb + maxub, totb}; }
        }
        float cv[4][8];
#pragma unroll
        for (int j = 0; j < 4; ++j) { float a[8];
#pragma unroll
            for (int q = 0; q < 8; ++q) a[q] = 0.f;
#pragma unroll
            for (int tp = 0; tp < 5; ++tp) { const u32x4 w = xr[j + tp]; const f32x4 w0 = wq[tp][0], w1 = wq[tp][1];
                a[0] += bflo(w.x) * w0.x; a[1] += bfhi(w.x) * w0.y; a[2] += bflo(w.y) * w0.z; a[3] += bfhi(w.y) * w0.w; a[4] += bflo(w.z) * w1.x; a[5] += bfhi(w.z) * w1.y; a[6] += bflo(w.w) * w1.z; a[7] += bfhi(w.w) * w1.w; }
            const float sc = isk ? 1.0f : 0.125f;
#pragma unroll
            for (int q = 0; q < 8; ++q) { a[q] = a[q] * sigmoidf_(a[q]); cv[j][q] = a[q]; }
            u32x4 o; o.x = pk2(a[0] * sc, a[1] * sc); o.y = pk2(a[2] * sc, a[3] * sc); o.z = pk2(a[4] * sc, a[5] * sc); o.w = pk2(a[6] * sc, a[7] * sc);
            *(GAS u32x4*)(qkc + (size_t)(tokb + 4 * slot + j) * 512 + isk * 256 + h * 64 + (cg & 7) * 8) = o; }
        __syncthreads();
        if (isk) { const int kc = (cg & 7) * 8; const f32x4 wf4 = *(const LAS f32x4*)(wf + 4 * slot), wb4 = *(const LAS f32x4*)(wb + 4 * slot);
#pragma unroll
            for (int jp = 0; jp < 2; ++jp) { const float wfa = wf4[2 * jp], wfb = wf4[2 * jp + 1], wba = wb4[2 * jp], wbb = wb4[2 * jp + 1];
#pragma unroll
                for (int q = 0; q < 8; ++q) { LAS unsigned* kf = (LAS unsigned*)(kwt + (kc + q) * 136 + 4 * slot + 2 * jp); LAS unsigned* kb = (LAS unsigned*)(kwt + 64 * 136 + (kc + q) * 136 + 4 * slot + 2 * jp);
                    *kf = pk2(cv[2 * jp][q] * wfa, cv[2 * jp + 1][q] * wfb); *kb = pk2(cv[2 * jp][q] * wba, cv[2 * jp + 1][q] * wbb); } } }
        __syncthreads();
        {
#pragma unroll
            for (int dir = 0; dir < 2; ++dir) { GAS bf16_t* outp = (GAS bf16_t*)mkv + ((size_t)(dir ? ccb : ccf) * 128 + 16 * wave + fr) * 64 + 4 * g;
                bf16x8 af[16];
#pragma unroll
                for (int i = 0; i < 16; ++i) af[i] = *(const LAS bf16x8*)(kwt + dir * 64 * 136 + (16 * (i >> 2) + fr) * 136 + 32 * (i & 3) + 8 * g);
                __builtin_amdgcn_sched_barrier(0);
#pragma unroll
                for (int mt = 0; mt < 4; ++mt) { f32x4 acc = {0.f, 0.f, 0.f, 0.f};
#pragma unroll
                    for (int ks = 0; ks < 4; ++ks) acc = __builtin_amdgcn_mfma_f32_16x16x32_bf16(af[mt * 4 + ks], bv[ks], acc, 0, 0, 0);
                    u32x2 w; w.x = pk2c(acc[0], acc[1]); w.y = pk2c(acc[2], acc[3]); *(GAS u32x2*)(outp + 16 * mt) = w; } }
            if (tid_ < 128) { const int dir = tid_ >> 6, dk = tid_ & 63; float sm = 0.f;
#pragma unroll
                for (int c8 = 0; c8 < 16; ++c8) { const u32x4 w4 = *(const LAS u32x4*)(kwt + dir * 64 * 136 + dk * 136 + 8 * c8); sm += (bflo(w4.x) + bfhi(w4.x)) + (bflo(w4.y) + bfhi(w4.y)) + (bflo(w4.z) + bfhi(w4.z)) + (bflo(w4.w) + bfhi(w4.w)); }
                mn[(size_t)(dir ? ccb : ccf) * 64 + dk] = sm; }
        }
        __syncthreads();
    }
}
__device__ __forceinline__ void ph_mlstm_scan(const Params& p, int gtid, int gsz) {
    GAS unsigned char* ws_ = (GAS unsigned char*)p.ws; LAUNDER_S(ws_);
    const GAS bf16_t* mkv = (const GAS bf16_t*)(ws_ + WS_MKV); const GAS float* mn = (const GAS float*)(ws_ + WS_MN); const GAS float* cst = (const GAS float*)(ws_ + WS_MCST);
    GAS bf16_t* mcp = (GAS bf16_t*)(ws_ + WS_MCP); GAS float* mnp = (GAS float*)(ws_ + WS_MNP); GAS float* mmp = (GAS float*)(ws_ + WS_MMP);
    if ((gtid & 511) < 16) {
#pragma unroll 1
        for (int ni = (gtid >> 9) * 16 + (gtid & 511); ni < 64 * 64; ni += (gsz >> 9) * 16) {
            const int chain = ni >> 6, dk = ni & 63, dir = chain & 1; float n = 0.f, m = 0.f;
#pragma unroll 1
            for (int hb = 0; hb < 2; ++hb) { float ncv[16]; f32x2 ag[16];
#pragma unroll
                for (int i = 0; i < 16; ++i) { const int ci = 16 * hb + i, c = dir ? 31 - ci : ci; const size_t cc = (size_t)chain * 32 + c; ncv[i] = mn[cc * 64 + dk]; ag[i] = *(const GAS f32x2*)(cst + 2 * cc); }
#pragma unroll
                for (int i = 0; i < 16; ++i) { const int ci = 16 * hb + i, c = dir ? 31 - ci : ci; const size_t cc = (size_t)chain * 32 + c;
                    mnp[cc * 64 + dk] = n; if (dk == 0) mmp[cc] = m;
                    const float mnew = fmaxf(ag[i].y + m, ag[i].x), sp = __expf(ag[i].y + m - mnew), sc = __expf(ag[i].x - mnew);
                    n = n * sp + ncv[i] * sc; m = mnew; } }
        }
    }
#pragma unroll 1
    for (int idx = gtid; idx < 64 * 128 * 16; idx += gsz) {
        const int dkq = idx & 15, dv = (idx >> 4) & 127, chain = idx >> 11, dir = chain & 1;
        f32x4 C = {0.f, 0.f, 0.f, 0.f}; float m = 0.f;
#pragma unroll 1
        for (int hb = 0; hb < 2; ++hb) {
            u32x2 kvw[16]; f32x2 ag[16];
#pragma unroll
            for (int i = 0; i < 16; ++i) { const int ci = 16 * hb + i, c = dir ? 31 - ci : ci; const size_t cc = (size_t)chain * 32 + c; kvw[i] = *(const GAS u32x2*)(mkv + (cc * 128 + dv) * 64 + dkq * 4); ag[i] = *(const GAS f32x2*)(cst + 2 * cc); }
#pragma unroll
            for (int i = 0; i < 16; ++i) { const int ci = 16 * hb + i, c = dir ? 31 - ci : ci; const size_t cc = (size_t)chain * 32 + c;
                u32x2 w; w.x = pk2(C[0], C[1]); w.y = pk2(C[2], C[3]); *(GAS u32x2*)(mcp + (cc * 128 + dv) * 64 + dkq * 4) = w;
                const float mnew = fmaxf(ag[i].y + m, ag[i].x), sp = __expf(ag[i].y + m - mnew), sc = __expf(ag[i].x - mnew);
                const f32x4 kv = {bflo(kvw[i].x), bfhi(kvw[i].x), bflo(kvw[i].y), bfhi(kvw[i].y)};
                C = C * sp + kv * sc; m = mnew; }
        }
    }
}
__device__ __forceinline__ void ph_mlstm_c(const Params& p, int l, LAS unsigned char* lds, const int tid, int G, int bid) {
    GAS unsigned char* ws_ = (GAS unsigned char*)p.ws; LAUNDER_S(ws_);
    LAS unsigned char* kl = lds + LDS_SCR; LAS unsigned char* vl = kl + 128 * 144; LAS unsigned char* cfl = vl + 128 * 272; LAS unsigned char* cbl = cfl + 128 * 144; LAS float* ugl = (LAS float*)(cbl + 128 * 144);
#pragma unroll 1
    for (int item = bid; item < BATCH * 4 * 32; item += G) {
        GAS unsigned char* wsl = ws_; LAUNDER_S(wsl);
        int tid_ = tid; LAUNDER_V(tid_);
        const int lane = tid_ & 63, wave = __builtin_amdgcn_readfirstlane(tid_ >> 6), fr = lane & 15, g = lane >> 4;
        const GAS bf16_t* proj = (const GAS bf16_t*)(wsl + WS_PROJ); const GAS bf16_t* qkc = (const GAS bf16_t*)(wsl + WS_QKC); const GAS bf16_t* vt = (const GAS bf16_t*)(wsl + WS_VT); const GAS bf16_t* mcp = (const GAS bf16_t*)(wsl + WS_MCP);
        const GAS float* mnp = (const GAS float*)(wsl + WS_MNP); const GAS float* mmp = (const GAS float*)(wsl + WS_MMP); const GAS float* gst = (const GAS float*)(wsl + WS_MGST); GAS bf16_t* y = (GAS bf16_t*)(wsl + WS_Y);
        const int chunk = item & 31, h = (item >> 5) & 3, b = item >> 7, tokb = b * SEQ + chunk * 128, t = 16 * wave + fr, tq = tokb + t;
        const size_t ccf = (size_t)((b * 4 + h) * 2) * 32 + chunk, ccb = ccf + 32;
        const GAS bf16_t* qp = qkc + (size_t)tq * 512 + h * 64 + 8 * g;
        const u32x4 q0 = *(const GAS u32x4*)qp, q1 = *(const GAS u32x4*)(qp + 32);
        const GAS float* gs = gst + (size_t)item * 768;
        const float bfw = gs[t], pmf = gs[256 + t], bbw = gs[384 + t], pmb = gs[640 + t], mpf = mmp[ccf], mpb = mmp[ccb];
        f32x4 npf[4], npb[4];
#pragma unroll
        for (int i = 0; i < 4; ++i) { npf[i] = *(const GAS f32x4*)(mnp + ccf * 64 + 32 * (i >> 1) + 8 * g + 4 * (i & 1)); npb[i] = *(const GAS f32x4*)(mnp + ccb * 64 + 32 * (i >> 1) + 8 * g + 4 * (i & 1)); }
        unsigned ogw[8];
        { const GAS unsigned char* op = (const GAS unsigned char*)(wsl + WS_OG) + (size_t)tq * 512 + h * 128 + 4 * g;
#pragma unroll
          for (int mt = 0; mt < 8; ++mt) ogw[mt] = *(const GAS unsigned*)(op + 16 * mt); }
        __syncthreads();
        { u32x4 tk[2], tv[4], tf[2], tb[2];
#pragma unroll
          for (int i = 0; i < 2; ++i) { const int idx = tid_ + 512 * i, rho = idx >> 3, c = idx & 7, key = (rho & ~31) + 8 * ((rho & 15) >> 2) + 4 * ((rho >> 4) & 1) + (rho & 3);
              tk[i] = *(const GAS u32x4*)(qkc + (size_t)(tokb + key) * 512 + 256 + h * 64 + c * 8);
              tf[i] = *(const GAS u32x4*)(mcp + (ccf * 128 + rho) * 64 + c * 8); tb[i] = *(const GAS u32x4*)(mcp + (ccb * 128 + rho) * 64 + c * 8); }
#pragma unroll
          for (int i = 0; i < 4; ++i) { const int idx = tid_ + 512 * i, dv = idx >> 4, c = idx & 15; tv[i] = *(const GAS u32x4*)(vt + ((size_t)((b * 4 + h) * 128 + dv)) * SEQ + chunk * 128 + c * 8); }
          f32x4 ugv = {0.f, 0.f, 0.f, 0.f};
          if (tid_ < 64) { const GAS float* gsu = gst + (size_t)item * 768 + (tid_ < 32 ? 128 : 512 - 128) + 4 * tid_; ugv = *(const GAS f32x4*)gsu; }
#pragma unroll
          for (int i = 0; i < 2; ++i) { const int idx = tid_ + 512 * i, rho = idx >> 3, c = idx & 7; *(LAS u32x4*)(kl + rho * 144 + c * 16) = tk[i]; *(LAS u32x4*)(cfl + rho * 144 + c * 16) = tf[i]; *(LAS u32x4*)(cbl + rho * 144 + c * 16) = tb[i]; }
#pragma unroll
          for (int i = 0; i < 4; ++i) { const int idx = tid_ + 512 * i; *(LAS u32x4*)(vl + (idx >> 4) * 272 + (idx & 15) * 16) = tv[i]; }
          if (tid_ < 64) *(LAS f32x4*)(ugl + 4 * tid_) = ugv; }
        const float Mf = fmaxf(mpf, pmf), Mb = fmaxf(mpb, pmb), sif = __expf(mpf - Mf), sib = __expf(mpb - Mb), flf = __expf(-bfw - Mf), flb = __expf(-bbw - Mb);
        const float qv[16] = {bflo(q0.x), bfhi(q0.x), bflo(q0.y), bfhi(q0.y), bflo(q0.z), bfhi(q0.z), bflo(q0.w), bfhi(q0.w), bflo(q1.x), bfhi(q1.x), bflo(q1.y), bfhi(q1.y), bflo(q1.z), bfhi(q1.z), bflo(q1.w), bfhi(q1.w)};
        float qnf = 0.f, qnb = 0.f;
#pragma unroll
        for (int ks = 0; ks < 2; ++ks)
#pragma unroll
            for (int hf = 0; hf < 2; ++hf) { const f32x4 nf = npf[ks * 2 + hf], nb = npb[ks * 2 + hf];
#pragma unroll
                for (int q = 0; q < 4; ++q) { qnf += qv[ks * 8 + hf * 4 + q] * nf[q]; qnb += qv[ks * 8 + hf * 4 + q] * nb[q]; } }
        qnf = rows_sum4(qnf); qnb = rows_sum4(qnb);
        const bf16x8 qf0 = __builtin_bit_cast(bf16x8, q0), qf1 = __builtin_bit_cast(bf16x8, q1);
        __syncthreads();
        f32x4 scf[4][2], scb[4][2]; float rsf = 0.f, rsb = 0.f;
        bf16x8 kfr[8][2];
#pragma unroll
        for (int i = 0; i < 8; ++i) { const LAS unsigned char* ka = kl + (16 * i + fr) * 144 + 16 * g; kfr[i][0] = *(const LAS bf16x8*)ka; kfr[i][1] = *(const LAS bf16x8*)(ka + 64); }
        __builtin_amdgcn_sched_barrier(0);
#pragma unroll
        for (int Gk = 0; Gk < 4; ++Gk)
#pragma unroll
            for (int tt = 0; tt < 2; ++tt) {
                f32x4 z = {0.f, 0.f, 0.f, 0.f};
                z = __builtin_amdgcn_mfma_f32_16x16x32_bf16(kfr[2 * Gk + tt][0], qf0, z, 0, 0, 0); z = __builtin_amdgcn_mfma_f32_16x16x32_bf16(kfr[2 * Gk + tt][1], qf1, z, 0, 0, 0);
                const int s0 = 32 * Gk + 8 * g + 4 * tt; const f32x4 uf = *(const LAS f32x4*)(ugl + s0), ub = *(const LAS f32x4*)(ugl + 128 + s0);
#pragma unroll
                for (int q = 0; q < 4; ++q) { const int s = s0 + q; const float ef = __expf(s <= t ? uf[q] - Mf : -1e30f), eb = __expf(s >= t ? ub[q] - Mb : -1e30f);
                    scf[Gk][tt][q] = z[q] * ef; scb[Gk][tt][q] = z[q] * eb; rsf += scf[Gk][tt][q]; rsb += scb[Gk][tt][q]; } }
        rsf = rows_sum4(rsf); rsb = rows_sum4(rsb);
        const float invf = 1.0f / fmaxf(fabsf(sif * qnf + rsf), flf), invb = 1.0f / fmaxf(fabsf(sib * qnb + rsb), flb), cf = sif * invf, cb = sib * invb;
        bf16x8 pf[4], qff[2], qfb[2];
#pragma unroll
        for (int Gk = 0; Gk < 4; ++Gk) { float e[8];
#pragma unroll
            for (int tt = 0; tt < 2; ++tt)
#pragma unroll
                for (int q = 0; q < 4; ++q) e[tt * 4 + q] = scf[Gk][tt][q] * invf + scb[Gk][tt][q] * invb;
            u32x4 w; w.x = pk2(e[0], e[1]); w.y = pk2(e[2], e[3]); w.z = pk2(e[4], e[5]); w.w = pk2(e[6], e[7]); pf[Gk] = __builtin_bit_cast(bf16x8, w); }
#pragma unroll
        for (int ks = 0; ks < 2; ++ks) { u32x4 w;
            w.x = pk2(qv[ks * 8 + 0] * cf, qv[ks * 8 + 1] * cf); w.y = pk2(qv[ks * 8 + 2] * cf, qv[ks * 8 + 3] * cf); w.z = pk2(qv[ks * 8 + 4] * cf, qv[ks * 8 + 5] * cf); w.w = pk2(qv[ks * 8 + 6] * cf, qv[ks * 8 + 7] * cf); qff[ks] = __builtin_bit_cast(bf16x8, w);
            w.x = pk2(qv[ks * 8 + 0] * cb, qv[ks * 8 + 1] * cb); w.y = pk2(qv[ks * 8 + 2] * cb, qv[ks * 8 + 3] * cb); w.z = pk2(qv[ks * 8 + 4] * cb, qv[ks * 8 + 5] * cb); w.w = pk2(qv[ks * 8 + 6] * cb, qv[ks * 8 + 7] * cb); qfb[ks] = __builtin_bit_cast(bf16x8, w); }
        f32x4 O[8]; float ss = 0.f;
#pragma unroll
        for (int hv = 0; hv < 2; ++hv) {
            bf16x8 fa[4][8];
#pragma unroll
            for (int m2 = 0; m2 < 4; ++m2) { const int mt = 4 * hv + m2; const LAS unsigned char* va = vl + (16 * mt + fr) * 272 + 16 * g; const LAS unsigned char* fp = cfl + (16 * mt + fr) * 144 + 16 * g; const LAS unsigned char* bp = cbl + (16 * mt + fr) * 144 + 16 * g;
#pragma unroll
                for (int Gk = 0; Gk < 4; ++Gk) fa[m2][Gk] = *(const LAS bf16x8*)(va + 64 * Gk);
                fa[m2][4] = *(const LAS bf16x8*)fp; fa[m2][5] = *(const LAS bf16x8*)(fp + 64); fa[m2][6] = *(const LAS bf16x8*)bp; fa[m2][7] = *(const LAS bf16x8*)(bp + 64); }
            __builtin_amdgcn_sched_barrier(0);
#pragma unroll
            for (int m2 = 0; m2 < 4; ++m2) { f32x4 acc = {0.f, 0.f, 0.f, 0.f};
#pragma unroll
                for (int Gk = 0; Gk < 4; ++Gk) acc = __builtin_amdgcn_mfma_f32_16x16x32_bf16(fa[m2][Gk], pf[Gk], acc, 0, 0, 0);
                acc = __builtin_amdgcn_mfma_f32_16x16x32_bf16(fa[m2][4], qff[0], acc, 0, 0, 0); acc = __builtin_amdgcn_mfma_f32_16x16x32_bf16(fa[m2][5], qff[1], acc, 0, 0, 0);
                acc = __builtin_amdgcn_mfma_f32_16x16x32_bf16(fa[m2][6], qfb[0], acc, 0, 0, 0); acc = __builtin_amdgcn_mfma_f32_16x16x32_bf16(fa[m2][7], qfb[1], acc, 0, 0, 0);
                O[4 * hv + m2] = acc; ss += acc[0] * acc[0] + acc[1] * acc[1] + acc[2] * acc[2] + acc[3] * acc[3]; }
        }
        ss = rows_sum4(ss);
        const float rr = rsqrtf(ss * (1.0f / 128.0f) + EPS);
        const GAS float* gm = (const GAS float*)(p.g_mh + l * 512 + h * 128 + 4 * g); GAS bf16_t* yo = y + (size_t)tq * D + h * 128 + 4 * g; GAS unsigned char* yo8 = (GAS unsigned char*)y + (size_t)tq * D + h * 128 + 4 * g; const bool y8 = l >= Y8_FROM; const float rrs = y8 ? 8.0f * rr : rr;
        f32x4 gmv[8];
#pragma unroll
        for (int mt = 0; mt < 8; ++mt) gmv[mt] = *(const GAS f32x4*)(gm + 16 * mt);
#pragma unroll
        for (int mt = 0; mt < 8; ++mt) { const unsigned ow = ogw[mt]; const f32x4 gv = gmv[mt];
            const float o0 = sigmoidf_(0.125f * __builtin_amdgcn_cvt_f32_fp8(ow, 0)) * O[mt][0] * rrs * gv.x, o1 = sigmoidf_(0.125f * __builtin_amdgcn_cvt_f32_fp8(ow, 1)) * O[mt][1] * rrs * gv.y, o2 = sigmoidf_(0.125f * __builtin_amdgcn_cvt_f32_fp8(ow, 2)) * O[mt][2] * rrs * gv.z, o3 = sigmoidf_(0.125f * __builtin_amdgcn_cvt_f32_fp8(ow, 3)) * O[mt][3] * rrs * gv.w;
            if (y8) *(GAS unsigned*)(yo8 + 16 * mt) = pg8::pk4_fp8(o0, o1, o2, o3);
            else { u32x2 w; w.x = pk2(o0, o1); w.y = pk2(o2, o3); *(GAS u32x2*)(yo + 16 * mt) = w; } }
    }
    __syncthreads();
}

__device__ __forceinline__ unsigned block_excl_scan(unsigned val, LAS unsigned* wtot, int lane, int wave) {
    unsigned inc = val;
#pragma unroll
    for (int o = 1; o < 64; o <<= 1) { const unsigned t = shuu(inc, o, lane); if (lane >= o) inc += t; }
    if (lane == 63) wtot[wave] = inc;
    __syncthreads();
    unsigned base = 0;
    for (int w = 0; w < wave; ++w) base += wtot[w];
    __syncthreads();
    return base + inc - val;
}
__device__ __forceinline__ void ph_topk(const Params& p, LAS unsigned char* lds, const int tid, int G, int bid) {
    GAS unsigned char* ws_ = (GAS unsigned char*)p.ws; LAUNDER_S(ws_);
    const int lane = tid & 63, wave = __builtin_amdgcn_readfirstlane(tid >> 6);
    LAS unsigned* hist = (LAS unsigned*)(lds + LDS_SCR); LAS unsigned* sel = hist + 256; LAS unsigned* wtot = hist + 272;
    const GAS float* aff = (const GAS float*)(ws_ + WS_AFF); GAS int* slot_tok = (GAS int*)(ws_ + WS_ROUTE + RT_SLOTTOK); GAS float* gate_slot = (GAS float*)(ws_ + WS_ROUTE + RT_GATE); GAS int* slotmap = (GAS int*)(ws_ + WS_ROUTE + RT_SLOTMAP);
    for (int item = bid; item < BATCH * NE; item += G) {
        const int b = item >> 4, e = item & 15; const GAS float* av = aff + (size_t)item * SEQ + tid * 8;
        const f32x4 v0 = *(const GAS f32x4*)av, v1 = *(const GAS f32x4*)(av + 4);
        const float vals[8] = {v0.x, v0.y, v0.z, v0.w, v1.x, v1.y, v1.z, v1.w}; unsigned key[8];
#pragma unroll
        for (int i = 0; i < 8; ++i) key[i] = __float_as_uint(vals[i]);
        unsigned prefix = 0u, mask = 0u, remaining = CAP;
        for (int pass = 0; pass < 4; ++pass) { const int shift = 24 - 8 * pass;
            if (tid < 256) hist[tid] = 0u;
            __syncthreads();
#pragma unroll
            for (int i = 0; i < 8; ++i) if ((key[i] & mask) == prefix) atomicAdd((unsigned*)&hist[(key[i] >> shift) & 255u], 1u);
            __syncthreads();
            if (wave == 0) { const unsigned c0 = hist[255 - 4 * lane], c1 = hist[254 - 4 * lane], c2 = hist[253 - 4 * lane], c3 = hist[252 - 4 * lane]; const unsigned sm = c0 + c1 + c2 + c3; unsigned inc = sm;
#pragma unroll
                for (int o = 1; o < 64; o <<= 1) { const unsigned t = shuu(inc, o, lane); if (lane >= o) inc += t; }
                const unsigned before = inc - sm;
                if (before < remaining && remaining <= inc) { unsigned r = remaining - before; unsigned d;
                    if (r <= c0) d = 255 - 4 * lane; else if (r <= c0 + c1) { d = 254 - 4 * lane; r -= c0; } else if (r <= c0 + c1 + c2) { d = 253 - 4 * lane; r -= c0 + c1; } else { d = 252 - 4 * lane; r -= c0 + c1 + c2; }
                    sel[0] = prefix | (d << shift); sel[1] = r; } }
            __syncthreads();
            prefix = sel[0]; remaining = sel[1]; mask |= 0xffu << shift;
        }
        unsigned ceq = 0;
#pragma unroll
        for (int i = 0; i < 8; ++i) ceq += (key[i] == prefix) ? 1u : 0u;
        unsigned eqb = block_excl_scan(ceq, wtot, lane, wave);
        bool sl[8]; unsigned csel = 0;
#pragma unroll
        for (int i = 0; i < 8; ++i) { const bool eq = key[i] == prefix; sl[i] = key[i] > prefix || (eq && eqb < remaining); eqb += eq ? 1u : 0u; csel += sl[i] ? 1u : 0u; }
        unsigned pos = block_excl_scan(csel, wtot, lane, wave);
#pragma unroll
        for (int i = 0; i < 8; ++i) { const int s = tid * 8 + i; int c = -1;
            if (sl[i]) { c = (int)pos++; const int slot = (e * BATCH + b) * CAP + c; slot_tok[slot] = b * SEQ + s; gate_slot[slot] = vals[i]; }
            slotmap[(size_t)(b * SEQ + s) * NE + e] = c; }
        __syncthreads();
    }
}
__device__ __forceinline__ void ph_gather(const Params& p, const int tid, int G, int bid) {
    unsigned char* ws_ = p.ws; LAUNDER_S(ws_);
    const int lane = tid & 63, gw = bid * 8 + __builtin_amdgcn_readfirstlane(tid >> 6), NGW = G * 8;
    const bf16_t* hb = (const bf16_t*)(ws_ + WS_H); bf16_t* xe = (bf16_t*)(ws_ + WS_XE); const int* slot_tok = (const int*)(ws_ + WS_ROUTE + RT_SLOTTOK);
    for (int r = gw; r < NSLOT; r += NGW) { const int tok = slot_tok[r]; const u32x4* s = (const u32x4*)((const unsigned char*)hb + (size_t)tok * D) + lane; u32x4* d = (u32x4*)((unsigned char*)xe + (size_t)r * D) + lane; d[0] = s[0]; }
}

__global__ void __launch_bounds__(512, 2) fwd(Params p) {
    extern __shared__ __attribute__((aligned(16))) unsigned char lds_raw[];
    LAS unsigned char* lds = (LAS unsigned char*)lds_raw;
    const int G = gridDim.x, bid = blockIdx.x, wave0 = __builtin_amdgcn_readfirstlane((int)threadIdx.x >> 6);
    { const int t = FRESH_TID(); if (t < 64) ((LAS unsigned*)lds)[t] = 0u; }
    __syncthreads();
    unsigned* ctl = (unsigned*)(p.ws + WS_CTL);
    XcdBarrier bar = xcd_barrier_post(ctl + CW_BAR + p.li * XCD_BAR_WORDS, (volatile LAS unsigned*)(lds + 16), wave0);
    const int lo = p.ph_lo, hi = p.ph_hi;
#define IN(k) (lo <= (k) && (k) < hi)
#define SEAM(k) do { if (IN(k) && IN((k) + 1)) xcd_barrier(bar); } while (0)
#define GTID(t) (bid * 512 + (t))
    LAS unsigned char* ring = lds + LDS_SCR;

    if (IN(0)) REPEAT(11) ph_convert(p, lds, FRESH_TID(), G, bid);
    SEAM(0);
    if (IN(1)) {
        unsigned char* ws_ = p.ws; LAUNDER_S(ws_);
        pg8::Gemm g{(const bf16_t*)(ws_ + WS_MEMH), (const bf16_t*)(ws_ + WS_WKV), DEPTH * BATCH * NMEM, DEPTH * 512, D}; pg8::KvOrder S{G, bid};
        pg8::EpiKvMem E{ws_, p.mem_gk};
        pg8::gemm_phase<pg8::EpiKvMem, pg8::KvOrder, true, true>(ring, g, S, E, FRESH_TID());
        __syncthreads();
        ph_cvt_experts(p, lds, FRESH_TID(), G, bid);
        __syncthreads();
        ph_norm<0, true>(p, 0, false, lds, FRESH_TID(), G, bid, p.x);
    }
    SEAM(1);
#pragma unroll 1
    for (int l = 0; l < DEPTH; ++l) {
        const int pb = 2 + 11 * l;
        if (l > 0) { if (IN(pb + 0)) ph_norm<0, false>(p, l, true, lds, FRESH_TID(), G, bid, p.ws + WS_XB);
            SEAM(pb + 0); }
        if (IN(pb + 1)) REPEAT(1) {
            unsigned char* ws_ = p.ws; LAUNDER_S(ws_);
            pg8::Gemm g{(const bf16_t*)(ws_ + WS_XB), (const bf16_t*)(ws_ + WS_WIN) + (size_t)l * NPROJ * D, NTOK, NPROJ, D}; pg8::StaticOrder S; S.init(NTOK, NPROJ, G, bid);
            pg8::EpiProj E{ws_, (const float*)(ws_ + WS_GT) + l * 192, (const float*)(ws_ + WS_RR)};
            pg8::gemm_phase<pg8::EpiProj, pg8::StaticOrder, true, true>(ring, g, S, E, FRESH_TID());
        }
        SEAM(pb + 1);
        if (IN(pb + 2)) REPEAT(2) {
            REPEAT(13) ph_mlstm_a(p, l, lds, FRESH_TID(), G, bid);

            REPEAT(12) ph_na_lds(p, l, lds, FRESH_TID(), G, bid); REPEAT(14) ph_cross_lds(p, l, lds, FRESH_TID(), G, bid);
        }
        SEAM(pb + 2);
        if (IN(pb + 3)) REPEAT(3) { const int t = FRESH_TID(); ph_mlstm_scan(p, GTID(t), G * 512); }
        SEAM(pb + 3);
        if (IN(pb + 4)) REPEAT(4) ph_mlstm_c(p, l, lds, FRESH_TID(), G, bid);
        SEAM(pb + 4);
        if (IN(pb + 5)) REPEAT(5) {
            unsigned char* ws_ = p.ws; LAUNDER_S(ws_);
            pg8::Gemm g{(const bf16_t*)(ws_ + WS_Y), (const bf16_t*)(ws_ + WS_WOUT) + (size_t)l * D * D, NTOK, D, D}; pg8::StaticOrder S; S.init(NTOK, D, G, bid);
            pg8::EpiResid E{(bf16_t*)(ws_ + WS_XB)};
            if (l >= Y8_FROM) { pg8::Gemm g8{(const bf16_t*)(ws_ + WS_Y), (const bf16_t*)(ws_ + WS_WOUT) + (size_t)l * D * D, NTOK, D, D / 2};
                pg8::gemm_phase_f8<pg8::EpiResid, pg8::StaticOrder, true, true, 124, 119>(ring, g8, S, E, FRESH_TID()); }
            else pg8::gemm_phase<pg8::EpiResid, pg8::StaticOrder, true, true>(ring, g, S, E, FRESH_TID());
        }
        SEAM(pb + 5);
        if (IN(pb + 6)) ph_norm1_t4(p, l, lds, FRESH_TID(), G, bid);
        SEAM(pb + 6);
        if (IN(pb + 7)) REPEAT(7) ph_topk(p, lds, FRESH_TID(), G, bid);
        SEAM(pb + 7);
        if (IN(pb + 9)) REPEAT(9) {
            unsigned char* ws_ = p.ws; LAUNDER_S(ws_);
            pg8::Gemm g{(const bf16_t*)(ws_ + WS_H), (const bf16_t*)(ws_ + WS_W13 + (size_t)l * NE * 4096 * D), NSLOT, NE * 4096, D / 2}; pg8::MoeOrder S{G, bid, 16, 256};
            pg8::EpiSwiGLU8 E{ws_ + WS_HID};
            pg8::gemm_phase_f8g<pg8::EpiSwiGLU8, pg8::MoeOrder, true, true, 124, 119>(ring, g, S, E, FRESH_TID(), (const int*)(ws_ + WS_ROUTE + RT_SLOTTOK));
        }
        SEAM(pb + 9);
        if (IN(pb + 10)) REPEAT(10) {
            unsigned char* ws_ = p.ws; LAUNDER_S(ws_);
            pg8::Gemm g{(const bf16_t*)(ws_ + WS_HID), (const bf16_t*)(ws_ + WS_W2 + (size_t)l * NE * D * DFF), NSLOT, NE * D, DFF / 2}; pg8::MoeOrder S{G, bid, 4, 64};
            pg8::EpiGate E{(bf16_t*)(ws_ + WS_YBUF), (const float*)(ws_ + WS_ROUTE + RT_GATE)};
            pg8::gemm_phase_f8<pg8::EpiGate, pg8::MoeOrder, true, true, 124, 119>(ring, g, S, E, FRESH_TID());
        }
        SEAM(pb + 10);
    }
    if (IN(NPHASE - 1)) ph_norm<2, false>(p, 0, true, lds, FRESH_TID(), G, bid, p.ws + WS_XB);
#undef GTID
#undef IN
#undef SEAM
}

#ifndef ATTN_NAIVE
#define ATTN_NAIVE 0
#endif
#ifndef MK_PER_PHASE
#define MK_PER_PHASE 0
#endif
extern "C" void kernel_launch(void* const* d_in, const int* in_sizes, int n_in, void* d_out, int out_size, void* d_ws, size_t ws_size, hipStream_t stream) {
    static int grid = 0;
    if (grid == 0) {
        if (n_in != 20 || out_size != NTOK * D || ws_size < WS_END) { fprintf(stderr, "kernel_launch: unexpected shapes (n_in %d, out %d, ws %zu < %zu)\n", n_in, out_size, ws_size, (size_t)WS_END); grid = -1; return; }
        int dev = 0, cus = 0, per_cu = 0;
        if (hipGetDevice(&dev) != hipSuccess || hipDeviceGetAttribute(&cus, hipDeviceAttributeMultiprocessorCount, dev) != hipSuccess) { grid = -1; return; }
        if (hipFuncSetAttribute((const void*)fwd, hipFuncAttributeMaxDynamicSharedMemorySize, LDS_BYTES) != hipSuccess) { fprintf(stderr, "kernel_launch: hipFuncSetAttribute failed\n"); grid = -1; return; }
        if (hipOccupancyMaxActiveBlocksPerMultiprocessor(&per_cu, (const void*)fwd, 512, LDS_BYTES) != hipSuccess || per_cu < 1) { fprintf(stderr, "kernel_launch: occupancy query says %d\n", per_cu); per_cu = 1; }
        (void)hipGetLastError();
        grid = cus;
    }
    if (grid < 0) return;
    (void)hipMemsetAsync((char*)d_ws + WS_CTL, 0, CTL_BYTES, stream);
    Params P{};
    const float** pp = (const float**)&P;
    for (int i = 0; i < 20; ++i) pp[i] = (const float*)d_in[i];
    P.out = (float*)d_out; P.ws = (unsigned char*)d_ws; P.pad = 0;
#if MK_PER_PHASE
    for (int ph = 0; ph < NPHASE; ++ph) { P.ph_lo = ph; P.ph_hi = ph + 1; P.li = ph; hipLaunchKernelGGL(fwd, dim3(grid), dim3(512), LDS_BYTES, stream, P); }
#else
    P.ph_lo = 0; P.ph_hi = NPHASE; P.li = 0;
    hipLaunchKernelGGL(fwd, dim3(grid), dim3(512), LDS_BYTES, stream, P);
#endif
}
```

```cpp
#include <hip/hip_runtime.h>
#include <cstdio>
#include <cstdint>

constexpr size_t MiB = (size_t)1 << 20;
constexpr size_t WS_CTL = 0, CTL_BYTES = 1 * MiB;
constexpr size_t WS_WIN = 1 * MiB, WS_WKV = 21 * MiB, WS_WOUT = 25 * MiB, WS_W13 = 33 * MiB, WS_W2 = 545 * MiB;
constexpr size_t WS_H = 801 * MiB, WS_MEMH = 865 * MiB, WS_PROJ = 881 * MiB, WS_GATES = 1041 * MiB, WS_KVMEM = 1043 * MiB, WS_Y = 1051 * MiB;
constexpr size_t WS_AFF = 1115 * MiB, WS_ROUTE = 1117 * MiB, WS_XE = 1121 * MiB, WS_XB = WS_XE, WS_RR = WS_ROUTE + 3 * MiB, WS_OG = WS_H + 32 * MiB, WS_HID = 1249 * MiB, WS_YBUF = 1505 * MiB, WS_QKC = 1633 * MiB, WS_HDIR = 1665 * MiB, WS_VT = 1793 * MiB, WS_NVT = 1825 * MiB, WS_NRM = 1841 * MiB, WS_KMN = 1889 * MiB, WS_VMT = 1893 * MiB, WS_GT = 1897 * MiB, WS_END = 1898 * MiB;
constexpr size_t WS_MKV = WS_HID, WS_MCP = WS_HID + 64 * MiB, WS_MN = WS_HID + 96 * MiB, WS_MNP = WS_HID + 97 * MiB, WS_MCST = WS_HID + 98 * MiB, WS_MMP = WS_HID + 98 * MiB + 512 * 1024, WS_MGST = WS_HID + 99 * MiB;
constexpr size_t RT_SLOTTOK = 0, RT_GATE = 256 * 1024, RT_SLOTMAP = 1 * MiB;
constexpr int CW_BAR = 1024;


__device__ __forceinline__ float shx(float v, int mask, int lane) { return __int_as_float(__builtin_amdgcn_ds_bpermute((lane ^ mask) << 2, __float_as_int(v))); }
__device__ __forceinline__ float shu(float v, int o, int lane) { return __int_as_float(__builtin_amdgcn_ds_bpermute(((lane - o) & 63) << 2, __float_as_int(v))); }
__device__ __forceinline__ float shd(float v, int o, int lane) { return __int_as_float(__builtin_amdgcn_ds_bpermute(((lane + o) & 63) << 2, __float_as_int(v))); }
__device__ __forceinline__ float shb(float v, int src) { return __int_as_float(__builtin_amdgcn_ds_bpermute(src << 2, __float_as_int(v))); }
__device__ __forceinline__ unsigned shuu(unsigned v, int o, int lane) { return (unsigned)__builtin_amdgcn_ds_bpermute(((lane - o) & 63) << 2, (int)v); }

typedef unsigned u32x2s __attribute__((ext_vector_type(2)));
__device__ __forceinline__ float rows_sum4(float v) {
    u32x2s r = __builtin_amdgcn_permlane16_swap(__float_as_uint(v), __float_as_uint(v), false, false); v = __uint_as_float(r.x) + __uint_as_float(r.y);
    r = __builtin_amdgcn_permlane32_swap(__float_as_uint(v), __float_as_uint(v), false, false); return __uint_as_float(r.x) + __uint_as_float(r.y); }
__device__ __forceinline__ float rows_max4(float v) {
    u32x2s r = __builtin_amdgcn_permlane16_swap(__float_as_uint(v), __float_as_uint(v), false, false); v = fmaxf(__uint_as_float(r.x), __uint_as_float(r.y));
    r = __builtin_amdgcn_permlane32_swap(__float_as_uint(v), __float_as_uint(v), false, false); return fmaxf(__uint_as_float(r.x), __uint_as_float(r.y)); }
namespace pg8 {
#define PG8_LAS __attribute__((address_space(3)))
typedef unsigned short bf16_t;
typedef short bf16x8 __attribute__((ext_vector_type(8)));
typedef float f32x4 __attribute__((ext_vector_type(4)));
typedef unsigned u32x4 __attribute__((ext_vector_type(4)));
constexpr int BM = 256, BK = 64, HALF = 128, HTB = HALF * BK * 2  , STAGE_BYTES = 8 * HTB, NXCD = 8, WGM = 8;

__host__ __device__ __forceinline__ int lds_byte(int r, int c) { const int st = (r >> 4) * 2 + (c >> 5), rr = r & 15, cc = c & 31, ob = rr * 64 + cc * 2; return st * 1024 + (ob ^ (((ob >> 9) & 1) << 5)); }
__host__ __device__ __forceinline__ void stage_rc(int b, int& R, int& C) { const int st = b / 1024, sb = b % 1024, swz = sb ^ (((sb >> 9) & 1) << 5); R = (st >> 1) * 16 + swz / 64; C = (st & 1) * 32 + (swz % 64) / 2; }
__host__ __device__ __forceinline__ int perm32(int rho) { const int n = rho >> 4, i = rho & 15; return 8 * (i >> 2) + 4 * n + (i & 3); }

struct Unit { int pm, pn; };
struct Gemm { const bf16_t* A; const bf16_t* Bt; int M, N, K; };

struct StaticOrder {
    int nM, nN, nwg, G, c;
    __host__ __device__ void init(int M, int N, int G_, int c_) { nM = M / BM; nN = N / BM; nwg = nM * nN; G = G_; c = c_; }
    __host__ __device__ bool next(int i, Unit& u) const {
        const long L = (long)i * G + c; if (L >= nwg) return false;
        int wgid = (int)L; { const int q = nwg / NXCD, r = nwg % NXCD, xcd = wgid % NXCD, off = wgid / NXCD; wgid = (xcd < r ? xcd * (q + 1) : r * (q + 1) + (xcd - r) * q) + off; }
        const int nig = WGM * nN, gid = wgid / nig, fm = gid * WGM, gsz = (nM - fm) < WGM ? (nM - fm) : WGM;
        u.pm = fm + ((wgid % nig) % gsz); u.pn = (wgid % nig) / gsz; return true;
    }
    __device__ __forceinline__ void a_ready(const Unit&) const {}
    __device__ __forceinline__ void done(const Unit&) const {}
};

__device__ __forceinline__ unsigned cvt_pk_bf16(float lo, float hi) { unsigned r; asm volatile("v_cvt_pk_bf16_f32 %0, %1, %2" : "=v"(r) : "v"(lo), "v"(hi)); return r; }
typedef float f32x2 __attribute__((ext_vector_type(2)));

struct EpiStoreBf16 {
    static constexpr bool PERM = true, AFTER_DRAIN = false;
    bf16_t* O; int ldc; int ncolt;
    __device__ __forceinline__ void operator()(const f32x4 (&acc)[2][2][4][2], const Unit& u, int wr, int wc, int fr, int fq) const {
        const int row0 = u.pm * BM + wr * 64 + fr, col0 = (u.pn % ncolt) * BM + wc * 32 + 8 * fq;
#pragma unroll
        for (int ai = 0; ai < 2; ++ai)
#pragma unroll
            for (int m = 0; m < 4; ++m) { bf16_t* rowp = O + (size_t)(row0 + ai * HALF + m * 16) * ldc + col0;
#pragma unroll
                for (int bj = 0; bj < 2; ++bj) { const f32x4 v0 = acc[ai][bj][m][0], v1 = acc[ai][bj][m][1];
                    u32x4 w; w.x = cvt_pk_bf16(v0[0], v0[1]); w.y = cvt_pk_bf16(v0[2], v0[3]); w.z = cvt_pk_bf16(v1[0], v1[1]); w.w = cvt_pk_bf16(v1[2], v1[3]);
                    *(u32x4*)(rowp + bj * HALF) = w; } }
    }
};
struct EpiResid {
    static constexpr bool PERM = true, AFTER_DRAIN = false;
    bf16_t* X;
    __device__ __forceinline__ void operator()(const f32x4 (&acc)[2][2][4][2], const Unit& u, int wr, int wc, int fr, int fq) const {
        const int row0 = u.pm * BM + wr * 64 + fr, col0 = u.pn * BM + wc * 32 + 8 * fq;
        u32x4 t[2][4][2];
#pragma unroll
        for (int ai = 0; ai < 2; ++ai)
#pragma unroll
            for (int m = 0; m < 4; ++m) { const bf16_t* rowp = X + (size_t)(row0 + ai * HALF + m * 16) * 1024 + col0;
#pragma unroll
                for (int bj = 0; bj < 2; ++bj) t[ai][m][bj] = *(const u32x4*)(rowp + bj * HALF); }
#pragma unroll
        for (int ai = 0; ai < 2; ++ai)
#pragma unroll
            for (int m = 0; m < 4; ++m) { bf16_t* rowp = X + (size_t)(row0 + ai * HALF + m * 16) * 1024 + col0;
#pragma unroll
                for (int bj = 0; bj < 2; ++bj) { const f32x4 v0 = acc[ai][bj][m][0], v1 = acc[ai][bj][m][1]; const u32x4 x = t[ai][m][bj];
                    u32x4 w; w.x = cvt_pk_bf16(v0[0] + __uint_as_float(x.x << 16), v0[1] + __uint_as_float(x.x & 0xffff0000u)); w.y = cvt_pk_bf16(v0[2] + __uint_as_float(x.y << 16), v0[3] + __uint_as_float(x.y & 0xffff0000u));
                    w.z = cvt_pk_bf16(v1[0] + __uint_as_float(x.z << 16), v1[1] + __uint_as_float(x.z & 0xffff0000u)); w.w = cvt_pk_bf16(v1[2] + __uint_as_float(x.w << 16), v1[3] + __uint_as_float(x.w & 0xffff0000u));
                    *(u32x4*)(rowp + bj * HALF) = w; } }
    }
};
struct EpiSwiGLU {
    static constexpr bool PERM = true, AFTER_DRAIN = false;
    bf16_t* Hd;
    __device__ __forceinline__ void operator()(const f32x4 (&acc)[2][2][4][2], const Unit& u, int wr, int wc, int fr, int fq) const {
        const int row0 = u.pm * BM + wr * 64 + fr, col0 = (u.pn & 15) * HALF + wc * 32 + 8 * fq;
#pragma unroll
        for (int ai = 0; ai < 2; ++ai)
#pragma unroll
            for (int m = 0; m < 4; ++m) { bf16_t* rowp = Hd + (size_t)(row0 + ai * HALF + m * 16) * 2048 + col0;
                float h[8];
#pragma unroll
                for (int n = 0; n < 2; ++n)
#pragma unroll
                    for (int j = 0; j < 4; ++j) { const float a = acc[ai][0][m][n][j], b = acc[ai][1][m][n][j]; h[n * 4 + j] = a * __builtin_amdgcn_rcpf(1.0f + __expf(-a)) * b; }
                u32x4 w; w.x = cvt_pk_bf16(h[0], h[1]); w.y = cvt_pk_bf16(h[2], h[3]); w.z = cvt_pk_bf16(h[4], h[5]); w.w = cvt_pk_bf16(h[6], h[7]);
                *(u32x4*)rowp = w; }
    }
};

typedef unsigned u32x2v __attribute__((ext_vector_type(2)));
__device__ __forceinline__ unsigned pk4_fp8(float a, float b, float c, float d) {
    a = fminf(fmaxf(a, -448.f), 448.f); b = fminf(fmaxf(b, -448.f), 448.f); c = fminf(fmaxf(c, -448.f), 448.f); d = fminf(fmaxf(d, -448.f), 448.f);
    int w = 0; w = __builtin_amdgcn_cvt_pk_fp8_f32(a, b, w, false); w = __builtin_amdgcn_cvt_pk_fp8_f32(c, d, w, true); return (unsigned)w; }
typedef short v2s16 __attribute__((ext_vector_type(2)));
__device__ __forceinline__ unsigned pk4_fp8s(float a, float b, float c, float d, float scale) {
    v2s16 r = {0, 0}; r = __builtin_amdgcn_cvt_scalef32_pk_fp8_f32(r, a, b, scale, false); r = __builtin_amdgcn_cvt_scalef32_pk_fp8_f32(r, c, d, scale, true); return __builtin_bit_cast(unsigned, r); }
struct EpiSwiGLU8 {
    static constexpr bool PERM = true, AFTER_DRAIN = false;
    unsigned char* Hd;
    __device__ __forceinline__ void operator()(const f32x4 (&acc)[2][2][4][2], const Unit& u, int wr, int wc, int fr, int fq) const {
        const int row0 = u.pm * BM + wr * 64 + fr, col0 = (u.pn & 15) * HALF + wc * 32 + 8 * fq;
#pragma unroll
        for (int ai = 0; ai < 2; ++ai)
#pragma unroll
            for (int m = 0; m < 4; ++m) { unsigned char* rowp = Hd + (size_t)(row0 + ai * HALF + m * 16) * 2048 + col0;
                float h[8];
#pragma unroll
                for (int n = 0; n < 2; ++n)
#pragma unroll
                    for (int j = 0; j < 4; ++j) { const float a = acc[ai][0][m][n][j], b = acc[ai][1][m][n][j]; h[n * 4 + j] = 8.0f * a * __builtin_amdgcn_rcpf(1.0f + __expf(-a)) * b; }
                u32x2v w; w.x = pk4_fp8(h[0], h[1], h[2], h[3]); w.y = pk4_fp8(h[4], h[5], h[6], h[7]);
                *(u32x2v*)rowp = w; }
    }
};
struct EpiGate {
    static constexpr bool PERM = true, AFTER_DRAIN = false;
    bf16_t* Y; const float* gate;
    __device__ __forceinline__ void operator()(const f32x4 (&acc)[2][2][4][2], const Unit& u, int wr, int wc, int fr, int fq) const {
        const int row0 = u.pm * BM + wr * 64 + fr, col0 = (u.pn & 3) * BM + wc * 32 + 8 * fq;
        float gs[2][4];
#pragma unroll
        for (int ai = 0; ai < 2; ++ai)
#pragma unroll
            for (int m = 0; m < 4; ++m) gs[ai][m] = gate[row0 + ai * HALF + m * 16];
#pragma unroll
        for (int ai = 0; ai < 2; ++ai)
#pragma unroll
            for (int m = 0; m < 4; ++m) { const int row = row0 + ai * HALF + m * 16; const float g = gs[ai][m]; unsigned char* rowp = (unsigned char*)Y + (size_t)row * 1024 + col0;
#pragma unroll
                for (int bj = 0; bj < 2; ++bj) { const f32x4 v0 = acc[ai][bj][m][0] * g, v1 = acc[ai][bj][m][1] * g;
                    u32x2v w; w.x = pk4_fp8s(v0[0], v0[1], v0[2], v0[3], 0.125f); w.y = pk4_fp8s(v1[0], v1[1], v1[2], v1[3], 0.125f);
                    *(u32x2v*)(rowp + bj * HALF) = w; } }
    }
};

__device__ __forceinline__ void st_bf16(bf16_t* p, unsigned w, bool hi) { *p = (bf16_t)(hi ? (w >> 16) : (w & 0xffffu)); }
struct EpiProj {
    static constexpr bool PERM = true, AFTER_DRAIN = false;
    unsigned char* ws; const float* gt; const float* rrow;
    __device__ __forceinline__ void operator()(const f32x4 (&acc)[2][2][4][2], const Unit& u, int wr, int wc, int fr, int fq) const {
        const int pn = u.pn, row0 = u.pm * BM + wr * 64 + fr, lane = fq * 16 + fr;
        float rs[2][4];
#pragma unroll
        for (int ai = 0; ai < 2; ++ai)
#pragma unroll
            for (int m = 0; m < 4; ++m) rs[ai][m] = rrow[row0 + ai * HALF + m * 16];
        bf16_t* P = (bf16_t*)(ws + WS_PROJ); bf16_t* VT = (bf16_t*)(ws + WS_VT); bf16_t* NVT = (bf16_t*)(ws + WS_NVT); bf16_t* NRM = (bf16_t*)(ws + WS_NRM);
        if (pn == 6 || pn == 7 || pn == 9) {
            const int sel = pn == 6 ? 0 : (pn == 7 ? 1 : 2); const float* gsrc = gt + sel * 64; const float qs = pn == 7 ? 1.0f : 0.125f;
            f32x4 gv[2][2];
#pragma unroll
            for (int bj = 0; bj < 2; ++bj)
#pragma unroll
                for (int n = 0; n < 2; ++n) gv[bj][n] = *(const f32x4*)(gsrc + 32 * bj + 8 * fq + 4 * n);
            const int nb = (pn == 6 ? 0 : (pn == 7 ? 256 : 512)) + 64 * wc + 8 * fq, pb = pn * BM + 64 * wc + 8 * fq;
#pragma unroll
            for (int ai = 0; ai < 2; ++ai)
#pragma unroll
                for (int m = 0; m < 4; ++m) { const size_t row = (size_t)(row0 + ai * HALF + m * 16); float ss = 0.f;
#pragma unroll
                    for (int bj = 0; bj < 2; ++bj)
#pragma unroll
                        for (int n = 0; n < 2; ++n) { const f32x4 v = acc[ai][bj][m][n]; ss += v[0] * v[0] + v[1] * v[1] + v[2] * v[2] + v[3] * v[3]; }
                    ss = rows_sum4(ss) * rs[ai][m] * rs[ai][m];
                    const float rr = rsqrtf(ss * (1.0f / 64.0f) + 1e-6f) * qs * rs[ai][m];
#pragma unroll
                    for (int bj = 0; bj < 2; ++bj) { const f32x4 v0 = acc[ai][bj][m][0], v1 = acc[ai][bj][m][1];
                        const f32x4 n0 = v0 * gv[bj][0] * rr, n1 = v1 * gv[bj][1] * rr; u32x4 w;
                        w.x = cvt_pk_bf16(n0[0], n0[1]); w.y = cvt_pk_bf16(n0[2], n0[3]); w.z = cvt_pk_bf16(n1[0], n1[1]); w.w = cvt_pk_bf16(n1[2], n1[3]);
                        *(u32x4*)(NRM + row * 768 + nb + 32 * bj) = w; } }
            return;
        }
        const int col0 = pn * BM + wc * 32 + 8 * fq;
        if (pn == 4 || pn == 5) {
            unsigned char* OG = ws + WS_OG;
#pragma unroll
            for (int ai = 0; ai < 2; ++ai)
#pragma unroll
                for (int m = 0; m < 4; ++m) { unsigned char* rowp = OG + (size_t)(row0 + ai * HALF + m * 16) * 512 + (pn - 4) * BM + wc * 32 + 8 * fq;
#pragma unroll
                    for (int bj = 0; bj < 2; ++bj) { const f32x4 v0 = acc[ai][bj][m][0] * rs[ai][m], v1 = acc[ai][bj][m][1] * rs[ai][m];
                        u32x2v w; w.x = pk4_fp8(8.f * v0[0], 8.f * v0[1], 8.f * v0[2], 8.f * v0[3]); w.y = pk4_fp8(8.f * v1[0], 8.f * v1[1], 8.f * v1[2], 8.f * v1[3]);
                        *(u32x2v*)(rowp + bj * HALF) = w; } }
            return;
        }
        if (!(pn == 2 || pn == 3 || pn == 8))
#pragma unroll
        for (int ai = 0; ai < 2; ++ai)
#pragma unroll
            for (int m = 0; m < 4; ++m) { bf16_t* rowp = P + (size_t)(row0 + ai * HALF + m * 16) * 2560 + col0;
#pragma unroll
                for (int bj = 0; bj < 2; ++bj) { const f32x4 v0 = acc[ai][bj][m][0] * rs[ai][m], v1 = acc[ai][bj][m][1] * rs[ai][m];
                    u32x4 w; w.x = cvt_pk_bf16(v0[0], v0[1]); w.y = cvt_pk_bf16(v0[2], v0[3]); w.z = cvt_pk_bf16(v1[0], v1[1]); w.w = cvt_pk_bf16(v1[2], v1[3]);
                    *(u32x4*)(rowp + bj * HALF) = w; } }
        if (pn == 2 || pn == 3 || pn == 8) {
            const int b = u.pm >> 4, s0 = (u.pm & 15) * BM + wr * 64 + fr;
#pragma unroll
            for (int bj = 0; bj < 2; ++bj) {
                bf16_t* base;
                if (pn == 8) base = NVT + ((size_t)((b * 4 + 2 * bj + (wc >> 1)) * 64 + 32 * (wc & 1) + 8 * fq)) * 4096 + s0;
                else base = VT + ((size_t)((b * 4 + (pn - 2) * 2 + bj) * 128 + 32 * wc + 8 * fq)) * 4096 + s0;
#pragma unroll
                for (int ai = 0; ai < 2; ++ai)
#pragma unroll
                    for (int m = 0; m < 4; ++m)
#pragma unroll
                        for (int n = 0; n < 2; ++n) { const f32x4 v = acc[ai][bj][m][n] * rs[ai][m]; const unsigned w0 = cvt_pk_bf16(v[0], v[1]), w1 = cvt_pk_bf16(v[2], v[3]);
                            if (pn == 8) {
                                const int head = 2 * bj + (wc >> 1), dim = 32 * (wc & 1) + 8 * fq + 4 * n, gr = (u.pm & 15) * 4 + wr + 2 * ai, colq = m * 16 + fr;
                                bf16_t* q = NVT + ((size_t)(((b * 4 + head) * 64 + gr) * 64 + dim)) * 64 + colq;
                                st_bf16(q, w0, false); st_bf16(q + 64, w0, true); st_bf16(q + 128, w1, false); st_bf16(q + 192, w1, true); }
                            else { bf16_t* q = base + (size_t)(4 * n) * 4096 + ai * HALF + m * 16;
                                st_bf16(q, w0, false); st_bf16(q + 4096, w0, true); st_bf16(q + 2 * 4096, w1, false); st_bf16(q + 3 * 4096, w1, true); } }
            }
        }
    }
};
struct EpiKvMem {
    static constexpr bool PERM = true, AFTER_DRAIN = false;
    unsigned char* ws; const float* gk;
    __device__ __forceinline__ void operator()(const f32x4 (&acc)[2][2][4][2], const Unit& u, int wr, int wc, int fr, int fq) const {
        const int row0 = u.pm * BM + wr * 64 + fr, l = u.pn >> 1, lane = fq * 16 + fr;
        bf16_t* KMN = (bf16_t*)(ws + WS_KMN); bf16_t* VMT = (bf16_t*)(ws + WS_VMT);
        if ((u.pn & 1) == 0) {
            f32x4 gv[2][2];
#pragma unroll
            for (int bj = 0; bj < 2; ++bj)
#pragma unroll
                for (int n = 0; n < 2; ++n) gv[bj][n] = *(const f32x4*)(gk + l * 64 + 32 * bj + 8 * fq + 4 * n);
#pragma unroll
            for (int ai = 0; ai < 2; ++ai)
#pragma unroll
                for (int m = 0; m < 4; ++m) { const size_t row = (size_t)(row0 + ai * HALF + m * 16); float ss = 0.f;
#pragma unroll
                    for (int bj = 0; bj < 2; ++bj)
#pragma unroll
                        for (int n = 0; n < 2; ++n) { const f32x4 v = acc[ai][bj][m][n]; ss += v[0] * v[0] + v[1] * v[1] + v[2] * v[2] + v[3] * v[3]; }
                    ss = rows_sum4(ss);
                    const float rr = rsqrtf(ss * (1.0f / 64.0f) + 1e-6f);
#pragma unroll
                    for (int bj = 0; bj < 2; ++bj) { const f32x4 v0 = acc[ai][bj][m][0], v1 = acc[ai][bj][m][1];
                        const f32x4 n0 = v0 * gv[bj][0] * rr, n1 = v1 * gv[bj][1] * rr; u32x4 w;
                        w.x = cvt_pk_bf16(n0[0], n0[1]); w.y = cvt_pk_bf16(n0[2], n0[3]); w.z = cvt_pk_bf16(n1[0], n1[1]); w.w = cvt_pk_bf16(n1[2], n1[3]);
                        *(u32x4*)(KMN + row * 256 + 64 * wc + 32 * bj + 8 * fq) = w; } }
            return;
        }
        const int lb = u.pm;
#pragma unroll
        for (int bj = 0; bj < 2; ++bj) { bf16_t* base = VMT + ((size_t)((lb * 4 + 2 * bj + (wc >> 1)) * 64 + 32 * (wc & 1) + 8 * fq)) * 256 + wr * 64 + fr;
#pragma unroll
            for (int ai = 0; ai < 2; ++ai)
#pragma unroll
                for (int m = 0; m < 4; ++m)
#pragma unroll
                    for (int n = 0; n < 2; ++n) { const f32x4 v = acc[ai][bj][m][n]; const unsigned w0 = cvt_pk_bf16(v[0], v[1]), w1 = cvt_pk_bf16(v[2], v[3]);
                        bf16_t* q = base + (size_t)(4 * n) * 256 + ai * HALF + m * 16;
                        st_bf16(q, w0, false); st_bf16(q + 256, w0, true); st_bf16(q + 512, w1, false); st_bf16(q + 768, w1, true); } }
    }
};
struct KvOrder {
    int G, c;
    __device__ bool next(int i, Unit& u) const { const int L = i * G + c; if (L >= 64) return false; const int l = L >> 4, w = L & 15; u.pm = l * 8 + (w & 7); u.pn = l * 2 + (w >> 3); return true; }
    __device__ __forceinline__ void a_ready(const Unit&) const {}
    __device__ __forceinline__ void done(const Unit&) const {}
};
struct MoeOrder {
    int G, c, nN, upe;
    __device__ bool next(int i, Unit& u) const {
        const int L = i * G + c; if (L >= 16 * upe) return false;
        const int e = L / upe, w = L % upe, q = upe / NXCD, wgid = (w % NXCD) * q + w / NXCD;
        int nig = WGM * nN, gid = wgid / nig, pml = gid * WGM + (wgid % nig) % WGM, pnl = (wgid % nig) / WGM;
        if (nN == 4) { pml = 2 * (w % NXCD) + ((w / NXCD) & 1); pnl = (w / NXCD) >> 1; }
        const int ee = (nN == 4) ? 15 - e : e;
        u.pm = ee * 16 + pml; u.pn = ee * nN + pnl; return true;
    }
    __device__ __forceinline__ void a_ready(const Unit&) const {}
    __device__ __forceinline__ void done(const Unit&) const {}
};

template <class Epi, class Sched, bool ALIGN_EPI = false, bool SP2 = false>
__device__ __forceinline__ void gemm_phase(PG8_LAS unsigned char* lds, const Gemm g, const Sched& S, const Epi& E, const int tid) {
    const int wid = __builtin_amdgcn_readfirstlane(tid >> 6), lane = tid & 63, wr = wid >> 2, wc = wid & 3, fr = lane & 15, fq = lane >> 4;
    const int K = g.K, nt = K / BK;
    unsigned voffA[2], voffB[2];
#pragma unroll
    for (int i = 0; i < 2; ++i) { int R, C; stage_rc(tid * 16 + i * 8192, R, C); const int Rb = Epi::PERM ? ((R & ~31) + perm32(R & 31)) : R;
        voffA[i] = (unsigned)(R * K + C) * 2u; voffB[i] = (unsigned)(Rb * K + C) * 2u; }
    const size_t kstep = (size_t)(BK * 2);
    const size_t hstep = (size_t)HALF * K * 2;
    const size_t tstep = 2 * hstep;
    const unsigned ldsw = (unsigned)wid * 1024u;
    const int aoff = lds_byte(wr * 64 + fr, fq * 8), boff = lds_byte(wc * 32 + fr, fq * 8);
#define PG8_SA(b, h) (((b) * 2 + (h)) * HTB)
#define PG8_SB(b, h) ((4 + (b) * 2 + (h)) * HTB)
#define PG8_STAGE(bufoff, gbase, voff) do { _Pragma("unroll") for (int _i = 0; _i < 2; ++_i) \
        __builtin_amdgcn_global_load_lds((const unsigned*)((const char*)(gbase) + (voff)[_i]), (PG8_LAS unsigned*)(lds + (bufoff) + ldsw + _i * 8192), 16, 0, 0); } while (0)
#define PG8_LDA(dst, b, h) do { _Pragma("unroll") for (int m = 0; m < 4; ++m) _Pragma("unroll") for (int k = 0; k < 2; ++k) dst[m][k] = *(const PG8_LAS bf16x8*)(lds + PG8_SA(b, h) + aoff + m * 2048 + k * 1024); } while (0)
#define PG8_LDB(dst, b, h) do { _Pragma("unroll") for (int n = 0; n < 2; ++n) _Pragma("unroll") for (int k = 0; k < 2; ++k) dst[n][k] = *(const PG8_LAS bf16x8*)(lds + PG8_SB(b, h) + boff + n * 2048 + k * 1024); } while (0)
#define PG8_MMA(ai, bj, At, Bt) do { __builtin_amdgcn_s_setprio(1); _Pragma("unroll") for (int m = 0; m < 4; ++m) _Pragma("unroll") for (int n = 0; n < 2; ++n) _Pragma("unroll") for (int k = 0; k < 2; ++k) \
        acc[ai][bj][m][n] = __builtin_amdgcn_mfma_f32_16x16x32_bf16(Bt[n][k], At[m][k], acc[ai][bj][m][n], 0, 0, 0); __builtin_amdgcn_s_setprio(0); } while (0)
#define PG8_WAIT_V(n) asm volatile("s_waitcnt vmcnt(" #n ")" ::: "memory")
#define PG8_WAIT_L(n) asm volatile("s_waitcnt lgkmcnt(" #n ")" ::: "memory")
#define PG8_BAR __builtin_amdgcn_s_barrier()
#define PG8_SCHED __builtin_amdgcn_sched_barrier(0)
    Unit cur, nxt; int ui = 0;
    if (!S.next(0, cur)) return;
    f32x4 acc[2][2][4][2];
#pragma unroll
    for (int a = 0; a < 2; ++a)
#pragma unroll
        for (int b = 0; b < 2; ++b)
#pragma unroll
            for (int m = 0; m < 4; ++m)
#pragma unroll
                for (int n = 0; n < 2; ++n) acc[a][b][m][n] = (f32x4){0.f, 0.f, 0.f, 0.f};
    bf16x8 At[4][2], B0[2][2], B1[2][2];
    const char* cA = (const char*)g.A + (size_t)cur.pm * tstep; const char* cB = (const char*)g.Bt + (size_t)cur.pn * tstep;
    S.a_ready(cur);
    if constexpr (SP2) {
        PG8_STAGE(PG8_SB(0, 0), cB, voffB); PG8_STAGE(PG8_SB(0, 1), cB + hstep, voffB); PG8_STAGE(PG8_SA(0, 0), cA, voffA); PG8_STAGE(PG8_SA(0, 1), cA + hstep, voffA);
        if (wr == 1) PG8_BAR;
        PG8_WAIT_V(2); PG8_BAR;
        PG8_STAGE(PG8_SB(1, 0), cB + kstep, voffB); PG8_STAGE(PG8_SA(1, 0), cA + kstep, voffA); PG8_STAGE(PG8_SB(1, 1), cB + hstep + kstep, voffB);
        PG8_WAIT_V(6); PG8_BAR;
    } else {
        PG8_STAGE(PG8_SB(0, 0), cB, voffB); PG8_STAGE(PG8_SA(0, 0), cA, voffA); PG8_STAGE(PG8_SB(0, 1), cB + hstep, voffB); PG8_STAGE(PG8_SA(0, 1), cA + hstep, voffA);
        if (wr == 1) PG8_BAR;
        PG8_WAIT_V(4); PG8_BAR;
        PG8_STAGE(PG8_SB(1, 0), cB + kstep, voffB); PG8_STAGE(PG8_SA(1, 0), cA + kstep, voffA); PG8_STAGE(PG8_SB(1, 1), cB + hstep + kstep, voffB);
        PG8_WAIT_V(6); PG8_BAR;
    }
    for (;;) {
        const bool has_next = S.next(ui + 1, nxt);
        const char* nA = has_next ? (const char*)g.A + (size_t)nxt.pm * tstep : cA; const char* nB = has_next ? (const char*)g.Bt + (size_t)nxt.pn * tstep : cB;
        for (int t = 0; t < nt; t += 2) {
            const bool last = (t == nt - 2);
            const char* a1 = cA + (size_t)(t + 1) * kstep;
            const char* a2 = last ? nA : cA + (size_t)(t + 2) * kstep; const char* b2 = last ? nB : cB + (size_t)(t + 2) * kstep;
            const char* a3 = a2 + kstep; const char* b3 = b2 + kstep;
            if (last && has_next) S.a_ready(nxt);
            if constexpr (SP2) {
            PG8_LDB(B0, 0, 0); PG8_LDB(B1, 0, 1); PG8_SCHED; PG8_LDA(At, 0, 0); PG8_STAGE(PG8_SA(1, 1), a1 + hstep, voffA);
            PG8_WAIT_V(8); PG8_WAIT_L(0); PG8_BAR; PG8_MMA(0, 0, At, B0); PG8_MMA(0, 1, At, B1); PG8_BAR; PG8_SCHED;
            PG8_LDA(At, 0, 1); PG8_STAGE(PG8_SB(0, 0), b2, voffB); PG8_STAGE(PG8_SB(0, 1), b2 + hstep, voffB); PG8_STAGE(PG8_SA(0, 0), a2, voffA);
            PG8_WAIT_V(8); PG8_WAIT_L(0); PG8_BAR; PG8_MMA(1, 0, At, B0); PG8_MMA(1, 1, At, B1); PG8_BAR; PG8_SCHED;
            PG8_LDB(B0, 1, 0); PG8_LDB(B1, 1, 1); PG8_SCHED; PG8_LDA(At, 1, 0); PG8_STAGE(PG8_SA(0, 1), a2 + hstep, voffA);
            PG8_WAIT_V(8); PG8_WAIT_L(0); PG8_BAR; PG8_MMA(0, 0, At, B0); PG8_MMA(0, 1, At, B1); PG8_BAR; PG8_SCHED;
            PG8_LDA(At, 1, 1); PG8_STAGE(PG8_SB(1, 0), b3, voffB); PG8_STAGE(PG8_SB(1, 1), b3 + hstep, voffB); PG8_STAGE(PG8_SA(1, 0), a3, voffA);
            PG8_WAIT_V(8); PG8_WAIT_L(0); PG8_BAR; PG8_MMA(1, 0, At, B0); PG8_MMA(1, 1, At, B1); PG8_BAR; PG8_SCHED;
            } else {
            PG8_LDB(B0, 0, 0); PG8_SCHED; PG8_LDA(At, 0, 0); PG8_STAGE(PG8_SA(1, 1), a1 + hstep, voffA);
            PG8_WAIT_L(8); PG8_BAR; PG8_WAIT_L(0); PG8_MMA(0, 0, At, B0); PG8_BAR; PG8_SCHED;
            PG8_LDB(B1, 0, 1); PG8_STAGE(PG8_SB(0, 0), b2, voffB);
            PG8_BAR; PG8_WAIT_L(0); PG8_MMA(0, 1, At, B1); PG8_BAR;
            PG8_LDA(At, 0, 1); PG8_STAGE(PG8_SA(0, 0), a2, voffA);
            PG8_BAR; PG8_WAIT_L(0); PG8_MMA(1, 0, At, B0); PG8_BAR; PG8_SCHED;
            PG8_STAGE(PG8_SB(0, 1), b2 + hstep, voffB);
            PG8_WAIT_V(6); PG8_BAR; PG8_MMA(1, 1, At, B1); PG8_BAR;
            PG8_LDB(B0, 1, 0); PG8_SCHED; PG8_LDA(At, 1, 0); PG8_STAGE(PG8_SA(0, 1), a2 + hstep, voffA);
            PG8_WAIT_L(8); PG8_BAR; PG8_WAIT_L(0); PG8_MMA(0, 0, At, B0); PG8_BAR; PG8_SCHED;
            PG8_LDB(B1, 1, 1); PG8_STAGE(PG8_SB(1, 0), b3, voffB);
            PG8_BAR; PG8_WAIT_L(0); PG8_MMA(0, 1, At, B1); PG8_BAR;
            PG8_LDA(At, 1, 1); PG8_STAGE(PG8_SA(1, 0), a3, voffA);
            PG8_BAR; PG8_WAIT_L(0); PG8_MMA(1, 0, At, B0); PG8_BAR; PG8_SCHED;
            PG8_STAGE(PG8_SB(1, 1), b3 + hstep, voffB);
            PG8_WAIT_V(6); PG8_BAR; PG8_MMA(1, 1, At, B1); PG8_BAR;
            }
        }
        if constexpr (ALIGN_EPI) { if (wr == 0) PG8_BAR; }
        asm volatile("s_nop 15\n\ts_nop 15" ::: "memory");
        if constexpr (!Epi::AFTER_DRAIN) { E(acc, cur, wr, wc, fr, fq); S.done(cur); }
        if (!has_next) break;
#pragma unroll
        for (int a = 0; a < 2; ++a)
#pragma unroll
            for (int b = 0; b < 2; ++b)
#pragma unroll
                for (int m = 0; m < 4; ++m)
#pragma unroll
                    for (int n = 0; n < 2; ++n) acc[a][b][m][n] = (f32x4){0.f, 0.f, 0.f, 0.f};
        cur = nxt; cA = nA; cB = nB; ++ui;
        if constexpr (ALIGN_EPI) { if (wr == 1) PG8_BAR; }
    }
    PG8_WAIT_V(0);
    if constexpr (!ALIGN_EPI) { if (wr == 0) PG8_BAR; }
    PG8_BAR;
    if constexpr (Epi::AFTER_DRAIN) { E.fused(acc, cur, wr, wc, fr, fq, lds, wid, lane); S.done(cur); }
#undef PG8_SA
#undef PG8_SB
#undef PG8_STAGE
#undef PG8_LDA
#undef PG8_LDB
#undef PG8_MMA
#undef PG8_WAIT_V
#undef PG8_WAIT_L
#undef PG8_BAR
#undef PG8_SCHED
}

typedef int v8i __attribute__((ext_vector_type(8)));
typedef int v4i __attribute__((ext_vector_type(4)));
__host__ __device__ __forceinline__ int lds_byte8(int r, int c) { const int st = (r >> 4) * 2 + (c >> 5), rr = r & 15, cc = c & 31, ob = rr * 64 + cc * 2; return st * 1024 + (ob ^ (((ob >> 9) & 1) << 4)); }
__host__ __device__ __forceinline__ void stage_rc8(int b, int& R, int& C) { const int st = b / 1024, sb = b % 1024, swz = sb ^ (((sb >> 9) & 1) << 4); R = (st >> 1) * 16 + swz / 64; C = (st & 1) * 32 + (swz % 64) / 2; }
template <class Epi, class Sched, bool ALIGN_EPI, bool SP2, int SCA  , int SCB  >
__device__ __forceinline__ void gemm_phase_f8(PG8_LAS unsigned char* lds, const Gemm g, const Sched& S, const Epi& E, const int tid) {
    const int wid = __builtin_amdgcn_readfirstlane(tid >> 6), lane = tid & 63, wr = wid >> 2, wc = wid & 3, fr = lane & 15, fq = lane >> 4;
    const int K = g.K, nt = K / BK;
    unsigned voffA[2], voffB[2];
#pragma unroll
    for (int i = 0; i < 2; ++i) { int R, C; stage_rc8(tid * 16 + i * 8192, R, C); const int Rb = Epi::PERM ? ((R & ~31) + perm32(R & 31)) : R;
        voffA[i] = (unsigned)(R * K + C) * 2u; voffB[i] = (unsigned)(Rb * K + C) * 2u; }
    const size_t kstep = (size_t)(BK * 2);
    const size_t hstep = (size_t)HALF * K * 2;
    const size_t tstep = 2 * hstep;
    const unsigned ldsw = (unsigned)wid * 1024u;
    const int aoff = lds_byte8(wr * 64 + fr, fq * 16), boff = lds_byte8(wc * 32 + fr, fq * 16);
#define PG8_SA(b, h) (((b) * 2 + (h)) * HTB)
#define PG8_SB(b, h) ((4 + (b) * 2 + (h)) * HTB)
#define PG8_STAGE(bufoff, gbase, voff) do { _Pragma("unroll") for (int _i = 0; _i < 2; ++_i) \
        __builtin_amdgcn_global_load_lds((const unsigned*)((const char*)(gbase) + (voff)[_i]), (PG8_LAS unsigned*)(lds + (bufoff) + ldsw + _i * 8192), 16, 0, 0); } while (0)
#define PG8_LDA(dst, b, h) do { _Pragma("unroll") for (int m = 0; m < 4; ++m) { const u32x4 lo_ = *(const PG8_LAS u32x4*)(lds + PG8_SA(b, h) + aoff + m * 2048), hi_ = *(const PG8_LAS u32x4*)(lds + PG8_SA(b, h) + (aoff ^ 16) + m * 2048); \
        dst[m] = __builtin_shufflevector(__builtin_bit_cast(v4i, lo_), __builtin_bit_cast(v4i, hi_), 0, 1, 2, 3, 4, 5, 6, 7); } } while (0)
#define PG8_LDB(dst, b, h) do { _Pragma("unroll") for (int n = 0; n < 2; ++n) { const u32x4 lo_ = *(const PG8_LAS u32x4*)(lds + PG8_SB(b, h) + boff + n * 2048), hi_ = *(const PG8_LAS u32x4*)(lds + PG8_SB(b, h) + (boff ^ 16) + n * 2048); \
        dst[n] = __builtin_shufflevector(__builtin_bit_cast(v4i, lo_), __builtin_bit_cast(v4i, hi_), 0, 1, 2, 3, 4, 5, 6, 7); } } while (0)
#define PG8_MMA(ai, bj, At, Bt) do { __builtin_amdgcn_s_setprio(1); _Pragma("unroll") for (int m = 0; m < 4; ++m) _Pragma("unroll") for (int n = 0; n < 2; ++n) \
        asm volatile("v_mfma_scale_f32_16x16x128_f8f6f4 %0, %1, %2, %0, %3, %4 op_sel_hi:[0,0,0]" : "+v"(acc[ai][bj][m][n]) : "v"(Bt[n]), "v"(At[m]), "v"(scb_), "v"(sca_)); __builtin_amdgcn_s_setprio(0); } while (0)
#define PG8_WAIT_V(n) asm volatile("s_waitcnt vmcnt(" #n ")" ::: "memory")
#define PG8_WAIT_L(n) asm volatile("s_waitcnt lgkmcnt(" #n ")" ::: "memory")
#define PG8_BAR __builtin_amdgcn_s_barrier()
#define PG8_SCHED __builtin_amdgcn_sched_barrier(0)
    Unit cur, nxt; int ui = 0;
    if (!S.next(0, cur)) return;
    f32x4 acc[2][2][4][2];
#pragma unroll
    for (int a = 0; a < 2; ++a)
#pragma unroll
        for (int b = 0; b < 2; ++b)
#pragma unroll
            for (int m = 0; m < 4; ++m)
#pragma unroll
                for (int n = 0; n < 2; ++n) acc[a][b][m][n] = (f32x4){0.f, 0.f, 0.f, 0.f};
    v8i At[4], B0[2], B1[2]; const int scb_ = SCB, sca_ = SCA;
    const char* cA = (const char*)g.A + (size_t)cur.pm * tstep; const char* cB = (const char*)g.Bt + (size_t)cur.pn * tstep;
    S.a_ready(cur);
    if constexpr (SP2) {
        PG8_STAGE(PG8_SB(0, 0), cB, voffB); PG8_STAGE(PG8_SB(0, 1), cB + hstep, voffB); PG8_STAGE(PG8_SA(0, 0), cA, voffA); PG8_STAGE(PG8_SA(0, 1), cA + hstep, voffA);
        if (wr == 1) PG8_BAR;
        PG8_WAIT_V(2); PG8_BAR;
        PG8_STAGE(PG8_SB(1, 0), cB + kstep, voffB); PG8_STAGE(PG8_SA(1, 0), cA + kstep, voffA); PG8_STAGE(PG8_SB(1, 1), cB + hstep + kstep, voffB);
        PG8_WAIT_V(6); PG8_BAR;
    } else {
        PG8_STAGE(PG8_SB(0, 0), cB, voffB); PG8_STAGE(PG8_SA(0, 0), cA, voffA); PG8_STAGE(PG8_SB(0, 1), cB + hstep, voffB); PG8_STAGE(PG8_SA(0, 1), cA + hstep, voffA);
        if (wr == 1) PG8_BAR;
        PG8_WAIT_V(4); PG8_BAR;
        PG8_STAGE(PG8_SB(1, 0), cB + kstep, voffB); PG8_STAGE(PG8_SA(1, 0), cA + kstep, voffA); PG8_STAGE(PG8_SB(1, 1), cB + hstep + kstep, voffB);
        PG8_WAIT_V(6); PG8_BAR;
    }
    for (;;) {
        const bool has_next = S.next(ui + 1, nxt);
        const char* nA = has_next ? (const char*)g.A + (size_t)nxt.pm * tstep : cA; const char* nB = has_next ? (const char*)g.Bt + (size_t)nxt.pn * tstep : cB;
        for (int t = 0; t < nt; t += 2) {
            const bool last = (t == nt - 2);
            const char* a1 = cA + (size_t)(t + 1) * kstep;
            const char* a2 = last ? nA : cA + (size_t)(t + 2) * kstep; const char* b2 = last ? nB : cB + (size_t)(t + 2) * kstep;
            const char* a3 = a2 + kstep; const char* b3 = b2 + kstep;
            if (last && has_next) S.a_ready(nxt);
            if constexpr (SP2) {
            PG8_LDB(B0, 0, 0); PG8_LDB(B1, 0, 1); PG8_SCHED; PG8_LDA(At, 0, 0); PG8_STAGE(PG8_SA(1, 1), a1 + hstep, voffA);
            PG8_WAIT_V(8); PG8_WAIT_L(0); PG8_BAR; PG8_MMA(0, 0, At, B0); PG8_MMA(0, 1, At, B1); PG8_BAR; PG8_SCHED;
            PG8_LDA(At, 0, 1); PG8_STAGE(PG8_SB(0, 0), b2, voffB); PG8_STAGE(PG8_SB(0, 1), b2 + hstep, voffB); PG8_STAGE(PG8_SA(0, 0), a2, voffA);
            PG8_WAIT_V(8); PG8_WAIT_L(0); PG8_BAR; PG8_MMA(1, 0, At, B0); PG8_MMA(1, 1, At, B1); PG8_BAR; PG8_SCHED;
            PG8_LDB(B0, 1, 0); PG8_LDB(B1, 1, 1); PG8_SCHED; PG8_LDA(At, 1, 0); PG8_STAGE(PG8_SA(0, 1), a2 + hstep, voffA);
            PG8_WAIT_V(8); PG8_WAIT_L(0); PG8_BAR; PG8_MMA(0, 0, At, B0); PG8_MMA(0, 1, At, B1); PG8_BAR; PG8_SCHED;
            PG8_LDA(At, 1, 1); PG8_STAGE(PG8_SB(1, 0), b3, voffB); PG8_STAGE(PG8_SB(1, 1), b3 + hstep, voffB); PG8_STAGE(PG8_SA(1, 0), a3, voffA);
            PG8_WAIT_V(8); PG8_WAIT_L(0); PG8_BAR; PG8_MMA(1, 0, At, B0); PG8_MMA(1, 1, At, B1); PG8_BAR; PG8_SCHED;
            } else {
            PG8_LDB(B0, 0, 0); PG8_SCHED; PG8_LDA(At, 0, 0); PG8_STAGE(PG8_SA(1, 1), a1 + hstep, voffA);
            PG8_WAIT_L(8); PG8_BAR; PG8_WAIT_L(0); PG8_MMA(0, 0, At, B0); PG8_BAR; PG8_SCHED;
            PG8_LDB(B1, 0, 1); PG8_STAGE(PG8_SB(0, 0), b2, voffB);
            PG8_BAR; PG8_WAIT_L(0); PG8_MMA(0, 1, At, B1); PG8_BAR;
            PG8_LDA(At, 0, 1); PG8_STAGE(PG8_SA(0, 0), a2, voffA);
            PG8_BAR; PG8_WAIT_L(0); PG8_MMA(1, 0, At, B0); PG8_BAR; PG8_SCHED;
            PG8_STAGE(PG8_SB(0, 1), b2 + hstep, voffB);
            PG8_WAIT_V(6); PG8_BAR; PG8_MMA(1, 1, At, B1); PG8_BAR;
            PG8_LDB(B0, 1, 0); PG8_SCHED; PG8_LDA(At, 1, 0); PG8_STAGE(PG8_SA(0, 1), a2 + hstep, voffA);
            PG8_WAIT_L(8); PG8_BAR; PG8_WAIT_L(0); PG8_MMA(0, 0, At, B0); PG8_BAR; PG8_SCHED;
            PG8_LDB(B1, 1, 1); PG8_STAGE(PG8_SB(1, 0), b3, voffB);
            PG8_BAR; PG8_WAIT_L(0); PG8_MMA(0, 1, At, B1); PG8_BAR;
            PG8_LDA(At, 1, 1); PG8_STAGE(PG8_SA(1, 0), a3, voffA);
            PG8_BAR; PG8_WAIT_L(0); PG8_MMA(1, 0, At, B0); PG8_BAR; PG8_SCHED;
            PG8_STAGE(PG8_SB(1, 1), b3 + hstep, voffB);
            PG8_WAIT_V(6); PG8_BAR; PG8_MMA(1, 1, At, B1); PG8_BAR;
            }
        }
        if constexpr (ALIGN_EPI) { if (wr == 0) PG8_BAR; }
        asm volatile("s_nop 15\n\ts_nop 15" ::: "memory");
        if constexpr (!Epi::AFTER_DRAIN) { E(acc, cur, wr, wc, fr, fq); S.done(cur); }
        if (!has_next) break;
#pragma unroll
        for (int a = 0; a < 2; ++a)
#pragma unroll
            for (int b = 0; b < 2; ++b)
#pragma unroll
                for (int m = 0; m < 4; ++m)
#pragma unroll
                    for (int n = 0; n < 2; ++n) acc[a][b][m][n] = (f32x4){0.f, 0.f, 0.f, 0.f};
        cur = nxt; cA = nA; cB = nB; ++ui;
        if constexpr (ALIGN_EPI) { if (wr == 1) PG8_BAR; }
    }
    PG8_WAIT_V(0);
    if constexpr (!ALIGN_EPI) { if (wr == 0) PG8_BAR; }
    PG8_BAR;
    if constexpr (Epi::AFTER_DRAIN) { E.fused(acc, cur, wr, wc, fr, fq, lds, wid, lane); S.done(cur); }
#undef PG8_SA
#undef PG8_SB
#undef PG8_STAGE
#undef PG8_LDA
#undef PG8_LDB
#undef PG8_MMA
#undef PG8_WAIT_V
#undef PG8_WAIT_L
#undef PG8_BAR
#undef PG8_SCHED
}


template <class Epi, class Sched, bool ALIGN_EPI, bool SP2, int SCA  , int SCB  >
__device__ __forceinline__ void gemm_phase_f8g(PG8_LAS unsigned char* lds, const Gemm g, const Sched& S, const Epi& E, const int tid, const int* rowtab) {
    const int wid = __builtin_amdgcn_readfirstlane(tid >> 6), lane = tid & 63, wr = wid >> 2, wc = wid & 3, fr = lane & 15, fq = lane >> 4;
    const int K = g.K, nt = K / BK;
    unsigned voffA[2], voffB[2]; int gR0 = 0; unsigned gCb = 0;
#pragma unroll
    for (int i = 0; i < 2; ++i) { int R, C; stage_rc8(tid * 16 + i * 8192, R, C); const int Rb = Epi::PERM ? ((R & ~31) + perm32(R & 31)) : R;
        voffA[i] = (unsigned)(R * K + C) * 2u; voffB[i] = (unsigned)(Rb * K + C) * 2u; if (i == 0) { gR0 = R; gCb = (unsigned)C * 2u; } }
    const size_t kstep = (size_t)(BK * 2);
    const size_t hstep = (size_t)HALF * K * 2;
    const size_t tstep = 2 * hstep;
    const unsigned ldsw = (unsigned)wid * 1024u;
    const int aoff = lds_byte8(wr * 64 + fr, fq * 16), boff = lds_byte8(wc * 32 + fr, fq * 16);
#define PG8_SA(b, h) (((b) * 2 + (h)) * HTB)
#define PG8_SB(b, h) ((4 + (b) * 2 + (h)) * HTB)
#define PG8_STAGE(bufoff, gbase, voff) do { _Pragma("unroll") for (int _i = 0; _i < 2; ++_i) \
        __builtin_amdgcn_global_load_lds((const unsigned*)((const char*)(gbase) + (voff)[_i]), (PG8_LAS unsigned*)(lds + (bufoff) + ldsw + _i * 8192), 16, 0, 0); } while (0)
#define PG8_STAGE_G(bufoff, o0, o1, kb) do { __builtin_amdgcn_global_load_lds((const unsigned*)((const char*)g.A + (o0) + (kb)), (PG8_LAS unsigned*)(lds + (bufoff) + ldsw), 16, 0, 0); \
        __builtin_amdgcn_global_load_lds((const unsigned*)((const char*)g.A + (o1) + (kb)), (PG8_LAS unsigned*)(lds + (bufoff) + ldsw + 8192), 16, 0, 0); } while (0)
#define PG8_ROWOFF(dst, pm_) do { const int* rt_ = rowtab + (pm_) * 256 + gR0; const unsigned kb_ = 2u * (unsigned)K; \
        dst[0][0] = (unsigned)rt_[0] * kb_ + gCb; dst[0][1] = (unsigned)rt_[64] * kb_ + gCb; dst[1][0] = (unsigned)rt_[128] * kb_ + gCb; dst[1][1] = (unsigned)rt_[192] * kb_ + gCb; } while (0)
#define PG8_LDA(dst, b, h) do { _Pragma("unroll") for (int m = 0; m < 4; ++m) { const u32x4 lo_ = *(const PG8_LAS u32x4*)(lds + PG8_SA(b, h) + aoff + m * 2048), hi_ = *(const PG8_LAS u32x4*)(lds + PG8_SA(b, h) + (aoff ^ 16) + m * 2048); \
        dst[m] = __builtin_shufflevector(__builtin_bit_cast(v4i, lo_), __builtin_bit_cast(v4i, hi_), 0, 1, 2, 3, 4, 5, 6, 7); } } while (0)
#define PG8_LDB(dst, b, h) do { _Pragma("unroll") for (int n = 0; n < 2; ++n) { const u32x4 lo_ = *(const PG8_LAS u32x4*)(lds + PG8_SB(b, h) + boff + n * 2048), hi_ = *(const PG8_LAS u32x4*)(lds + PG8_SB(b, h) + (boff ^ 16) + n * 2048); \
        dst[n] = __builtin_shufflevector(__builtin_bit_cast(v4i, lo_), __builtin_bit_cast(v4i, hi_), 0, 1, 2, 3, 4, 5, 6, 7); } } while (0)
#define PG8_MMA(ai, bj, At, Bt) do { __builtin_amdgcn_s_setprio(1); _Pragma("unroll") for (int m = 0; m < 4; ++m) _Pragma("unroll") for (int n = 0; n < 2; ++n) \
        asm volatile("v_mfma_scale_f32_16x16x128_f8f6f4 %0, %1, %2, %0, %3, %4 op_sel_hi:[0,0,0]" : "+v"(acc[ai][bj][m][n]) : "v"(Bt[n]), "v"(At[m]), "v"(scb_), "v"(sca_)); __builtin_amdgcn_s_setprio(0); } while (0)
#define PG8_WAIT_V(n) asm volatile("s_waitcnt vmcnt(" #n ")" ::: "memory")
#define PG8_WAIT_L(n) asm volatile("s_waitcnt lgkmcnt(" #n ")" ::: "memory")
#define PG8_BAR __builtin_amdgcn_s_barrier()
#define PG8_SCHED __builtin_amdgcn_sched_barrier(0)
    Unit cur, nxt; int ui = 0;
    if (!S.next(0, cur)) return;
    f32x4 acc[2][2][4][2];
#pragma unroll
    for (int a = 0; a < 2; ++a)
#pragma unroll
        for (int b = 0; b < 2; ++b)
#pragma unroll
            for (int m = 0; m < 4; ++m)
#pragma unroll
                for (int n = 0; n < 2; ++n) acc[a][b][m][n] = (f32x4){0.f, 0.f, 0.f, 0.f};
    v8i At[4], B0[2], B1[2]; const int scb_ = SCB, sca_ = SCA;
    const char* cA = (const char*)g.A + (size_t)cur.pm * tstep; const char* cB = (const char*)g.Bt + (size_t)cur.pn * tstep;
    S.a_ready(cur);
    unsigned co[2][2], no[2][2]; PG8_ROWOFF(co, cur.pm);
    if constexpr (SP2) {
        PG8_STAGE(PG8_SB(0, 0), cB, voffB); PG8_STAGE(PG8_SB(0, 1), cB + hstep, voffB); PG8_STAGE_G(PG8_SA(0, 0), co[0][0], co[0][1], 0); PG8_STAGE_G(PG8_SA(0, 1), co[1][0], co[1][1], 0);
        if (wr == 1) PG8_BAR;
        PG8_WAIT_V(2); PG8_BAR;
        PG8_STAGE(PG8_SB(1, 0), cB + kstep, voffB); PG8_STAGE_G(PG8_SA(1, 0), co[0][0], co[0][1], kstep); PG8_STAGE(PG8_SB(1, 1), cB + hstep + kstep, voffB);
        PG8_WAIT_V(6); PG8_BAR;
    } else {
        PG8_STAGE(PG8_SB(0, 0), cB, voffB); PG8_STAGE(PG8_SA(0, 0), cA, voffA); PG8_STAGE(PG8_SB(0, 1), cB + hstep, voffB); PG8_STAGE(PG8_SA(0, 1), cA + hstep, voffA);
        if (wr == 1) PG8_BAR;
        PG8_WAIT_V(4); PG8_BAR;
        PG8_STAGE(PG8_SB(1, 0), cB + kstep, voffB); PG8_STAGE(PG8_SA(1, 0), cA + kstep, voffA); PG8_STAGE(PG8_SB(1, 1), cB + hstep + kstep, voffB);
        PG8_WAIT_V(6); PG8_BAR;
    }
    for (;;) {
        const bool has_next = S.next(ui + 1, nxt);
        const char* nA = cA; const char* nB = has_next ? (const char*)g.Bt + (size_t)nxt.pn * tstep : cB;
        if (has_next) PG8_ROWOFF(no, nxt.pm); else { no[0][0] = co[0][0]; no[0][1] = co[0][1]; no[1][0] = co[1][0]; no[1][1] = co[1][1]; }
        for (int t = 0; t < nt; t += 2) {
            const bool last = (t == nt - 2);
            const char* a1 = cA + (size_t)(t + 1) * kstep;
            const char* a2 = last ? nA : cA + (size_t)(t + 2) * kstep; const char* b2 = last ? nB : cB + (size_t)(t + 2) * kstep;
            const char* a3 = a2 + kstep; const char* b3 = b2 + kstep;
            if (last && has_next) S.a_ready(nxt);
            const unsigned s00 = last ? no[0][0] : co[0][0], s01 = last ? no[0][1] : co[0][1], s10 = last ? no[1][0] : co[1][0], s11 = last ? no[1][1] : co[1][1];
            const size_t k1 = (size_t)(t + 1) * kstep, k2 = last ? (size_t)0 : (size_t)(t + 2) * kstep;
            if constexpr (SP2) {
            PG8_LDB(B0, 0, 0); PG8_LDB(B1, 0, 1); PG8_SCHED; PG8_LDA(At, 0, 0); PG8_STAGE_G(PG8_SA(1, 1), co[1][0], co[1][1], k1);
            PG8_WAIT_V(8); PG8_WAIT_L(0); PG8_BAR; PG8_MMA(0, 0, At, B0); PG8_MMA(0, 1, At, B1); PG8_BAR; PG8_SCHED;
            PG8_LDA(At, 0, 1); PG8_STAGE(PG8_SB(0, 0), b2, voffB); PG8_STAGE(PG8_SB(0, 1), b2 + hstep, voffB); PG8_STAGE_G(PG8_SA(0, 0), s00, s01, k2);
            PG8_WAIT_V(8); PG8_WAIT_L(0); PG8_BAR; PG8_MMA(1, 0, At, B0); PG8_MMA(1, 1, At, B1); PG8_BAR; PG8_SCHED;
            PG8_LDB(B0, 1, 0); PG8_LDB(B1, 1, 1); PG8_SCHED; PG8_LDA(At, 1, 0); PG8_STAGE_G(PG8_SA(0, 1), s10, s11, k2);
            PG8_WAIT_V(8); PG8_WAIT_L(0); PG8_BAR; PG8_MMA(0, 0, At, B0); PG8_MMA(0, 1, At, B1); PG8_BAR; PG8_SCHED;
            PG8_LDA(At, 1, 1); PG8_STAGE(PG8_SB(1, 0), b3, voffB); PG8_STAGE(PG8_SB(1, 1), b3 + hstep, voffB); PG8_STAGE_G(PG8_SA(1, 0), s00, s01, k2 + kstep);
            PG8_WAIT_V(8); PG8_WAIT_L(0); PG8_BAR; PG8_MMA(1, 0, At, B0); PG8_MMA(1, 1, At, B1); PG8_BAR; PG8_SCHED;
            } else {
            PG8_LDB(B0, 0, 0); PG8_SCHED; PG8_LDA(At, 0, 0); PG8_STAGE(PG8_SA(1, 1), a1 + hstep, voffA);
            PG8_WAIT_L(8); PG8_BAR; PG8_WAIT_L(0); PG8_MMA(0, 0, At, B0); PG8_BAR; PG8_SCHED;
            PG8_LDB(B1, 0, 1); PG8_STAGE(PG8_SB(0, 0), b2, voffB);
            PG8_BAR; PG8_WAIT_L(0); PG8_MMA(0, 1, At, B1); PG8_BAR;
            PG8_LDA(At, 0, 1); PG8_STAGE(PG8_SA(0, 0), a2, voffA);
            PG8_BAR; PG8_WAIT_L(0); PG8_MMA(1, 0, At, B0); PG8_BAR; PG8_SCHED;
            PG8_STAGE(PG8_SB(0, 1), b2 + hstep, voffB);
            PG8_WAIT_V(6); PG8_BAR; PG8_MMA(1, 1, At, B1); PG8_BAR;
            PG8_LDB(B0, 1, 0); PG8_SCHED; PG8_LDA(At, 1, 0); PG8_STAGE(PG8_SA(0, 1), a2 + hstep, voffA);
            PG8_WAIT_L(8); PG8_BAR; PG8_WAIT_L(0); PG8_MMA(0, 0, At, B0); PG8_BAR; PG8_SCHED;
            PG8_LDB(B1, 1, 1); PG8_STAGE(PG8_SB(1, 0), b3, voffB);
            PG8_BAR; PG8_WAIT_L(0); PG8_MMA(0, 1, At, B1); PG8_BAR;
            PG8_LDA(At, 1, 1); PG8_STAGE(PG8_SA(1, 0), a3, voffA);
            PG8_BAR; PG8_WAIT_L(0); PG8_MMA(1, 0, At, B0); PG8_BAR; PG8_SCHED;
            PG8_STAGE(PG8_SB(1, 1), b3 + hstep, voffB);
            PG8_WAIT_V(6); PG8_BAR; PG8_MMA(1, 1, At, B1); PG8_BAR;
            }
        }
        if constexpr (ALIGN_EPI) { if (wr == 0) PG8_BAR; }
        asm volatile("s_nop 15\n\ts_nop 15" ::: "memory");
        if constexpr (!Epi::AFTER_DRAIN) { E(acc, cur, wr, wc, fr, fq); S.done(cur); }
        if (!has_next) break;
#pragma unroll
        for (int a = 0; a < 2; ++a)
#pragma unroll
            for (int b = 0; b < 2; ++b)
#pragma unroll
                for (int m = 0; m < 4; ++m)
#pragma unroll
                    for (int n = 0; n < 2; ++n) acc[a][b][m][n] = (f32x4){0.f, 0.f, 0.f, 0.f};
        cur = nxt; cA = nA; cB = nB; ++ui; co[0][0] = no[0][0]; co[0][1] = no[0][1]; co[1][0] = no[1][0]; co[1][1] = no[1][1];
        if constexpr (ALIGN_EPI) { if (wr == 1) PG8_BAR; }
    }
    PG8_WAIT_V(0);
    if constexpr (!ALIGN_EPI) { if (wr == 0) PG8_BAR; }
    PG8_BAR;
    if constexpr (Epi::AFTER_DRAIN) { E.fused(acc, cur, wr, wc, fr, fq, lds, wid, lane); S.done(cur); }
#undef PG8_SA
#undef PG8_SB
#undef PG8_STAGE
#undef PG8_STAGE_G
#undef PG8_ROWOFF
#undef PG8_LDA
#undef PG8_LDB
#undef PG8_MMA
#undef PG8_WAIT_V
#undef PG8_WAIT_L
#undef PG8_BAR
#undef PG8_SCHED
}


}

#ifndef ATTN_NAIVE
#define ATTN_NAIVE 0
#endif
#ifndef REP_MASK
#define REP_MASK 0
#endif
#define REPEAT(j) for (int rep_ = 0; rep_ < ((REP_MASK >> (j)) & 1) + 1; ++rep_)
#ifndef MLSTM_NAIVE
#define MLSTM_NAIVE 0
#endif
constexpr int D = 1024, BATCH = 8, SEQ = 4096, DEPTH = 4, NTOK = BATCH * SEQ, NMEM = 256, NE = 16, CAP = 512, DFF = 2048, NSLOT = BATCH * NE * CAP;
constexpr int DIN = 2576, NPROJ = 2560;
constexpr int C_MQ = 0, C_MK = 256, C_MV = 512, C_MO = 1024, C_NQ = 1536, C_NK = 1792, C_NV = 2048, C_CQ = 2304;
constexpr int GATE_COL = 1536;
constexpr float EPS = 1e-6f;
constexpr int NPHASE = 2 + 11 * DEPTH + 1;

constexpr int LDS_BYTES = 147456;
constexpr int LDS_SCR = 256;

#define LAS __attribute__((address_space(3)))
typedef pg8::bf16_t bf16_t;
typedef pg8::f32x4 f32x4;
typedef pg8::u32x4 u32x4;
typedef unsigned u32x2 __attribute__((ext_vector_type(2)));
typedef float f32x2 __attribute__((ext_vector_type(2)));
#define LDS_WAIT() asm volatile("s_waitcnt lgkmcnt(0)" ::: "memory")
#ifndef Y8_FROM
#define Y8_FROM 1
#endif
#define GAS __attribute__((address_space(1)))
#define LAUNDER_V(x) asm volatile("" : "+v"(x))
#define LAUNDER_S(x) asm volatile("" : "+s"(x))
__device__ __forceinline__ int fresh_tid(int wave0) { int t_; asm volatile("v_mbcnt_lo_u32_b32 %0, -1, 0\n\tv_mbcnt_hi_u32_b32 %0, -1, %0" : "=v"(t_)); return (wave0 << 6) | t_; }
#define FRESH_TID() fresh_tid(wave0)
__device__ __forceinline__ float bflo(unsigned w) { return __uint_as_float(w << 16); }
__device__ __forceinline__ float bfhi(unsigned w) { return __uint_as_float(w & 0xffff0000u); }
__device__ __forceinline__ float bf1(bf16_t h) { return __uint_as_float(((unsigned)h) << 16); }
__device__ __forceinline__ unsigned pk2(float lo, float hi) { return pg8::cvt_pk_bf16(lo, hi); }
__device__ __forceinline__ unsigned f2bf_c(float f) { const unsigned u = __float_as_uint(f); return (u + 0x7fffu + ((u >> 16) & 1u)) >> 16; }
__device__ __forceinline__ unsigned pk2c(float lo, float hi) { return f2bf_c(lo) | (f2bf_c(hi) << 16); }
__device__ __forceinline__ float wave_sum(float v, int lane) {
#pragma unroll
    for (int o = 1; o < 64; o <<= 1) v += shx(v, o, lane);
    return v;
}
#define DPPF(v, ctrl) __int_as_float(__builtin_amdgcn_update_dpp(0, __float_as_int(v), (ctrl), 0xF, 0xF, true))
__device__ __forceinline__ float row_sum16(float v) { v += DPPF(v, 0xB1); v += DPPF(v, 0x4E); v += DPPF(v, 0x141); v += DPPF(v, 0x140); return v; }
__device__ __forceinline__ float row_max16(float v) { v = fmaxf(v, DPPF(v, 0xB1)); v = fmaxf(v, DPPF(v, 0x4E)); v = fmaxf(v, DPPF(v, 0x141)); v = fmaxf(v, DPPF(v, 0x140)); return v; }
__device__ __forceinline__ float wave_sum_fast(float v) { return rows_sum4(row_sum16(v)); }
#define SWZF(v, pat) __int_as_float(__builtin_amdgcn_ds_swizzle(__float_as_int(v), (pat)))
__device__ __forceinline__ float sigmoidf_(float x) { return __builtin_amdgcn_rcpf(1.0f + __expf(-x)); }

#define XB_TMO      128
#define XB_XCNT(j)  (256  + 64 * (j))
#define XB_XSUB(j)  (1280 + 64 * (j))
#define XB_XGEN(j)  (2304 + 64 * (j))
#define XB_TOP      3328
#define XB_TOPGEN   3392
#define XCD_BAR_WORDS 3456
#define XB_SPIN_CAP (1u << 18)
__device__ __forceinline__ unsigned xb_ld(unsigned* p)              { return __hip_atomic_load(p, __ATOMIC_RELAXED, __HIP_MEMORY_SCOPE_AGENT); }
__device__ __forceinline__ unsigned xb_add(unsigned* p, unsigned v) { return __hip_atomic_fetch_add(p, v, __ATOMIC_RELAXED, __HIP_MEMORY_SCOPE_AGENT); }
__device__ __forceinline__ unsigned xb_xcc_id() { return (unsigned)__builtin_amdgcn_s_getreg((3 << 11) | 20) & 0xFu; }
#define XB_SPIN(cond, bar) do { unsigned _sp = 0; while (cond) { __builtin_amdgcn_s_sleep(1); \
    if ((++_sp & 255u) == 0u) { if (xb_ld(&(bar)[XB_TMO])) break; if (_sp > XB_SPIN_CAP) { atomicAdd(&(bar)[XB_TMO], 1u); break; } } } } while (0)
struct XcdBarrier { unsigned* bar; unsigned x; volatile LAS unsigned* st; int w0; };
__device__ __forceinline__ XcdBarrier xcd_barrier_post(unsigned* bar, volatile LAS unsigned* st, int w0) {
    XcdBarrier b; b.bar = bar; b.x = xb_xcc_id(); b.st = st; b.w0 = w0;
    if (fresh_tid(w0) == 0) (void)xb_add(&bar[XB_XCNT(b.x)], 1u);
    return b;
}
__device__ __forceinline__ void xcd_barrier_complete(unsigned* bar, unsigned x, unsigned& nloc, unsigned& nx) {
    const unsigned G = gridDim.x * gridDim.y * gridDim.z;
    unsigned sum, cnt, mine, sp = 0u;
    for (;;) {
        sum = 0u; cnt = 0u; mine = 0u;
#pragma unroll
        for (unsigned j = 0; j < 16; ++j) { const unsigned c = xb_ld(&bar[XB_XCNT(j)]); sum += c; cnt += (c > 0u) ? 1u : 0u; mine = (j == x) ? c : mine; }
        if (sum == G) break;
        __builtin_amdgcn_s_sleep(1);
        if ((++sp & 255u) == 0u) { if (xb_ld(&bar[XB_TMO])) break; if (sp > XB_SPIN_CAP) { atomicAdd(&bar[XB_TMO], 1u); break; } }
    }
    nloc = mine > 0u ? mine : 1u; nx = cnt > 0u ? cnt : 1u;
}
__device__ __forceinline__ void xcd_barrier(const XcdBarrier& b) {
    asm volatile("s_waitcnt vmcnt(0)" ::: "memory");
    __syncthreads();
    if (fresh_tid(b.w0) == 0) {
        unsigned* bar = b.bar;
        __builtin_amdgcn_s_waitcnt(0);
        unsigned nloc = b.st[0], nx = b.st[1];
        if (nloc == 0u) { xcd_barrier_complete(bar, b.x, nloc, nx); b.st[0] = nloc; b.st[1] = nx; }
        const unsigned old = xb_add(&bar[XB_XSUB(b.x)], 1u);
        const unsigned gen = old / nloc;
        if (old + 1u == (gen + 1u) * nloc) {
            __builtin_amdgcn_fence(__ATOMIC_RELEASE, "agent");
            asm volatile("s_waitcnt vmcnt(0)" ::: "memory");
            const unsigned og = xb_add(&bar[XB_TOP], 1u);
            const unsigned tg = og / nx;
            if (og + 1u == (tg + 1u) * nx) xb_add(&bar[XB_TOPGEN], 1u);
            else XB_SPIN(xb_ld(&bar[XB_TOPGEN]) == tg, bar);
            __builtin_amdgcn_fence(__ATOMIC_ACQUIRE, "agent");
            xb_add(&bar[XB_XGEN(b.x)], 1u);
            asm volatile("s_waitcnt vmcnt(0)" ::: "memory");
        } else {
            XB_SPIN(xb_ld(&bar[XB_XGEN(b.x)]) == gen, bar);
            __builtin_amdgcn_fence(__ATOMIC_ACQUIRE, "agent");
            asm volatile("s_waitcnt vmcnt(0)" ::: "memory");
        }
    }
    __syncthreads();
}

struct Params {
    const float *x, *mem, *g_mix, *w_in, *b_gates, *conv_qk, *g_mh, *na_gq, *na_gk, *na_rpb, *g_mem, *w_mem_kv, *mem_gq, *mem_gk, *w_out, *g_ffn, *w_router, *w1, *w3, *w2;
    float* out; unsigned char* ws; int ph_lo, ph_hi, li, pad;
};

__device__ __forceinline__ void tr_tile(const float* src, int ldw, bf16_t* dst, int K, LAS float* scr, int lane, int jump = 0, const float* ksc = nullptr) {
    f32x4 v[16]; const int c = lane & 7;
    f32x4 g0 = {1.f, 1.f, 1.f, 1.f}, g1 = g0;
#pragma unroll
    for (int i = 0; i < 16; ++i) v[i] = *(const f32x4*)(src + (size_t)(4 * i + (lane >> 4)) * ldw + 4 * (lane & 15));
    if (ksc) { g0 = *(const f32x4*)(ksc + 8 * c); g1 = *(const f32x4*)(ksc + 8 * c + 4); }
#pragma unroll
    for (int i = 0; i < 16; ++i) { LAS float* s = scr + (4 * i + (lane >> 4)) * 65 + 4 * (lane & 15); s[0] = v[i].x; s[1] = v[i].y; s[2] = v[i].z; s[3] = v[i].w; }
    LDS_WAIT();
#pragma unroll
    for (int j = 0; j < 8; ++j) { const int n = (lane >> 3) + 8 * j; const LAS float* s = scr + (8 * c) * 65 + n;
        u32x4 o; o.x = pk2(s[0] * g0.x, s[65] * g0.y); o.y = pk2(s[130] * g0.z, s[195] * g0.w); o.z = pk2(s[260] * g1.x, s[325] * g1.y); o.w = pk2(s[390] * g1.z, s[455] * g1.w);
        *(u32x4*)(dst + (size_t)(n + (n >= 32 ? jump : 0)) * K + 8 * c) = o; }
    LDS_WAIT();
}
__device__ __forceinline__ void tr8_load(const float* src, int ldw, int lane, f32x4 (&v)[16]) {
#pragma unroll
    for (int i = 0; i < 16; ++i) v[i] = *(const f32x4*)(src + (size_t)(4 * i + (lane >> 4)) * ldw + 4 * (lane & 15));
}
__device__ __forceinline__ void tr8_finish(const f32x4 (&v)[16], unsigned char* dst, int K, LAS float* scr, int lane) {
#pragma unroll
    for (int i = 0; i < 16; ++i) { LAS float* s = scr + (4 * i + (lane >> 4)) * 65 + 4 * (lane & 15); s[0] = v[i].x; s[1] = v[i].y; s[2] = v[i].z; s[3] = v[i].w; }
    LDS_WAIT();
    const int c = lane & 7;
#pragma unroll
    for (int j = 0; j < 8; ++j) { const int n = (lane >> 3) + 8 * j; const LAS float* s = scr + (8 * c) * 65 + n;
        u32x2 o; o.x = pg8::pk4_fp8(256.f * s[0], 256.f * s[65], 256.f * s[130], 256.f * s[195]); o.y = pg8::pk4_fp8(256.f * s[260], 256.f * s[325], 256.f * s[390], 256.f * s[455]);
        *(u32x2*)(dst + (size_t)n * K + 8 * c) = o; }
    LDS_WAIT();
}
__device__ __forceinline__ void f8_tile(const Params& p, unsigned char* ws_, int it, const float*& src, int& ldw, unsigned char*& dst, int& K) {
    constexpr int T_W1 = 64 * 512;
    if (it < 2 * T_W1) { const int which = it / T_W1, r = it - which * T_W1, le = r >> 9, q = r & 511, kb = q >> 5, nb = q & 31, n0 = nb * 64, drow = (n0 >> 7) * 256 + (n0 & 127) + which * 128;
        src = (which ? p.w3 : p.w1) + (size_t)le * D * DFF + (size_t)kb * 64 * DFF + n0; ldw = DFF; dst = ws_ + WS_W13 + ((size_t)le * 4096 + drow) * D + kb * 64; K = D; }
    else { const int r = it - 2 * T_W1, le = r >> 9, q = r & 511, kb = q >> 4, nb = q & 15;
        src = p.w2 + (size_t)le * DFF * D + (size_t)kb * 64 * D + nb * 64; ldw = D; dst = ws_ + WS_W2 + ((size_t)le * D + nb * 64) * DFF + kb * 64; K = DFF; }
}
__device__ __forceinline__ void tr_tile8(const float* src, int ldw, unsigned char* dst, int K, LAS float* scr, int lane) {
#pragma unroll 4
    for (int i = 0; i < 16; ++i) { const int kk = 4 * i + (lane >> 4); const f32x4 v = *(const f32x4*)(src + (size_t)kk * ldw + 4 * (lane & 15));
        LAS float* s = scr + kk * 65 + 4 * (lane & 15); s[0] = v.x; s[1] = v.y; s[2] = v.z; s[3] = v.w; }
    LDS_WAIT();
    const int c = lane & 7;
#pragma unroll
    for (int j = 0; j < 8; ++j) { const int n = (lane >> 3) + 8 * j; const LAS float* s = scr + (8 * c) * 65 + n;
        u32x2 o; o.x = pg8::pk4_fp8(256.f * s[0], 256.f * s[65], 256.f * s[130], 256.f * s[195]); o.y = pg8::pk4_fp8(256.f * s[260], 256.f * s[325], 256.f * s[390], 256.f * s[455]);
        *(u32x2*)(dst + (size_t)n * K + 8 * c) = o; }
    LDS_WAIT();
}
__device__ __forceinline__ void ph_cvt_experts(const Params& p, LAS unsigned char* lds, const int tid, int G, int bid) {
    unsigned char* ws_ = p.ws; LAUNDER_S(ws_);
    const int lane = tid & 63, wave = __builtin_amdgcn_readfirstlane(tid >> 6);
    constexpr int NB = 3 * 4096;
    const bool shift = (G == 256);
    const int nmine = (NB - bid + G - 1) / G, nown = shift && bid < 64 ? 45 : nmine, n = shift && bid >= 64 ? nmine + 1 : nown;
    {
        LAS float* tile = (LAS float*)(lds + LDS_SCR);
        f32x4 cur[16]; const float* src = nullptr; int ldw = 0; unsigned char* dst = nullptr; int Kd = 0, hi = 0;
#define CVT_DECODE(I, src_, ldw_, dst_, K_, hi_) do { const int mtx = (I) >> 12, r_ = (I) & 4095, le = r_ >> 6, q_ = r_ & 63; \
            if (mtx < 2) { const int kb = q_ >> 3, nb = q_ & 7; \
                src_ = (mtx ? p.w3 : p.w1) + (size_t)le * D * DFF + (size_t)kb * 128 * DFF + nb * 256; ldw_ = DFF; dst_ = ws_ + WS_W13 + ((size_t)le * 4096 + nb * 512 + mtx * 128) * D + kb * 128; K_ = D; hi_ = 128; } \
            else { const int kb = q_ >> 2, nb = q_ & 3; \
                src_ = p.w2 + (size_t)le * DFF * D + (size_t)kb * 128 * D + nb * 256; ldw_ = D; dst_ = ws_ + WS_W2 + ((size_t)le * D + nb * 256) * DFF + kb * 128; K_ = DFF; hi_ = 0; } } while (0)
#define CVT_LOAD(v, src_, ldw_) do { _Pragma("unroll") for (int i = 0; i < 16; ++i) v[i] = *(const f32x4*)((src_) + (size_t)(16 * wave + i) * (ldw_) + 4 * lane); } while (0)
#define CVT_PROC(v, dst_, K_, hi_) do { \
            _Pragma("unroll") for (int i = 0; i < 16; ++i) { const int k = 16 * wave + i; *(LAS f32x4*)(tile + k * 256 + ((4 * lane) ^ ((k >> 3) << 2))) = v[i]; } \
            __syncthreads(); \
            { const int c = lane & 15; \
              _Pragma("unroll") for (int j = 0; j < 8; ++j) { const int n = 32 * wave + 4 * j + (lane >> 4); const LAS float* t1 = tile + (8 * c) * 256 + (n ^ (c << 2)); \
                  u32x2 o; o.x = pg8::pk4_fp8s(t1[0], t1[256], t1[512], t1[768], 0.00390625f); o.y = pg8::pk4_fp8s(t1[1024], t1[1280], t1[1536], t1[1792], 0.00390625f); \
                  *(u32x2*)((dst_) + (size_t)(n + (n >> 7) * (hi_)) * (K_) + 8 * c) = o; } } \
            __syncthreads(); } while (0)
        f32x4 vb[16]; const float* srcb = nullptr; int ldwb = 0; unsigned char* dstb = nullptr; int Kb = 0, hib = 0;
#define CVT_BLK(t_) ((t_) < nown ? bid + (t_) * G : ((bid - 64) & 63) + (45 + ((bid - 64) >> 6)) * G)
        int t = 0;
        if (t < n) { const int I = CVT_BLK(t); CVT_DECODE(I, src, ldw, dst, Kd, hi); CVT_LOAD(cur, src, ldw); }
#pragma unroll 1
        while (t < n) {
            if (t + 1 < n) { const int I2 = CVT_BLK(t + 1); CVT_DECODE(I2, srcb, ldwb, dstb, Kb, hib); CVT_LOAD(vb, srcb, ldwb); }
            CVT_PROC(cur, dst, Kd, hi);
            if (t + 1 >= n) break;
            if (t + 2 < n) { const int I3 = CVT_BLK(t + 2); CVT_DECODE(I3, src, ldw, dst, Kd, hi); CVT_LOAD(cur, src, ldw); }
            CVT_PROC(vb, dstb, Kb, hib);
            t += 2; }
#undef CVT_BLK
#undef CVT_PROC
#undef CVT_DECODE
#undef CVT_LOAD
    }
}
__device__ __forceinline__ void ph_convert(const Params& p, LAS unsigned char* lds, const int tid, int G, int bid) {
    unsigned char* ws_ = p.ws; LAUNDER_S(ws_);
    const int lane = tid & 63, wave = __builtin_amdgcn_readfirstlane(tid >> 6);
    LAS float* scr = (LAS float*)(lds + LDS_SCR + wave * 16640);
    const int gw = bid * 8 + wave, NGW = G * 8;
    bf16_t* w13t = (bf16_t*)(ws_ + WS_W13); bf16_t* w2t = (bf16_t*)(ws_ + WS_W2); bf16_t* wint = (bf16_t*)(ws_ + WS_WIN); bf16_t* wkvt = (bf16_t*)(ws_ + WS_WKV); bf16_t* woutt = (bf16_t*)(ws_ + WS_WOUT);
    constexpr int T_IN = 4 * 16 * 40, T_KV = 4 * 16 * 8, T_OUT = 4 * 16 * 16;
    for (int it = gw; it < T_IN + T_KV + T_OUT; it += NGW) {
        int r = it;
        if (r < T_IN) { const int l = r / 640, q = r % 640, kb = q / 40, nb = q % 40, n0 = nb * 64, sc = n0 < GATE_COL ? n0 : n0 + 16;
            const int tile = n0 >> 8; const bool hp = (tile == 6 || tile == 7 || tile == 9); const int drow = hp ? (tile * 256 + 32 * ((n0 & 255) >> 6)) : n0;
            tr_tile(p.w_in + (size_t)l * D * DIN + (size_t)kb * 64 * DIN + sc, DIN, wint + ((size_t)l * NPROJ + drow) * D + kb * 64, D, scr, lane, hp ? 96 : 0, p.g_mix + l * D + kb * 64); continue; }
        r -= T_IN;
        if (r < T_KV) { const int l = r >> 7, q = r & 127, kb = q >> 3, nb = q & 7;
            const bool hp = nb < 4; const int drow = hp ? 32 * nb : nb * 64;
            tr_tile(p.w_mem_kv + (size_t)l * D * 512 + (size_t)kb * 64 * 512 + nb * 64, 512, wkvt + ((size_t)l * 512 + drow) * D + kb * 64, D, scr, lane, hp ? 96 : 0); continue; }
        r -= T_KV;
        { const int l = r >> 8, q = r & 255, kb = q >> 4, nb = q & 15;
            if (l >= Y8_FROM) tr_tile8(p.w_out + (size_t)l * D * D + (size_t)kb * 64 * D + nb * 64, D, (unsigned char*)(woutt + (size_t)l * D * D) + (size_t)(nb * 64) * D + kb * 64, D, scr, lane);
          else tr_tile(p.w_out + (size_t)l * D * D + (size_t)kb * 64 * D + nb * 64, D, woutt + ((size_t)l * D + nb * 64) * D + kb * 64, D, scr, lane); }
    }
    bf16_t* memh = (bf16_t*)(ws_ + WS_MEMH);
    for (int r = gw; r < BATCH * NMEM; r += NGW) {
        const f32x4* xr = (const f32x4*)(p.mem + (size_t)r * D) + lane; f32x4 v[4]; float ss = 0.f;
#pragma unroll
        for (int j = 0; j < 4; ++j) { v[j] = xr[64 * j]; ss += v[j].x * v[j].x + v[j].y * v[j].y + v[j].z * v[j].z + v[j].w * v[j].w; }
        const float rr = rsqrtf(wave_sum(ss, lane) * (1.f / D) + EPS);
        f32x4 gm[DEPTH][4];
#pragma unroll
        for (int l = 0; l < DEPTH; ++l)
#pragma unroll
            for (int j = 0; j < 4; ++j) gm[l][j] = *((const f32x4*)(p.g_mem + l * D) + lane + 64 * j);
#pragma unroll
        for (int l = 0; l < DEPTH; ++l) { u32x2* o = (u32x2*)(memh + ((size_t)l * BATCH * NMEM + r) * D) + lane;
#pragma unroll
            for (int j = 0; j < 4; ++j) { const f32x4 g = gm[l][j]; u32x2 w; w.x = pk2(v[j].x * rr * g.x, v[j].y * rr * g.y); w.y = pk2(v[j].z * rr * g.z, v[j].w * rr * g.w); o[64 * j] = w; } }
    }
    { float* gt = (float*)(ws_ + WS_GT); const int i = bid * 512 + tid;
      if (i < DEPTH * 192) { const int l = i / 192, q = i % 192, w = q >> 6, d = q & 63; gt[i] = (w == 0 ? p.na_gq : (w == 1 ? p.na_gk : p.mem_gq))[l * 64 + d]; } }
}

__device__ __forceinline__ float reduce16(float (&pv)[16], int lane) {
    float a8[8], a4[4], a2[2];
#pragma unroll
    for (int i = 0; i < 8; ++i) { const bool od = lane & 1; const float keep = od ? pv[2 * i + 1] : pv[2 * i], send = od ? pv[2 * i] : pv[2 * i + 1]; a8[i] = keep + DPPF(send, 0xB1); }
#pragma unroll
    for (int i = 0; i < 4; ++i) { const bool od = lane & 2; const float keep = od ? a8[2 * i + 1] : a8[2 * i], send = od ? a8[2 * i] : a8[2 * i + 1]; a4[i] = keep + DPPF(send, 0x4E); }
#pragma unroll
    for (int i = 0; i < 2; ++i) { const bool od = lane & 4; const float keep = od ? a4[2 * i + 1] : a4[2 * i], send = od ? a4[2 * i] : a4[2 * i + 1]; a2[i] = keep + SWZF(send, 0x101F); }
    const bool od = lane & 8; const float keep = od ? a2[1] : a2[0], send = od ? a2[0] : a2[1];
    return rows_sum4(keep + SWZF(send, 0x201F));
}
template <bool F> struct NormRaw { typedef u32x2 T; };
template <> struct NormRaw<true> { typedef f32x4 T; };
__device__ __forceinline__ void nrm_ld(f32x4& r, const void* base, size_t tok, int idx) { r = *((const f32x4*)((const float*)base + tok * D) + idx); }
__device__ __forceinline__ void nrm_ld(u32x2& r, const void* base, size_t tok, int idx) { r = *((const u32x2*)((const bf16_t*)base + tok * D) + idx); }
__device__ __forceinline__ f32x4 nrm_up(const f32x4& r) { return r; }
__device__ __forceinline__ f32x4 nrm_up(const u32x2& r) { return f32x4{bflo(r.x), bfhi(r.x), bflo(r.y), bfhi(r.y)}; }
template <int MODE, bool XF32>
__device__ __forceinline__ void ph_norm(const Params& p, int l, bool combine, LAS unsigned char* lds, const int tid, int G, int bid, const void* xin) {
    GAS unsigned char* ws_ = (GAS unsigned char*)p.ws; LAUNDER_S(ws_);
    const int lane = tid & 63, wave = __builtin_amdgcn_readfirstlane(tid >> 6);
    LAS unsigned char* wl = lds + LDS_SCR;
    if (MODE != 2) {
        const GAS float* wsrc = (const GAS float*)(MODE == 0 ? p.w_in + (size_t)l * D * DIN + GATE_COL : p.w_router + (size_t)l * D * NE); const int ldw = MODE == 0 ? DIN : NE;
        f32x4 wt[8];
#pragma unroll
        for (int j = 0; j < 8; ++j) { const int i = tid + 512 * j, k = i >> 2, part = i & 3; wt[j] = *(const GAS f32x4*)(wsrc + (size_t)k * ldw + part * 4); }
#pragma unroll
        for (int j = 0; j < 8; ++j) { const int i = tid + 512 * j, k = i >> 2, part = i & 3; *(LAS f32x4*)(wl + k * 64 + (k >> 2) * 16 + part * 16) = wt[j]; }
        __syncthreads();
    }
    const GAS float* gsrc = (const GAS float*)(MODE == 0 ? p.g_mix + l * D : p.g_ffn + l * D);
    f32x4 gv[4];
#pragma unroll
    for (int j = 0; j < 4; ++j) gv[j] = MODE != 2 ? *((const GAS f32x4*)gsrc + lane + 64 * j) : (f32x4){0.f, 0.f, 0.f, 0.f};
    GAS bf16_t* hb = (GAS bf16_t*)(ws_ + WS_H); const GAS bf16_t* ybuf = (const GAS bf16_t*)(ws_ + WS_YBUF); const GAS int* slotmap = (const GAS int*)(ws_ + WS_ROUTE + RT_SLOTMAP);
    GAS float* gates = (GAS float*)(ws_ + WS_GATES); GAS float* aff = (GAS float*)(ws_ + WS_AFF);
    LAS unsigned char* stg = lds + LDS_SCR + 70656 + wave * 8192;
#define NORM_ISSUE(tok, e, c, slot) do { const GAS unsigned char* yr = (const GAS unsigned char*)ybuf + ((size_t)(((e) * BATCH + ((tok) >> 12)) * CAP + (c))) * D + lane * 16; LAS unsigned char* dl = stg + __builtin_amdgcn_readfirstlane(slot) * 1024; \
        __builtin_amdgcn_global_load_lds((const GAS unsigned*)yr, (LAS unsigned*)dl, 16, 0, 0); } while (0)
#define NORM_COMBINE2(va_, tokA_, cva_, vb_, tokB_, cvb_) do { int ca = 0, cb = 0; \
        _Pragma("unroll 1") for (int e = 0; e < NE; ++e) { const int c = __builtin_amdgcn_readlane(cva_, e);        \
            if (c >= 0) { NORM_ISSUE(tokA_, e, c, ca); if (++ca == 8) NORM_FLUSH2(va_, vb_); } } \
        _Pragma("unroll 1") for (int e = 0; e < NE; ++e) { const int c = __builtin_amdgcn_readlane(cvb_, e); \
            if (c >= 0) { NORM_ISSUE(tokB_, e, c, ca + cb); ++cb; if (ca + cb == 8) NORM_FLUSH2(va_, vb_); } } \
        if (ca + cb) NORM_FLUSH2(va_, vb_); \
        NORM_XSTORE(va_, tokA_); NORM_XSTORE(vb_, tokB_); } while (0)
#define NORM_FLUSH2(va_, vb_) do { asm volatile("s_waitcnt vmcnt(0)" ::: "memory"); \
        for (int k = 0; k < ca; ++k) { _Pragma("unroll") for (int j = 0; j < 4; ++j) { const unsigned w = *(const LAS unsigned*)(stg + k * 1024 + j * 256 + lane * 4); \
            va_[j].x += 0.125f * __builtin_amdgcn_cvt_f32_fp8(w, 0); va_[j].y += 0.125f * __builtin_amdgcn_cvt_f32_fp8(w, 1); va_[j].z += 0.125f * __builtin_amdgcn_cvt_f32_fp8(w, 2); va_[j].w += 0.125f * __builtin_amdgcn_cvt_f32_fp8(w, 3); } } \
        for (int k = 0; k < cb; ++k) { _Pragma("unroll") for (int j = 0; j < 4; ++j) { const unsigned w = *(const LAS unsigned*)(stg + (ca + k) * 1024 + j * 256 + lane * 4); \
            vb_[j].x += 0.125f * __builtin_amdgcn_cvt_f32_fp8(w, 0); vb_[j].y += 0.125f * __builtin_amdgcn_cvt_f32_fp8(w, 1); vb_[j].z += 0.125f * __builtin_amdgcn_cvt_f32_fp8(w, 2); vb_[j].w += 0.125f * __builtin_amdgcn_cvt_f32_fp8(w, 3); } } \
        asm volatile("s_waitcnt lgkmcnt(0)" ::: "memory"); ca = 0; cb = 0; } while (0)
#define NORM_XSTORE(v, tok) do { if (MODE == 2) { _Pragma("unroll") for (int j = 0; j < 4; ++j) *((GAS f32x4*)(p.out + (size_t)(tok) * D) + lane + 64 * j) = v[j]; } \
        else { _Pragma("unroll") for (int j = 0; j < 4; ++j) { u32x2 w_; w_.x = pk2(v[j].x, v[j].y); w_.y = pk2(v[j].z, v[j].w); ((GAS u32x2*)(xb + (size_t)(tok) * D))[lane + 64 * j] = w_; } } } while (0)
    GAS bf16_t* xb = (GAS bf16_t*)(ws_ + WS_XB);
    const float bgate = MODE == 0 ? p.b_gates[l * 16 + (lane & 15)] : 0.f;
    int sna_ = -1, snb_ = -1;
    typename NormRaw<XF32>::T na_[4], nb_[4];
    { const int t0 = (bid * 8 + wave) * 2;
      if (t0 < NTOK) {
        if (combine) { sna_ = slotmap[(size_t)t0 * NE + (lane & 15)]; snb_ = slotmap[(size_t)(t0 + 1) * NE + (lane & 15)]; }
#pragma unroll
        for (int j = 0; j < 4; ++j) { nrm_ld(na_[j], xin, (size_t)t0, lane + 64 * j); nrm_ld(nb_[j], xin, (size_t)(t0 + 1), lane + 64 * j); } } }
#pragma unroll 1
    for (int tokA = (bid * 8 + wave) * 2; tokA < NTOK; tokA += G * 8 * 2) {
        const int tokB = tokA + 1;
        f32x4 va[4], vb[4];
#pragma unroll
        for (int j = 0; j < 4; ++j) { va[j] = nrm_up(na_[j]); vb[j] = nrm_up(nb_[j]); }
        const int cva = sna_, cvb = snb_;
        { const int tn = tokA + G * 8 * 2;
          if (tn < NTOK) {
            if (combine) { sna_ = slotmap[(size_t)tn * NE + (lane & 15)]; snb_ = slotmap[(size_t)(tn + 1) * NE + (lane & 15)]; }
#pragma unroll
            for (int j = 0; j < 4; ++j) { nrm_ld(na_[j], xin, (size_t)tn, lane + 64 * j); nrm_ld(nb_[j], xin, (size_t)(tn + 1), lane + 64 * j); } } }
        if (combine) { NORM_COMBINE2(va, tokA, cva, vb, tokB, cvb); }
        else if (XF32) { NORM_XSTORE(va, tokA); NORM_XSTORE(vb, tokB); }
        if (MODE == 2) continue;
        float ssa = 0.f, ssb = 0.f;
#pragma unroll
        for (int j = 0; j < 4; ++j) { ssa += va[j].x * va[j].x + va[j].y * va[j].y + va[j].z * va[j].z + va[j].w * va[j].w; }
#pragma unroll
        for (int j = 0; j < 4; ++j) { ssb += vb[j].x * vb[j].x + vb[j].y * vb[j].y + vb[j].z * vb[j].z + vb[j].w * vb[j].w; }
        const float rra = rsqrtf(wave_sum_fast(ssa) * (1.f / D) + EPS); float rrb = rsqrtf(wave_sum_fast(ssb) * (1.f / D) + EPS); asm volatile("" : "+v"(rrb));
        f32x2 pab[16];
#pragma unroll
        for (int g = 0; g < 16; ++g) pab[g] = (f32x2){0.f, 0.f};
        unsigned lb = (unsigned)lane * 272u + LDS_SCR; LAUNDER_V(lb);
        f32x4 hA[4], hB[4];
#pragma unroll
        for (int j = 0; j < 4; ++j) { const f32x4 gj = gv[j]; hA[j] = va[j] * gj * rra; hB[j] = vb[j] * gj * rrb; }
        f32x4 wc[2][4], wn[2][4];
#pragma unroll
        for (int qq = 0; qq < 2; ++qq) { const LAS f32x4* wr4 = (const LAS f32x4*)(lds + lb + qq * 64);
#pragma unroll
            for (int part = 0; part < 4; ++part) wc[qq][part] = wr4[part]; }
#pragma unroll
        for (int hs = 0; hs < 8; ++hs) {
            if (hs < 7) { const int jn = (hs + 1) >> 1, qb = 2 * ((hs + 1) & 1);
#pragma unroll
                for (int qq = 0; qq < 2; ++qq) { const LAS f32x4* wr4 = (const LAS f32x4*)(lds + lb + jn * 17408 + (qb + qq) * 64);
#pragma unroll
                    for (int part = 0; part < 4; ++part) wn[qq][part] = wr4[part]; } }
            __builtin_amdgcn_sched_barrier(0);
            { const int j = hs >> 1, qb = 2 * (hs & 1);
#pragma unroll
              for (int qq = 0; qq < 2; ++qq) { const f32x2 hq = {hA[j][qb + qq], hB[j][qb + qq]};
#pragma unroll
                  for (int part = 0; part < 4; ++part) { const f32x4 w4 = wc[qq][part];
                      pab[part * 4 + 0] += hq * w4.x; pab[part * 4 + 1] += hq * w4.y; pab[part * 4 + 2] += hq * w4.z; pab[part * 4 + 3] += hq * w4.w; } } }
            __builtin_amdgcn_sched_barrier(0);
            if (hs < 7) {
#pragma unroll
                for (int qq = 0; qq < 2; ++qq)
#pragma unroll
                    for (int part = 0; part < 4; ++part) wc[qq][part] = wn[qq][part]; } }
        float pa[16], pb[16];
#pragma unroll
        for (int g = 0; g < 16; ++g) { pa[g] = pab[g].x; pb[g] = pab[g].y; }
        const int g = lane & 15; const float ta = reduce16(pa, lane); float tb = reduce16(pb, lane);
        if (MODE == 0) { if (lane < 16) { gates[(size_t)tokA * 16 + g] = ta + bgate; gates[(size_t)tokB * 16 + g] = tb + bgate; }
            if (lane == 16) { GAS float* rrow = (GAS float*)(ws_ + WS_RR); rrow[tokA] = rra; rrow[tokB] = rrb; } }
        else { const float mxa = row_max16(ta), exa = __expf(ta - mxa), sma = row_sum16(exa); const float mxb = row_max16(tb), exb = __expf(tb - mxb), smb = row_sum16(exb);
            if (lane < 16) { aff[((size_t)(tokA >> 12) * NE + g) * SEQ + (tokA & (SEQ - 1))] = exa / sma; aff[((size_t)(tokB >> 12) * NE + g) * SEQ + (tokB & (SEQ - 1))] = exb / smb; } }
    }
#undef NORM_COMBINE2
#undef NORM_ISSUE
#undef NORM_XSTORE
#undef NORM_FLUSH2
}


__device__ __forceinline__ float reduce8(float (&pv)[8], int lane) {
    float a4[4], a2[2];
#pragma unroll
    for (int i = 0; i < 4; ++i) { const bool od = lane & 1; const float keep = od ? pv[2 * i + 1] : pv[2 * i], send = od ? pv[2 * i] : pv[2 * i + 1]; a4[i] = keep + DPPF(send, 0xB1); }
#pragma unroll
    for (int i = 0; i < 2; ++i) { const bool od = lane & 2; const float keep = od ? a4[2 * i + 1] : a4[2 * i], send = od ? a4[2 * i] : a4[2 * i + 1]; a2[i] = keep + DPPF(send, 0x4E); }
    const bool od = lane & 4; const float keep = od ? a2[1] : a2[0], send = od ? a2[0] : a2[1];
    float a1 = keep + SWZF(send, 0x101F);
    a1 += SWZF(a1, 0x201F);
    return rows_sum4(a1);
}
__device__ __forceinline__ void ph_norm1_t4(const Params& p, int l, LAS unsigned char* lds, const int tid, int G, int bid) {
    GAS unsigned char* ws_ = (GAS unsigned char*)p.ws; LAUNDER_S(ws_);
    const int lane = tid & 63, wave = __builtin_amdgcn_readfirstlane(tid >> 6);
    LAS unsigned char* wl = lds + LDS_SCR;
    { const GAS float* wsrc = (const GAS float*)(p.w_router + (size_t)l * D * NE);
      f32x4 wt[8];
#pragma unroll
      for (int j = 0; j < 8; ++j) { const int i = tid + 512 * j, k = i >> 2, part = i & 3; wt[j] = *(const GAS f32x4*)(wsrc + (size_t)k * NE + part * 4); }
#pragma unroll
      for (int j = 0; j < 8; ++j) { const int i = tid + 512 * j, k = i >> 2, part = i & 3; *(LAS f32x4*)(wl + k * 64 + (k >> 2) * 16 + part * 16) = wt[j]; }
      __syncthreads(); }
    const GAS float* gsrc = (const GAS float*)(p.g_ffn + l * D);
    f32x4 gv[4];
#pragma unroll
    for (int j = 0; j < 4; ++j) gv[j] = *((const GAS f32x4*)gsrc + lane + 64 * j);
    const GAS bf16_t* xb = (const GAS bf16_t*)(ws_ + WS_XB); GAS unsigned char* hb8 = ws_ + WS_H; GAS float* aff = (GAS float*)(ws_ + WS_AFF);
    u32x2 nr[4][4];
    const int tfirst = (bid * 8 + wave) * 4, tstep = G * 32;
    if (tfirst < NTOK) {
#pragma unroll
        for (int t = 0; t < 4; ++t)
#pragma unroll
            for (int j = 0; j < 4; ++j) nr[t][j] = *((const GAS u32x2*)(xb + (size_t)(tfirst + t) * D) + lane + 64 * j); }
#pragma unroll 1
    for (int tok0 = tfirst; tok0 < NTOK; tok0 += tstep) {
        f32x4 v[4][4]; float rr[4];
#pragma unroll
        for (int t = 0; t < 4; ++t)
#pragma unroll
            for (int j = 0; j < 4; ++j) { const u32x2 r = nr[t][j]; v[t][j] = (f32x4){bflo(r.x), bfhi(r.x), bflo(r.y), bfhi(r.y)}; }
        if (tok0 + tstep < NTOK) {
#pragma unroll
            for (int t = 0; t < 4; ++t)
#pragma unroll
                for (int j = 0; j < 4; ++j) nr[t][j] = *((const GAS u32x2*)(xb + (size_t)(tok0 + tstep + t) * D) + lane + 64 * j); }
#pragma unroll
        for (int t = 0; t < 4; ++t) { float ss = 0.f;
#pragma unroll
            for (int j = 0; j < 4; ++j) ss += v[t][j].x * v[t][j].x + v[t][j].y * v[t][j].y + v[t][j].z * v[t][j].z + v[t][j].w * v[t][j].w;
            rr[t] = rsqrtf(wave_sum_fast(ss) * (1.f / D) + EPS); }
#pragma unroll
        for (int j = 0; j < 4; ++j)
#pragma unroll
            for (int t = 0; t < 4; ++t) { const f32x4 h = v[t][j] * gv[j] * rr[t]; v[t][j] = h;
                ((GAS unsigned*)(hb8 + (size_t)(tok0 + t) * D))[lane + 64 * j] = pg8::pk4_fp8s(h.x, h.y, h.z, h.w, 0.125f); }
        float lg[4];
#pragma unroll
        for (int pass = 0; pass < 2; ++pass) {
            f32x2 pab[8], pcd[8];
#pragma unroll
            for (int e = 0; e < 8; ++e) { pab[e] = (f32x2){0.f, 0.f}; pcd[e] = (f32x2){0.f, 0.f}; }
            unsigned lb = (unsigned)lane * 272u + LDS_SCR + 32u * pass; LAUNDER_V(lb);
            f32x4 wcur[4][2], wnxt[4][2];
#pragma unroll
            for (int q = 0; q < 4; ++q) { const LAS f32x4* wr4 = (const LAS f32x4*)(lds + lb + q * 64); wcur[q][0] = wr4[0]; wcur[q][1] = wr4[1]; }
#pragma unroll
            for (int j = 0; j < 4; ++j) {
                if (j < 3) {
#pragma unroll
                    for (int q = 0; q < 4; ++q) { const LAS f32x4* wr4 = (const LAS f32x4*)(lds + lb + (j + 1) * 17408 + q * 64); wnxt[q][0] = wr4[0]; wnxt[q][1] = wr4[1]; } }
                __builtin_amdgcn_sched_barrier(0);
#pragma unroll
                for (int q = 0; q < 4; ++q) { const f32x2 hab = {v[0][j][q], v[1][j][q]}, hcd = {v[2][j][q], v[3][j][q]};
#pragma unroll
                    for (int pp = 0; pp < 2; ++pp) { const f32x4 w4 = wcur[q][pp];
                        pab[pp * 4 + 0] += hab * w4.x; pab[pp * 4 + 1] += hab * w4.y; pab[pp * 4 + 2] += hab * w4.z; pab[pp * 4 + 3] += hab * w4.w;
                        pcd[pp * 4 + 0] += hcd * w4.x; pcd[pp * 4 + 1] += hcd * w4.y; pcd[pp * 4 + 2] += hcd * w4.z; pcd[pp * 4 + 3] += hcd * w4.w; } }
                __builtin_amdgcn_sched_barrier(0);
                if (j < 3) {
#pragma unroll
                    for (int q = 0; q < 4; ++q) { wcur[q][0] = wnxt[q][0]; wcur[q][1] = wnxt[q][1]; } } }
            float pa[8], pb[8], pc[8], pd[8];
#pragma unroll
            for (int e = 0; e < 8; ++e) { pa[e] = pab[e].x; pb[e] = pab[e].y; pc[e] = pcd[e].x; pd[e] = pcd[e].y; }
            const float ra = reduce8(pa, lane), rb = reduce8(pb, lane), rc = reduce8(pc, lane), rd = reduce8(pd, lane);
            const bool mine = ((lane >> 3) & 1) == pass;
            if (pass == 0) { lg[0] = ra; lg[1] = rb; lg[2] = rc; lg[3] = rd; }
            else { lg[0] = mine ? ra : lg[0]; lg[1] = mine ? rb : lg[1]; lg[2] = mine ? rc : lg[2]; lg[3] = mine ? rd : lg[3]; }
        }
        const int g = lane & 15;
        f32x4 pr;
#pragma unroll
        for (int t = 0; t < 4; ++t) { const float mx = row_max16(lg[t]), ex = __expf(lg[t] - mx), sm = row_sum16(ex); pr[t] = ex * __builtin_amdgcn_rcpf(sm); }
        if (lane < 16) *(GAS f32x4*)(aff + ((size_t)(tok0 >> 12) * NE + g) * SEQ + (tok0 & (SEQ - 1))) = pr;
    }
}

typedef pg8::bf16x8 bf16x8;
template <bool NA>
__device__ __forceinline__ void ph_attn_mfma(const Params& p, int l, LAS unsigned char* lds, const int tid, int G, int bid) {
    unsigned char* ws_ = p.ws; LAUNDER_S(ws_);
    const int lane = tid & 63, gw = bid * 8 + __builtin_amdgcn_readfirstlane(tid >> 6), NGW = G * 8, fr = lane & 15, g = lane >> 4;
    const bf16_t* nrm = (const bf16_t*)(ws_ + WS_NRM); const bf16_t* nvt = (const bf16_t*)(ws_ + WS_NVT); const bf16_t* kmn = (const bf16_t*)(ws_ + WS_KMN); const bf16_t* vmt = (const bf16_t*)(ws_ + WS_VMT);
    bf16_t* y = (bf16_t*)(ws_ + WS_Y);
    LAS float* tb = (LAS float*)(lds + LDS_SCR);
    if (NA) { const float* rpb = p.na_rpb + (size_t)l * 4 * 15 * 31;
        for (int i = tid; i < 4 * 15 * 64; i += 512) { const int dcp = (i & 63) - 16, hr = i >> 6; tb[i] = (dcp >= 0 && dcp < 31) ? rpb[hr * 31 + dcp] : 0.f; }
        __syncthreads(); }
#pragma unroll 1
    for (int it = gw; it < BATCH * 4 * 256; it += NGW) {
        const int qb = it & 255, head = (it >> 8) & 3, b = it >> 10, tok0 = b * SEQ + qb * 16, r = qb >> 2, seg = qb & 3;
        const int rs = min(max(r - 4, 0), 56), kc0 = min(max(seg * 16 - 8, 0), 32);
        const bf16_t* qp = nrm + (size_t)(tok0 + fr) * 768 + (NA ? 0 : 512) + head * 64 + 8 * g;
        const bf16x8 qf0 = *(const bf16x8*)qp, qf1 = *(const bf16x8*)(qp + 32);
        const int jj0 = 8 * (fr >> 2) + (fr & 3);
        const bf16_t* kb = NA ? nrm + (size_t)(b * SEQ + rs * 64 + kc0 + jj0) * 768 + 256 + head * 64 + 8 * g : kmn + (size_t)((l * BATCH + b) * NMEM + jj0) * 256 + head * 64 + 8 * g;
        constexpr int KGS = NA ? 64 * 768 : 32 * 256, KTS = NA ? 4 * 768 : 4 * 256;
        bf16x8 ka[16][2];
#pragma unroll
        for (int i = 0; i < 16; ++i) { const bf16_t* kp = kb + (i >> 1) * KGS + (i & 1) * KTS; ka[i][0] = *(const bf16x8*)kp; ka[i][1] = *(const bf16x8*)(kp + 32); }
        __builtin_amdgcn_sched_barrier(0);
        f32x4 S[16];
#pragma unroll
        for (int i = 0; i < 16; ++i) { f32x4 z = {0.f, 0.f, 0.f, 0.f}; z = __builtin_amdgcn_mfma_f32_16x16x32_bf16(ka[i][0], qf0, z, 0, 0, 0); S[i] = __builtin_amdgcn_mfma_f32_16x16x32_bf16(ka[i][1], qf1, z, 0, 0, 0); }
        const bf16_t* vb = NA ? nvt + ((size_t)((b * 4 + head) * 64 + fr)) * SEQ + rs * 64 + kc0 + 8 * g : vmt + ((size_t)(((l * BATCH + b) * 4 + head) * 64 + fr)) * NMEM + 8 * g;
        constexpr int VMS = NA ? 16 * SEQ : 16 * NMEM, VGS = NA ? 64 : 32;
        bf16x8 va[16];
#pragma unroll
        for (int i = 0; i < 16; ++i) va[i] = *(const bf16x8*)(vb + (i >> 3) * VMS + (i & 7) * VGS);
        __builtin_amdgcn_sched_barrier(0);
        float mx = -1e30f;
        if (NA) { const int c = seg * 16 + fr, lo = min(max(c - 8, 0), 48) - c, dc0 = kc0 + 8 * g - c;
            const LAS float* tbl = tb + (head * 15 + (rs - r + 7)) * 64 + dc0 + 31;
#pragma unroll
            for (int i = 0; i < 16; ++i)
#pragma unroll
                for (int q = 0; q < 4; ++q) { const int dj = 4 * (i & 1) + q, dc = dc0 + dj; const float bv = tbl[(i >> 1) * 64 + dj];
                    const float mk = (dc >= lo && dc <= lo + 15) ? 0.f : -1e30f; const float v = (S[i][q] + bv) + mk; S[i][q] = v; mx = fmaxf(mx, v); } }
        else {
#pragma unroll
            for (int i = 0; i < 16; ++i)
#pragma unroll
                for (int q = 0; q < 4; ++q) mx = fmaxf(mx, S[i][q]); }
        mx = rows_max4(mx);
        float sum = 0.f; bf16x8 pf[8];
#pragma unroll
        for (int Gk = 0; Gk < 8; ++Gk) { float e[8];
#pragma unroll
            for (int t = 0; t < 2; ++t)
#pragma unroll
                for (int q = 0; q < 4; ++q) { e[t * 4 + q] = __expf(S[2 * Gk + t][q] - mx); sum += e[t * 4 + q]; }
            u32x4 w; w.x = pk2(e[0], e[1]); w.y = pk2(e[2], e[3]); w.z = pk2(e[4], e[5]); w.w = pk2(e[6], e[7]);
            pf[Gk] = __builtin_bit_cast(bf16x8, w); }
        sum = rows_sum4(sum);
        bf16x8 vc[16];
#pragma unroll
        for (int i = 0; i < 16; ++i) vc[i] = *(const bf16x8*)(vb + (2 + (i >> 3)) * VMS + (i & 7) * VGS);
        __builtin_amdgcn_sched_barrier(0);
        f32x4 O[4];
#pragma unroll
        for (int mt = 0; mt < 2; ++mt) { O[mt] = (f32x4){0.f, 0.f, 0.f, 0.f};
#pragma unroll
            for (int Gk = 0; Gk < 8; ++Gk) O[mt] = __builtin_amdgcn_mfma_f32_16x16x32_bf16(va[mt * 8 + Gk], pf[Gk], O[mt], 0, 0, 0); }
#pragma unroll
        for (int mt = 0; mt < 2; ++mt) { O[2 + mt] = (f32x4){0.f, 0.f, 0.f, 0.f};
#pragma unroll
            for (int Gk = 0; Gk < 8; ++Gk) O[2 + mt] = __builtin_amdgcn_mfma_f32_16x16x32_bf16(vc[mt * 8 + Gk], pf[Gk], O[2 + mt], 0, 0, 0); }
        const float inv = 1.0f / sum; bf16_t* yo = y + (size_t)(tok0 + fr) * D + (NA ? 512 : 768) + head * 64 + 4 * g;
#pragma unroll
        for (int mt = 0; mt < 4; ++mt) { u32x2 w; w.x = pk2(O[mt][0] * inv, O[mt][1] * inv); w.y = pk2(O[mt][2] * inv, O[mt][3] * inv); *(u32x2*)(yo + 16 * mt) = w; }
    }
    if (NA) __syncthreads();
}


__device__ __forceinline__ void ph_na_lds(const Params& p, int l, LAS unsigned char* lds, const int tid, int G, int bid) {
    GAS unsigned char* ws_ = (GAS unsigned char*)p.ws; LAUNDER_S(ws_);
    const GAS bf16_t* nrm = (const GAS bf16_t*)(ws_ + WS_NRM); const GAS bf16_t* nvt = (const GAS bf16_t*)(ws_ + WS_NVT); GAS bf16_t* y = (GAS bf16_t*)(ws_ + WS_Y);
    LAS unsigned char* kl = lds + LDS_SCR; LAS unsigned char* vl = kl + 8 * 64 * 144; LAS float* tb = (LAS float*)(vl + 64 * 1040);
#pragma unroll 1
    for (int unit = bid; unit < BATCH * 4 * 8; unit += G) {
        int tid_ = tid; LAUNDER_V(tid_);
        const int lane = tid_ & 63, wave = __builtin_amdgcn_readfirstlane(tid_ >> 6), fr = lane & 15, g = lane >> 4;
        const int band = unit & 7, head = (unit >> 3) & 3, b = unit >> 5, r0 = band * 8, rs0 = min(max(r0 - 4, 0), 56);
        const GAS bf16_t* kg = nrm + (size_t)(b * SEQ) * 768 + 256 + head * 64;
        const GAS bf16_t* vg = nvt + (size_t)((b * 4 + head) * 64) * SEQ;
        __syncthreads();
        { const GAS float* rpb = (const GAS float*)(p.na_rpb + ((size_t)l * 4 + head) * 15 * 31);
          float tbv[2];
#pragma unroll
          for (int j = 0; j < 2; ++j) { const int i = tid_ + 512 * j, dcp = (i & 63) - 16; tbv[j] = (i < 15 * 64 && dcp >= 0 && dcp < 31) ? rpb[(i >> 6) * 31 + dcp] : 0.f; }
#pragma unroll
          for (int j = 0; j < 2; ++j) { const int i = tid_ + 512 * j; if (i < 15 * 64) tb[i] = tbv[j]; }
#pragma unroll
          for (int hb = 0; hb < 2; ++hb) { u32x4 tk[4], tv[4];
#pragma unroll
              for (int i = 0; i < 4; ++i) { const int idx = tid_ + 512 * (4 * hb + i), row = idx >> 9, rem = idx & 511, gr = rs0 + row;
                  tk[i] = *(const GAS u32x4*)(kg + (size_t)(gr * 64 + (rem >> 3)) * 768 + (rem & 7) * 8); tv[i] = *(const GAS u32x4*)(vg + (size_t)gr * 4096 + rem * 8); }
#pragma unroll
              for (int i = 0; i < 4; ++i) { const int idx = tid_ + 512 * (4 * hb + i), row = idx >> 9, rem = idx & 511, sl = (rs0 + row) & 7;
                  *(LAS u32x4*)(kl + (sl * 64 + (rem >> 3)) * 144 + (rem & 7) * 16) = tk[i]; *(LAS u32x4*)(vl + (rem >> 3) * 1040 + sl * 128 + (rem & 7) * 16) = tv[i]; } } }
        u32x4 ka_[2], va_[2], kb_[2], vb_[2];
#define NA_NEED(r_) (((r_) + 1 < r0 + 8) && (min(max((r_) - 3, 0), 56) != min(max((r_) - 4, 0), 56)))
#define NA_LOADROW(kk, vv, gn_) do { const int t2 = tid_ - 256; _Pragma("unroll") for (int i = 0; i < 2; ++i) { const int rem = t2 + 256 * i; kk[i] = *(const GAS u32x4*)(kg + (size_t)((gn_) * 64 + (rem >> 3)) * 768 + (rem & 7) * 8); vv[i] = *(const GAS u32x4*)(vg + (size_t)(gn_) * 4096 + rem * 8); } } while (0)
#define NA_STOREROW(kk, vv, gn_) do { const int t2 = tid_ - 256, sl = (gn_) & 7; _Pragma("unroll") for (int i = 0; i < 2; ++i) { const int rem = t2 + 256 * i; *(LAS u32x4*)(kl + (sl * 64 + (rem >> 3)) * 144 + (rem & 7) * 16) = kk[i]; *(LAS u32x4*)(vl + (rem >> 3) * 1040 + sl * 128 + (rem & 7) * 16) = vv[i]; } } while (0)
        if (wave >= 4 && NA_NEED(r0)) NA_LOADROW(ka_, va_, rs0 + 8);
        __syncthreads();
        auto na_row = [&](const int r, u32x4 (&lk)[2], u32x4 (&lv)[2], const u32x4 (&sk)[2], const u32x4 (&sv)[2]) __attribute__((always_inline)) {
            const int rs = min(max(r - 4, 0), 56);
            if (wave >= 4) { const int r1 = r + 1; if (NA_NEED(r1)) { const int gn1 = min(max(r1 - 4, 0), 56) + 8; NA_LOADROW(lk, lv, gn1); } }
            else {
                const int seg = wave, tok0 = b * SEQ + r * 64 + seg * 16, kc0 = min(max(seg * 16 - 8, 0), 32);
                const GAS bf16_t* qp = nrm + (size_t)(tok0 + fr) * 768 + head * 64 + 8 * g;
                const bf16x8 qf0 = *(const GAS bf16x8*)qp, qf1 = *(const GAS bf16x8*)(qp + 32);
                const int jj0 = 8 * (fr >> 2) + (fr & 3);
                f32x4 S[16];
                { bf16x8 kfr[16][2];
#pragma unroll
                  for (int i = 0; i < 16; ++i) { const int sl = (rs + (i >> 1)) & 7; const LAS unsigned char* ka = kl + (sl * 64 + kc0 + jj0 + 4 * (i & 1)) * 144 + 16 * g; kfr[i][0] = *(const LAS bf16x8*)ka; kfr[i][1] = *(const LAS bf16x8*)(ka + 64); }
                  __builtin_amdgcn_sched_barrier(0);
#pragma unroll
                  for (int i = 0; i < 16; ++i) { f32x4 z = {0.f, 0.f, 0.f, 0.f}; z = __builtin_amdgcn_mfma_f32_16x16x32_bf16(kfr[i][0], qf0, z, 0, 0, 0); S[i] = __builtin_amdgcn_mfma_f32_16x16x32_bf16(kfr[i][1], qf1, z, 0, 0, 0); } }
                float mx = -1e30f;
                { const int c = seg * 16 + fr, lo = min(max(c - 8, 0), 48) - c, dc0 = kc0 + 8 * g - c; const LAS float* tbl = tb + (rs - r + 7) * 64 + dc0 + 31;
                  float bvv[16][4];
#pragma unroll
                  for (int i = 0; i < 16; ++i)
#pragma unroll
                      for (int q = 0; q < 4; ++q) bvv[i][q] = tbl[(i >> 1) * 64 + 4 * (i & 1) + q];
                  __builtin_amdgcn_sched_barrier(0);
#pragma unroll
                  for (int i = 0; i < 16; ++i)
#pragma unroll
                      for (int q = 0; q < 4; ++q) { const int dj = 4 * (i & 1) + q, dc = dc0 + dj; const float bv = bvv[i][q];
                          const float mk = (dc >= lo && dc <= lo + 15) ? 0.f : -1e30f; const float v = (S[i][q] + bv) + mk; S[i][q] = v; mx = fmaxf(mx, v); } }
                mx = rows_max4(mx);
                float sum = 0.f; bf16x8 pf[8];
#pragma unroll
                for (int Gk = 0; Gk < 8; ++Gk) { float e[8];
#pragma unroll
                    for (int t = 0; t < 2; ++t)
#pragma unroll
                        for (int q = 0; q < 4; ++q) { e[t * 4 + q] = __expf(S[2 * Gk + t][q] - mx); sum += e[t * 4 + q]; }
                    u32x4 w; w.x = pk2(e[0], e[1]); w.y = pk2(e[2], e[3]); w.z = pk2(e[4], e[5]); w.w = pk2(e[6], e[7]); pf[Gk] = __builtin_bit_cast(bf16x8, w); }
                sum = rows_sum4(sum);
                const bool y8 = l >= Y8_FROM; const float inv = (y8 ? 8.0f : 1.0f) / sum; GAS bf16_t* yo = y + (size_t)(tok0 + fr) * D + 512 + head * 64 + 4 * g; GAS unsigned char* yo8 = (GAS unsigned char*)y + (size_t)(tok0 + fr) * D + 512 + head * 64 + 4 * g;
#pragma unroll
                for (int hv = 0; hv < 2; ++hv) { bf16x8 vfr[16];
#pragma unroll
                    for (int i = 0; i < 16; ++i) vfr[i] = *(const LAS bf16x8*)(vl + (16 * (2 * hv + (i >> 3)) + fr) * 1040 + ((rs + (i & 7)) & 7) * 128 + 2 * (kc0 + 8 * g));
                    __builtin_amdgcn_sched_barrier(0);
#pragma unroll
                    for (int m2 = 0; m2 < 2; ++m2) { f32x4 O = {0.f, 0.f, 0.f, 0.f};
#pragma unroll
                        for (int Gk = 0; Gk < 8; ++Gk) O = __builtin_amdgcn_mfma_f32_16x16x32_bf16(vfr[m2 * 8 + Gk], pf[Gk], O, 0, 0, 0);
                        if (y8) *(GAS unsigned*)(yo8 + 16 * (2 * hv + m2)) = pg8::pk4_fp8(O[0] * inv, O[1] * inv, O[2] * inv, O[3] * inv);
                        else { u32x2 w; w.x = pk2(O[0] * inv, O[1] * inv); w.y = pk2(O[2] * inv, O[3] * inv); *(GAS u32x2*)(yo + 16 * (2 * hv + m2)) = w; } } }
            }
            __syncthreads();
            if (wave >= 4 && NA_NEED(r)) { const int gn = rs + 8; NA_STOREROW(sk, sv, gn); }
            __syncthreads();
        };
#pragma unroll 1
        for (int r = r0; r < r0 + 8; r += 2) { na_row(r, kb_, vb_, ka_, va_); na_row(r + 1, ka_, va_, kb_, vb_); }
    }
}

__device__ __forceinline__ void ph_cross_lds(const Params& p, int l, LAS unsigned char* lds, const int tid, int G, int bid) {
    GAS unsigned char* ws_ = (GAS unsigned char*)p.ws; LAUNDER_S(ws_);
    const GAS bf16_t* nrm = (const GAS bf16_t*)(ws_ + WS_NRM); const GAS bf16_t* kmn = (const GAS bf16_t*)(ws_ + WS_KMN); const GAS bf16_t* vmt = (const GAS bf16_t*)(ws_ + WS_VMT); GAS bf16_t* y = (GAS bf16_t*)(ws_ + WS_Y);
    LAS unsigned char* kl = lds + LDS_SCR; LAS unsigned char* vl = kl + 256 * 144;
#pragma unroll 1
    for (int unit = bid; unit < BATCH * 4 * 8; unit += G) {
        int tid_ = tid; LAUNDER_V(tid_);
        const int lane = tid_ & 63, wave = __builtin_amdgcn_readfirstlane(tid_ >> 6), fr = lane & 15, g = lane >> 4;
        const int qc = unit & 7, head = (unit >> 3) & 3, b = unit >> 5;
        __syncthreads();
        { u32x4 tk[4], tv[4];
#pragma unroll
          for (int i = 0; i < 4; ++i) { const int idx = tid_ + 512 * i, rho = idx >> 3, c = idx & 7, key = (rho & ~31) + 8 * ((rho & 15) >> 2) + 4 * ((rho >> 4) & 1) + (rho & 3);
              tk[i] = *(const GAS u32x4*)(kmn + (size_t)((l * BATCH + b) * NMEM + key) * 256 + head * 64 + c * 8);
              const int dh = idx >> 5, cv = idx & 31; tv[i] = *(const GAS u32x4*)(vmt + ((size_t)(((l * BATCH + b) * 4 + head) * 64 + dh)) * NMEM + cv * 8); }
#pragma unroll
          for (int i = 0; i < 4; ++i) { const int idx = tid_ + 512 * i; *(LAS u32x4*)(kl + (idx >> 3) * 144 + (idx & 7) * 16) = tk[i]; *(LAS u32x4*)(vl + (idx >> 5) * 528 + (idx & 31) * 16) = tv[i]; } }
        __syncthreads();
#pragma unroll 1
        for (int ti = 0; ti < 4; ++ti) {
            const int tok0 = b * SEQ + qc * 512 + (wave * 4 + ti) * 16;
            const GAS bf16_t* qp = nrm + (size_t)(tok0 + fr) * 768 + 512 + head * 64 + 8 * g;
            const bf16x8 qf0 = *(const GAS bf16x8*)qp, qf1 = *(const GAS bf16x8*)(qp + 32);
            f32x4 S[16]; float mx = -1e30f;
            { bf16x8 kfr[16][2];
#pragma unroll
              for (int i = 0; i < 16; ++i) { const LAS unsigned char* ka = kl + (16 * i + fr) * 144 + 16 * g; kfr[i][0] = *(const LAS bf16x8*)ka; kfr[i][1] = *(const LAS bf16x8*)(ka + 64); }
              __builtin_amdgcn_sched_barrier(0);
#pragma unroll
              for (int i = 0; i < 16; ++i) { f32x4 z = {0.f, 0.f, 0.f, 0.f}; z = __builtin_amdgcn_mfma_f32_16x16x32_bf16(kfr[i][0], qf0, z, 0, 0, 0); S[i] = __builtin_amdgcn_mfma_f32_16x16x32_bf16(kfr[i][1], qf1, z, 0, 0, 0); } }
#pragma unroll
            for (int i = 0; i < 16; ++i)
#pragma unroll
                for (int q = 0; q < 4; ++q) mx = fmaxf(mx, S[i][q]);
            mx = rows_max4(mx);
            float sum = 0.f; bf16x8 pf[8];
#pragma unroll
            for (int Gk = 0; Gk < 8; ++Gk) { float e[8];
#pragma unroll
                for (int t = 0; t < 2; ++t)
#pragma unroll
                    for (int q = 0; q < 4; ++q) { e[t * 4 + q] = __expf(S[2 * Gk + t][q] - mx); sum += e[t * 4 + q]; }
                u32x4 w; w.x = pk2(e[0], e[1]); w.y = pk2(e[2], e[3]); w.z = pk2(e[4], e[5]); w.w = pk2(e[6], e[7]); pf[Gk] = __builtin_bit_cast(bf16x8, w); }
            sum = rows_sum4(sum);
            const bool y8 = l >= Y8_FROM; const float inv = (y8 ? 8.0f : 1.0f) / sum; GAS bf16_t* yo = y + (size_t)(tok0 + fr) * D + 768 + head * 64 + 4 * g; GAS unsigned char* yo8 = (GAS unsigned char*)y + (size_t)(tok0 + fr) * D + 768 + head * 64 + 4 * g;
#pragma unroll
            for (int hv = 0; hv < 2; ++hv) { bf16x8 vfr[16];
#pragma unroll
                for (int i = 0; i < 16; ++i) vfr[i] = *(const LAS bf16x8*)(vl + (16 * (2 * hv + (i >> 3)) + fr) * 528 + 16 * (4 * (i & 7) + g));
                __builtin_amdgcn_sched_barrier(0);
#pragma unroll
                for (int m2 = 0; m2 < 2; ++m2) { f32x4 O = {0.f, 0.f, 0.f, 0.f};
#pragma unroll
                    for (int Gk = 0; Gk < 8; ++Gk) O = __builtin_amdgcn_mfma_f32_16x16x32_bf16(vfr[m2 * 8 + Gk], pf[Gk], O, 0, 0, 0);
                    if (y8) *(GAS unsigned*)(yo8 + 16 * (2 * hv + m2)) = pg8::pk4_fp8(O[0] * inv, O[1] * inv, O[2] * inv, O[3] * inv);
                    else { u32x2 w; w.x = pk2(O[0] * inv, O[1] * inv); w.y = pk2(O[2] * inv, O[3] * inv); *(GAS u32x2*)(yo + 16 * (2 * hv + m2)) = w; } } }
        }
    }
    __syncthreads();
}

__device__ __forceinline__ float logsigmoidf_(float x) { return x >= 0.f ? -__logf(1.0f + __expf(-x)) : x - __logf(1.0f + __expf(x)); }
#define DPPS(old_, v_, ctrl_, rmask_, bc_) __int_as_float(__builtin_amdgcn_update_dpp(__float_as_int(old_), __float_as_int(v_), (ctrl_), (rmask_), 0xF, (bc_)))
__device__ __forceinline__ float wave_iscan_add(float v) {
    v += DPPS(0.f, v, 0x111, 0xF, true); v += DPPS(0.f, v, 0x112, 0xF, true); v += DPPS(0.f, v, 0x114, 0xF, true); v += DPPS(0.f, v, 0x118, 0xF, true);
    v += DPPS(0.f, v, 0x142, 0xA, true); v += DPPS(0.f, v, 0x143, 0xC, true); return v; }
__device__ __forceinline__ float wave_iscan_max(float v) {
    const float ninf = -3.0e38f;
    v = fmaxf(v, DPPS(ninf, v, 0x111, 0xF, false)); v = fmaxf(v, DPPS(ninf, v, 0x112, 0xF, false)); v = fmaxf(v, DPPS(ninf, v, 0x114, 0xF, false)); v = fmaxf(v, DPPS(ninf, v, 0x118, 0xF, false));
    v = fmaxf(v, DPPS(ninf, v, 0x142, 0xA, false)); v = fmaxf(v, DPPS(ninf, v, 0x143, 0xC, false)); return v; }
__device__ __forceinline__ void conv8(const bf16_t* proj, const float* cw, int tok, int sg, int c0, float (&a)[8]) {
#pragma unroll
    for (int q = 0; q < 8; ++q) a[q] = 0.f;
#pragma unroll
    for (int j = 0; j < 5; ++j) { const int sj = sg + j - 2; if (sj >= 0 && sj < SEQ) { const u32x4 w = *(const u32x4*)(proj + (size_t)(tok + j - 2) * NPROJ + c0); const f32x4 w0 = *(const f32x4*)(cw + j * 512 + c0), w1 = *(const f32x4*)(cw + j * 512 + c0 + 4);
            a[0] += bflo(w.x) * w0.x; a[1] += bfhi(w.x) * w0.y; a[2] += bflo(w.y) * w0.z; a[3] += bfhi(w.y) * w0.w; a[4] += bflo(w.z) * w1.x; a[5] += bfhi(w.z) * w1.y; a[6] += bflo(w.w) * w1.z; a[7] += bfhi(w.w) * w1.w; } }
#pragma unroll
    for (int q = 0; q < 8; ++q) a[q] = a[q] * sigmoidf_(a[q]);
}
__device__ __forceinline__ void ph_mlstm_a(const Params& p, int l, LAS unsigned char* lds, const int tid, int G, int bid) {
    GAS unsigned char* ws_ = (GAS unsigned char*)p.ws; LAUNDER_S(ws_);
    LAS float* wf = (LAS float*)(lds + LDS_SCR); LAS float* wb = wf + 128; LAS bf16_t* kwt = (LAS bf16_t*)(lds + LDS_SCR + 1024);
    constexpr int NIT = BATCH * 4 * 32;
    u32x4 nxr[8]; bf16x8 nbv[4]; float ngq[8]; f32x4 wq[5][2]; int hw = -1;
#define MA_LOAD(item_, xr_, bv_, gq_) do { int t__ = tid; LAUNDER_V(t__); GAS unsigned char* w__ = ws_; LAUNDER_S(w__); const int itr_ = NIT - 1 - (item_), chunk_ = itr_ & 31, h_ = (itr_ >> 5) & 3, b_ = itr_ >> 7; \
        const int slot_ = t__ & 31, cg_ = t__ >> 5, ch_ = ((cg_ >> 3) ? C_MK : C_MQ) + h_ * 64 + (cg_ & 7) * 8, ln_ = t__ & 63, wv_ = __builtin_amdgcn_readfirstlane(t__ >> 6); \
        const GAS bf16_t* pj_ = (const GAS bf16_t*)(w__ + WS_PROJ); \
        _Pragma("unroll") for (int r = 0; r < 8; ++r) { const int sg = chunk_ * 128 + 4 * slot_ - 2 + r, sc = min(max(sg, 0), SEQ - 1); xr_[r] = *(const GAS u32x4*)(pj_ + (size_t)(b_ * SEQ + sc) * NPROJ + ch_); } \
        { const GAS bf16_t* vp = (const GAS bf16_t*)(w__ + WS_VT) + ((size_t)((b_ * 4 + h_) * 128 + 16 * wv_ + (ln_ & 15))) * SEQ + chunk_ * 128 + 8 * (ln_ >> 4); \
          _Pragma("unroll") for (int ks = 0; ks < 4; ++ks) bv_[ks] = *(const GAS bf16x8*)(vp + 32 * ks); } \
        if (wv_ == 0) { const GAS float* gp = (const GAS float*)(w__ + WS_GATES) + (size_t)(b_ * SEQ + chunk_ * 128 + 2 * ln_) * 16 + h_; \
          _Pragma("unroll") for (int q = 0; q < 8; ++q) gq_[q] = gp[4 * q]; } } while (0)
    if (bid < NIT) MA_LOAD(bid, nxr, nbv, ngq);
#pragma unroll 1
    for (int item = bid; item < NIT; item += G) {
        GAS unsigned char* wsl = ws_; LAUNDER_S(wsl); int tid_ = tid; LAUNDER_V(tid_);
        const int lane = tid_ & 63, wave = __builtin_amdgcn_readfirstlane(tid_ >> 6), fr = lane & 15, g = lane >> 4;
        GAS bf16_t* qkc = (GAS bf16_t*)(wsl + WS_QKC);
        GAS float* mkv = (GAS float*)(wsl + WS_MKV); GAS float* mn = (GAS float*)(wsl + WS_MN); GAS float* cst = (GAS float*)(wsl + WS_MCST); GAS float* gst = (GAS float*)(wsl + WS_MGST); const GAS float* cw = (const GAS float*)(p.conv_qk + (size_t)l * 5 * 512);
        const int itr = NIT - 1 - item;
        const int chunk = itr & 31, h = (itr >> 5) & 3, b = itr >> 7, tokb = b * SEQ + chunk * 128, ccf = ((b * 4 + h) * 2) * 32 + chunk, ccb = ccf + 32;
        const int slot = tid_ & 31, cg = tid_ >> 5, isk = cg >> 3, ch0 = (isk ? C_MK : C_MQ) + h * 64 + (cg & 7) * 8;
        u32x4 xr[8]; bf16x8 bv[4]; float gq[8];
#pragma unroll
        for (int r = 0; r < 8; ++r) xr[r] = nxr[r];
#pragma unroll
        for (int ks = 0; ks < 4; ++ks) bv[ks] = nbv[ks];
#pragma unroll
        for (int q = 0; q < 8; ++q) gq[q] = ngq[q];
        if (h != hw) { hw = h;
#pragma unroll
            for (int tp = 0; tp < 5; ++tp) { wq[tp][0] = *(const GAS f32x4*)(cw + tp * 512 + ch0); wq[tp][1] = *(const GAS f32x4*)(cw + tp * 512 + ch0 + 4); } }
#pragma unroll
        for (int r = 0; r < 8; ++r) { const int sg = chunk * 128 + 4 * slot - 2 + r; if (sg < 0 || sg >= SEQ) xr[r] = (u32x4){0u, 0u, 0u, 0u}; }
        if (item + G < NIT) MA_LOAD(item + G, nxr, nbv, ngq);
        if (wave == 0) {
            const int t0 = 2 * lane;
            const float if0 = gq[0], ff0 = gq[1], ib0 = gq[2], fb0 = gq[3], if1 = gq[4], ff1 = gq[5], ib1 = gq[6], fb1 = gq[7];
            const float lf0 = logsigmoidf_(ff0), lf1 = logsigmoidf_(ff1), lb0 = logsigmoidf_(fb0), lb1 = logsigmoidf_(fb1);
            const float incf = wave_iscan_add(lf0 + lf1), incb = wave_iscan_add(lb0 + lb1);
            const float totf = __int_as_float(__builtin_amdgcn_readlane(__float_as_int(incf), 63)), totb = __int_as_float(__builtin_amdgcn_readlane(__float_as_int(incb), 63)), basef = incf - (lf0 + lf1), baseb = incb - (lb0 + lb1);
            const float bf0 = basef + lf0, bf1 = basef + lf0 + lf1, bb0 = totb - baseb, bb1 = totb - (baseb + lb0);
            const float uf0 = if0 - bf0, uf1 = if1 - bf1, ub0 = ib0 - bb0, ub1 = ib1 - bb1;
            const float incm = wave_iscan_max(fmaxf(uf0, uf1));
            const float incs = shb(wave_iscan_max(shb(fmaxf(ub0, ub1), 63 - lane)), 63 - lane);
            float exm = shu(incm, 1, lane), exs = shd(incs, 1, lane); if (lane == 0) exm = -3.0e38f; if (lane == 63) exs = -3.0e38f;
            const float pmf0 = fmaxf(exm, uf0), pmf1 = fmaxf(pmf0, uf1), pmb1 = fmaxf(exs, ub1), pmb0 = fmaxf(pmb1, ub0);
            const float maxuf = __int_as_float(__builtin_amdgcn_readlane(__float_as_int(incm), 63)), maxub = __int_as_float(__builtin_amdgcn_readlane(__float_as_int(incs), 0));
            *(LAS f32x2*)(wf + t0) = (f32x2){__expf(uf0 - maxuf), __expf(uf1 - maxuf)}; *(LAS f32x2*)(wb + t0) = (f32x2){__expf(ub0 - maxub), __expf(ub1 - maxub)};
            GAS float* gs = gst + (size_t)itr * 768 + t0;
            *(GAS f32x2*)(gs) = (f32x2){bf0, bf1}; *(GAS f32x2*)(gs + 128) = (f32x2){uf0, uf1}; *(GAS f32x2*)(gs + 256) = (f32x2){pmf0, pmf1};
            *(GAS f32x2*)(gs + 384) = (f32x2){bb0, bb1}; *(GAS f32x2*)(gs + 512) = (f32x2){ub0, ub1}; *(GAS f32x2*)(gs + 640) = (f32x2){pmb0, pmb1};
            if (lane == 0) { *(GAS f32x2*)(cst + 2 * ccf) = (f32x2){totf + maxuf, totf}; *(GAS f32x2*)(cst + 2 * ccb) = (f32x2){totb + maxub, totb}; }
        }
        float cv[4][8];
#pragma unroll
        for (int j = 0; j < 4; ++j) { float a[8];
#pragma unroll
            for (int q = 0; q < 8; ++q) a[q] = 0.f;
#pragma unroll
            for (int tp = 0; tp < 5; ++tp) { const u32x4 w = xr[j + tp]; const f32x4 w0 = wq[tp][0], w1 = wq[tp][1];
                a[0] += bflo(w.x) * w0.x; a[1] += bfhi(w.x) * w0.y; a[2] += bflo(w.y) * w0.z; a[3] += bfhi(w.y) * w0.w; a[4] += bflo(w.z) * w1.x; a[5] += bfhi(w.z) * w1.y; a[6] += bflo(w.w) * w1.z; a[7] += bfhi(w.w) * w1.w; }
            const float sc = isk ? 1.0f : 0.125f;
#pragma unroll
            for (int q = 0; q < 8; ++q) { a[q] = a[q] * sigmoidf_(a[q]); cv[j][q] = a[q]; }
            u32x4 o; o.x = pk2(a[0] * sc, a[1] * sc); o.y = pk2(a[2] * sc, a[3] * sc); o.z = pk2(a[4] * sc, a[5] * sc); o.w = pk2(a[6] * sc, a[7] * sc);
            *(GAS u32x4*)(qkc + (size_t)(tokb + 4 * slot + j) * 512 + isk * 256 + h * 64 + (cg & 7) * 8) = o; }
        __syncthreads();
        if (isk) { const int kc = (cg & 7) * 8; const f32x4 wf4 = *(const LAS f32x4*)(wf + 4 * slot), wb4 = *(const LAS f32x4*)(wb + 4 * slot);
#pragma unroll
            for (int jp = 0; jp < 2; ++jp) { const float wfa = wf4[2 * jp], wfb = wf4[2 * jp + 1], wba = wb4[2 * jp], wbb = wb4[2 * jp + 1];
#pragma unroll
                for (int q = 0; q < 8; ++q) { LAS unsigned* kf = (LAS unsigned*)(kwt + (kc + q) * 136 + 4 * slot + 2 * jp); LAS unsigned* kb = (LAS unsigned*)(kwt + 64 * 136 + (kc + q) * 136 + 4 * slot + 2 * jp);
                    *kf = pk2(cv[2 * jp][q] * wfa, cv[2 * jp + 1][q] * wfb); *kb = pk2(cv[2 * jp][q] * wba, cv[2 * jp + 1][q] * wbb); } } }
        __syncthreads();
        {
#pragma unroll
            for (int dir = 0; dir < 2; ++dir) { GAS bf16_t* outp = (GAS bf16_t*)mkv + ((size_t)(dir ? ccb : ccf) * 128 + 16 * wave + fr) * 64 + 4 * g;
                bf16x8 af[16];
#pragma unroll
                for (int i = 0; i < 16; ++i) af[i] = *(const LAS bf16x8*)(kwt + dir * 64 * 136 + (16 * (i >> 2) + fr) * 136 + 32 * (i & 3) + 8 * g);
                __builtin_amdgcn_sched_barrier(0);
#pragma unroll
                for (int mt = 0; mt < 4; ++mt) { f32x4 acc = {0.f, 0.f, 0.f, 0.f};
#pragma unroll
                    for (int ks = 0; ks < 4; ++ks) acc = __builtin_amdgcn_mfma_f32_16x16x32_bf16(af[mt * 4 + ks], bv[ks], acc, 0, 0, 0);
                    u32x2 w; w.x = pk2c(acc[0], acc[1]); w.y = pk2c(acc[2], acc[3]); *(GAS u32x2*)(outp + 16 * mt) = w; } }
            if (tid_ < 128) { const int dir = tid_ >> 6, dk = tid_ & 63; float sm = 0.f;
#pragma unroll
                for (int c8 = 0; c8 < 16; ++c8) { const u32x4 w4 = *(const LAS u32x4*)(kwt + dir * 64 * 136 + dk * 136 + 8 * c8); sm += (bflo(w4.x) + bfhi(w4.x)) + (bflo(w4.y) + bfhi(w4.y)) + (bflo(w4.z) + bfhi(w4.z)) + (bflo(w4.w) + bfhi(w4.w)); }
                mn[(size_t)(dir ? ccb : ccf) * 64 + dk] = sm; }
        }
        __syncthreads();
    }
}
__device__ __forceinline__ void ph_mlstm_scan(const Params& p, int gtid, int gsz) {
    GAS unsigned char* ws_ = (GAS unsigned char*)p.ws; LAUNDER_S(ws_);
    const GAS bf16_t* mkv = (const GAS bf16_t*)(ws_ + WS_MKV); const GAS float* mn = (const GAS float*)(ws_ + WS_MN); const GAS float* cst = (const GAS float*)(ws_ + WS_MCST);
    GAS bf16_t* mcp = (GAS bf16_t*)(ws_ + WS_MCP); GAS float* mnp = (GAS float*)(ws_ + WS_MNP); GAS float* mmp = (GAS float*)(ws_ + WS_MMP);
    if ((gtid & 511) < 16) {
#pragma unroll 1
        for (int ni = (gtid >> 9) * 16 + (gtid & 511); ni < 64 * 64; ni += (gsz >> 9) * 16) {
            const int chain = ni >> 6, dk = ni & 63, dir = chain & 1; float n = 0.f, m = 0.f;
#pragma unroll 1
            for (int hb = 0; hb < 2; ++hb) { float ncv[16]; f32x2 ag[16];
#pragma unroll
                for (int i = 0; i < 16; ++i) { const int ci = 16 * hb + i, c = dir ? 31 - ci : ci; const size_t cc = (size_t)chain * 32 + c; ncv[i] = mn[cc * 64 + dk]; ag[i] = *(const GAS f32x2*)(cst + 2 * cc); }
#pragma unroll
                for (int i = 0; i < 16; ++i) { const int ci = 16 * hb + i, c = dir ? 31 - ci : ci; const size_t cc = (size_t)chain * 32 + c;
                    mnp[cc * 64 + dk] = n; if (dk == 0) mmp[cc] = m;
                    const float mnew = fmaxf(ag[i].y + m, ag[i].x), sp = __expf(ag[i].y + m - mnew), sc = __expf(ag[i].x - mnew);
                    n = n * sp + ncv[i] * sc; m = mnew; } }
        }
    }
#pragma unroll 1
    for (int idx = gtid; idx < 64 * 128 * 16; idx += gsz) {
        const int dkq = idx & 15, dv = (idx >> 4) & 127, chain = idx >> 11, dir = chain & 1;
        f32x4 C = {0.f, 0.f, 0.f, 0.f}; float m = 0.f;
#pragma unroll 1
        for (int hb = 0; hb < 2; ++hb) {
            u32x2 kvw[16]; f32x2 ag[16];
#pragma unroll
            for (int i = 0; i < 16; ++i) { const int ci = 16 * hb + i, c = dir ? 31 - ci : ci; const size_t cc = (size_t)chain * 32 + c; kvw[i] = *(const GAS u32x2*)(mkv + (cc * 128 + dv) * 64 + dkq * 4); ag[i] = *(const GAS f32x2*)(cst + 2 * cc); }
#pragma unroll
            for (int i = 0; i < 16; ++i) { const int ci = 16 * hb + i, c = dir ? 31 - ci : ci; const size_t cc = (size_t)chain * 32 + c;
                u32x2 w; w.x = pk2(C[0], C[1]); w.y = pk2(C[2], C[3]); *(GAS u32x2*)(mcp + (cc * 128 + dv) * 64 + dkq * 4) = w;
                const float mnew = fmaxf(ag[i].y + m, ag[i].x), sp = __expf(ag[i].y + m - mnew), sc = __expf(ag[i].x - mnew);
                const f32x4 kv = {bflo(kvw[i].x), bfhi(kvw[i].x), bflo(kvw[i].y), bfhi(kvw[i].y)};
                C = C * sp + kv * sc; m = mnew; }
        }
    }
}
__device__ __forceinline__ void ph_mlstm_c(const Params& p, int l, LAS unsigned char* lds, const int tid, int G, int bid) {
    GAS unsigned char* ws_ = (GAS unsigned char*)p.ws; LAUNDER_S(ws_);
    LAS unsigned char* kl = lds + LDS_SCR; LAS unsigned char* vl = kl + 128 * 144; LAS unsigned char* cfl = vl + 128 * 272; LAS unsigned char* cbl = cfl + 128 * 144; LAS float* ugl = (LAS float*)(cbl + 128 * 144);
#pragma unroll 1
    for (int item = bid; item < BATCH * 4 * 32; item += G) {
        GAS unsigned char* wsl = ws_; LAUNDER_S(wsl);
        int tid_ = tid; LAUNDER_V(tid_);
        const int lane = tid_ & 63, wave = __builtin_amdgcn_readfirstlane(tid_ >> 6), fr = lane & 15, g = lane >> 4;
        const GAS bf16_t* proj = (const GAS bf16_t*)(wsl + WS_PROJ); const GAS bf16_t* qkc = (const GAS bf16_t*)(wsl + WS_QKC); const GAS bf16_t* vt = (const GAS bf16_t*)(wsl + WS_VT); const GAS bf16_t* mcp = (const GAS bf16_t*)(wsl + WS_MCP);
        const GAS float* mnp = (const GAS float*)(wsl + WS_MNP); const GAS float* mmp = (const GAS float*)(wsl + WS_MMP); const GAS float* gst = (const GAS float*)(wsl + WS_MGST); GAS bf16_t* y = (GAS bf16_t*)(wsl + WS_Y);
        const int chunk = item & 31, h = (item >> 5) & 3, b = item >> 7, tokb = b * SEQ + chunk * 128, t = 16 * wave + fr, tq = tokb + t;
        const size_t ccf = (size_t)((b * 4 + h) * 2) * 32 + chunk, ccb = ccf + 32;
        const GAS bf16_t* qp = qkc + (size_t)tq * 512 + h * 64 + 8 * g;
        const u32x4 q0 = *(const GAS u32x4*)qp, q1 = *(const GAS u32x4*)(qp + 32);
        const GAS float* gs = gst + (size_t)item * 768;
        const float bfw = gs[t], pmf = gs[256 + t], bbw = gs[384 + t], pmb = gs[640 + t], mpf = mmp[ccf], mpb = mmp[ccb];
        f32x4 npf[4], npb[4];
#pragma unroll
        for (int i = 0; i < 4; ++i) { npf[i] = *(const GAS f32x4*)(mnp + ccf * 64 + 32 * (i >> 1) + 8 * g + 4 * (i & 1)); npb[i] = *(const GAS f32x4*)(mnp + ccb * 64 + 32 * (i >> 1) + 8 * g + 4 * (i & 1)); }
        unsigned ogw[8];
        { const GAS unsigned char* op = (const GAS unsigned char*)(wsl + WS_OG) + (size_t)tq * 512 + h * 128 + 4 * g;
#pragma unroll
          for (int mt = 0; mt < 8; ++mt) ogw[mt] = *(const GAS unsigned*)(op + 16 * mt); }
        __syncthreads();
        { u32x4 tk[2], tv[4], tf[2], tb[2];
#pragma unroll
          for (int i = 0; i < 2; ++i) { const int idx = tid_ + 512 * i, rho = idx >> 3, c = idx & 7, key = (rho & ~31) + 8 * ((rho & 15) >> 2) + 4 * ((rho >> 4) & 1) + (rho & 3);
              tk[i] = *(const GAS u32x4*)(qkc + (size_t)(tokb + key) * 512 + 256 + h * 64 + c * 8);
              tf[i] = *(const GAS u32x4*)(mcp + (ccf * 128 + rho) * 64 + c * 8); tb[i] = *(const GAS u32x4*)(mcp + (ccb * 128 + rho) * 64 + c * 8); }
#pragma unroll
          for (int i = 0; i < 4; ++i) { const int idx = tid_ + 512 * i, dv = idx >> 4, c = idx & 15; tv[i] = *(const GAS u32x4*)(vt + ((size_t)((b * 4 + h) * 128 + dv)) * SEQ + chunk * 128 + c * 8); }
          f32x4 ugv = {0.f, 0.f, 0.f, 0.f};
          if (tid_ < 64) { const GAS float* gsu = gst + (size_t)item * 768 + (tid_ < 32 ? 128 : 512 - 128) + 4 * tid_; ugv = *(const GAS f32x4*)gsu; }
#pragma unroll
          for (int i = 0; i < 2; ++i) { const int idx = tid_ + 512 * i, rho = idx >> 3, c = idx & 7; *(LAS u32x4*)(kl + rho * 144 + c * 16) = tk[i]; *(LAS u32x4*)(cfl + rho * 144 + c * 16) = tf[i]; *(LAS u32x4*)(cbl + rho * 144 + c * 16) = tb[i]; }
#pragma unroll
          for (int i = 0; i < 4; ++i) { const int idx = tid_ + 512 * i; *(LAS u32x4*)(vl + (idx >> 4) * 272 + (idx & 15) * 16) = tv[i]; }
          if (tid_ < 64) *(LAS f32x4*)(ugl + 4 * tid_) = ugv; }
        const float Mf = fmaxf(mpf, pmf), Mb = fmaxf(mpb, pmb), sif = __expf(mpf - Mf), sib = __expf(mpb - Mb), flf = __expf(-bfw - Mf), flb = __expf(-bbw - Mb);
        const float qv[16] = {bflo(q0.x), bfhi(q0.x), bflo(q0.y), bfhi(q0.y), bflo(q0.z), bfhi(q0.z), bflo(q0.w), bfhi(q0.w), bflo(q1.x), bfhi(q1.x), bflo(q1.y), bfhi(q1.y), bflo(q1.z), bfhi(q1.z), bflo(q1.w), bfhi(q1.w)};
        float qnf = 0.f, qnb = 0.f;
#pragma unroll
        for (int ks = 0; ks < 2; ++ks)
#pragma unroll
            for (int hf = 0; hf < 2; ++hf) { const f32x4 nf = npf[ks * 2 + hf], nb = npb[ks * 2 + hf];
#pragma unroll
                for (int q = 0; q < 4; ++q) { qnf += qv[ks * 8 + hf * 4 + q] * nf[q]; qnb += qv[ks * 8 + hf * 4 + q] * nb[q]; } }
        qnf = rows_sum4(qnf); qnb = rows_sum4(qnb);
        const bf16x8 qf0 = __builtin_bit_cast(bf16x8, q0), qf1 = __builtin_bit_cast(bf16x8, q1);
        __syncthreads();
        f32x4 scf[4][2], scb[4][2]; float rsf = 0.f, rsb = 0.f;
        bf16x8 kfr[8][2];
#pragma unroll
        for (int i = 0; i < 8; ++i) { const LAS unsigned char* ka = kl + (16 * i + fr) * 144 + 16 * g; kfr[i][0] = *(const LAS bf16x8*)ka; kfr[i][1] = *(const LAS bf16x8*)(ka + 64); }
        __builtin_amdgcn_sched_barrier(0);
#pragma unroll
        for (int Gk = 0; Gk < 4; ++Gk)
#pragma unroll
            for (int tt = 0; tt < 2; ++tt) {
                f32x4 z = {0.f, 0.f, 0.f, 0.f};
                z = __builtin_amdgcn_mfma_f32_16x16x32_bf16(kfr[2 * Gk + tt][0], qf0, z, 0, 0, 0); z = __builtin_amdgcn_mfma_f32_16x16x32_bf16(kfr[2 * Gk + tt][1], qf1, z, 0, 0, 0);
                const int s0 = 32 * Gk + 8 * g + 4 * tt; const f32x4 uf = *(const LAS f32x4*)(ugl + s0), ub = *(const LAS f32x4*)(ugl + 128 + s0);
#pragma unroll
                for (int q = 0; q < 4; ++q) { const int s = s0 + q; const float ef = __expf(s <= t ? uf[q] - Mf : -1e30f), eb = __expf(s >= t ? ub[q] - Mb : -1e30f);
                    scf[Gk][tt][q] = z[q] * ef; scb[Gk][tt][q] = z[q] * eb; rsf += scf[Gk][tt][q]; rsb += scb[Gk][tt][q]; } }
        rsf = rows_sum4(rsf); rsb = rows_sum4(rsb);
        const float invf = 1.0f / fmaxf(fabsf(sif * qnf + rsf), flf), invb = 1.0f / fmaxf(fabsf(sib * qnb + rsb), flb), cf = sif * invf, cb = sib * invb;
        bf16x8 pf[4], qff[2], qfb[2];
#pragma unroll
        for (int Gk = 0; Gk < 4; ++Gk) { float e[8];
#pragma unroll
            for (int tt = 0; tt < 2; ++tt)
#pragma unroll
                for (int q = 0; q < 4; ++q) e[tt * 4 + q] = scf[Gk][tt][q] * invf + scb[Gk][tt][q] * invb;
            u32x4 w; w.x = pk2(e[0], e[1]); w.y = pk2(e[2], e[3]); w.z = pk2(e[4], e[5]); w.w = pk2(e[6], e[7]); pf[Gk] = __builtin_bit_cast(bf16x8, w); }
#pragma unroll
        for (int ks = 0; ks < 2; ++ks) { u32x4 w;
            w.x = pk2(qv[ks * 8 + 0] * cf, qv[ks * 8 + 1] * cf); w.y = pk2(qv[ks * 8 + 2] * cf, qv[ks * 8 + 3] * cf); w.z = pk2(qv[ks * 8 + 4] * cf, qv[ks * 8 + 5] * cf); w.w = pk2(qv[ks * 8 + 6] * cf, qv[ks * 8 + 7] * cf); qff[ks] = __builtin_bit_cast(bf16x8, w);
            w.x = pk2(qv[ks * 8 + 0] * cb, qv[ks * 8 + 1] * cb); w.y = pk2(qv[ks * 8 + 2] * cb, qv[ks * 8 + 3] * cb); w.z = pk2(qv[ks * 8 + 4] * cb, qv[ks * 8 + 5] * cb); w.w = pk2(qv[ks * 8 + 6] * cb, qv[ks * 8 + 7] * cb); qfb[ks] = __builtin_bit_cast(bf16x8, w); }
        f32x4 O[8]; float ss = 0.f;
#pragma unroll
        for (int hv = 0; hv < 2; ++hv) {
            bf16x8 fa[4][8];
#pragma unroll
            for (int m2 = 0; m2 < 4; ++m2) { const int mt = 4 * hv + m2; const LAS unsigned char* va = vl + (16 * mt + fr) * 272 + 16 * g; const LAS unsigned char* fp = cfl + (16 * mt + fr) * 144 + 16 * g; const LAS unsigned char* bp = cbl + (16 * mt + fr) * 144 + 16 * g;
#pragma unroll
                for (int Gk = 0; Gk < 4; ++Gk) fa[m2][Gk] = *(const LAS bf16x8*)(va + 64 * Gk);
                fa[m2][4] = *(const LAS bf16x8*)fp; fa[m2][5] = *(const LAS bf16x8*)(fp + 64); fa[m2][6] = *(const LAS bf16x8*)bp; fa[m2][7] = *(const LAS bf16x8*)(bp + 64); }
            __builtin_amdgcn_sched_barrier(0);
#pragma unroll
            for (int m2 = 0; m2 < 4; ++m2) { f32x4 acc = {0.f, 0.f, 0.f, 0.f};
#pragma unroll
                for (int Gk = 0; Gk < 4; ++Gk) acc = __builtin_amdgcn_mfma_f32_16x16x32_bf16(fa[m2][Gk], pf[Gk], acc, 0, 0, 0);
                acc = __builtin_amdgcn_mfma_f32_16x16x32_bf16(fa[m2][4], qff[0], acc, 0, 0, 0); acc = __builtin_amdgcn_mfma_f32_16x16x32_bf16(fa[m2][5], qff[1], acc, 0, 0, 0);
                acc = __builtin_amdgcn_mfma_f32_16x16x32_bf16(fa[m2][6], qfb[0], acc, 0, 0, 0); acc = __builtin_amdgcn_mfma_f32_16x16x32_bf16(fa[m2][7], qfb[1], acc, 0, 0, 0);
                O[4 * hv + m2] = acc; ss += acc[0] * acc[0] + acc[1] * acc[1] + acc[2] * acc[2] + acc[3] * acc[3]; }
        }
        ss = rows_sum4(ss);
        const float rr = rsqrtf(ss * (1.0f / 128.0f) + EPS);
        const GAS float* gm = (const GAS float*)(p.g_mh + l * 512 + h * 128 + 4 * g); GAS bf16_t* yo = y + (size_t)tq * D + h * 128 + 4 * g; GAS unsigned char* yo8 = (GAS unsigned char*)y + (size_t)tq * D + h * 128 + 4 * g; const bool y8 = l >= Y8_FROM; const float rrs = y8 ? 8.0f * rr : rr;
        f32x4 gmv[8];
#pragma unroll
        for (int mt = 0; mt < 8; ++mt) gmv[mt] = *(const GAS f32x4*)(gm + 16 * mt);
#pragma unroll
        for (int mt = 0; mt < 8; ++mt) { const unsigned ow = ogw[mt]; const f32x4 gv = gmv[mt];
            const float o0 = sigmoidf_(0.125f * __builtin_amdgcn_cvt_f32_fp8(ow, 0)) * O[mt][0] * rrs * gv.x, o1 = sigmoidf_(0.125f * __builtin_amdgcn_cvt_f32_fp8(ow, 1)) * O[mt][1] * rrs * gv.y, o2 = sigmoidf_(0.125f * __builtin_amdgcn_cvt_f32_fp8(ow, 2)) * O[mt][2] * rrs * gv.z, o3 = sigmoidf_(0.125f * __builtin_amdgcn_cvt_f32_fp8(ow, 3)) * O[mt][3] * rrs * gv.w;
            if (y8) *(GAS unsigned*)(yo8 + 16 * mt) = pg8::pk4_fp8(o0, o1, o2, o3);
            else { u32x2 w; w.x = pk2(o0, o1); w.y = pk2(o2, o3); *(GAS u32x2*)(yo + 16 * mt) = w; } }
    }
    __syncthreads();
}

__device__ __forceinline__ unsigned block_excl_scan(unsigned val, LAS unsigned* wtot, int lane, int wave) {
    unsigned inc = val;
#pragma unroll
    for (int o = 1; o < 64; o <<= 1) { const unsigned t = shuu(inc, o, lane); if (lane >= o) inc += t; }
    if (lane == 63) wtot[wave] = inc;
    __syncthreads();
    unsigned base = 0;
    for (int w = 0; w < wave; ++w) base += wtot[w];
    __syncthreads();
    return base + inc - val;
}
__device__ __forceinline__ void ph_topk(const Params& p, LAS unsigned char* lds, const int tid, int G, int bid) {
    GAS unsigned char* ws_ = (GAS unsigned char*)p.ws; LAUNDER_S(ws_);
    const int lane = tid & 63, wave = __builtin_amdgcn_readfirstlane(tid >> 6);
    LAS unsigned* hist = (LAS unsigned*)(lds + LDS_SCR); LAS unsigned* sel = hist + 256; LAS unsigned* wtot = hist + 272;
    const GAS float* aff = (const GAS float*)(ws_ + WS_AFF); GAS int* slot_tok = (GAS int*)(ws_ + WS_ROUTE + RT_SLOTTOK); GAS float* gate_slot = (GAS float*)(ws_ + WS_ROUTE + RT_GATE); GAS int* slotmap = (GAS int*)(ws_ + WS_ROUTE + RT_SLOTMAP);
    for (int item = bid; item < BATCH * NE; item += G) {
        const int b = item >> 4, e = item & 15; const GAS float* av = aff + (size_t)item * SEQ + tid * 8;
        const f32x4 v0 = *(const GAS f32x4*)av, v1 = *(const GAS f32x4*)(av + 4);
        const float vals[8] = {v0.x, v0.y, v0.z, v0.w, v1.x, v1.y, v1.z, v1.w}; unsigned key[8];
#pragma unroll
        for (int i = 0; i < 8; ++i) key[i] = __float_as_uint(vals[i]);
        unsigned prefix = 0u, mask = 0u, remaining = CAP;
        for (int pass = 0; pass < 4; ++pass) { const int shift = 24 - 8 * pass;
            if (tid < 256) hist[tid] = 0u;
            __syncthreads();
#pragma unroll
            for (int i = 0; i < 8; ++i) if ((key[i] & mask) == prefix) atomicAdd((unsigned*)&hist[(key[i] >> shift) & 255u], 1u);
            __syncthreads();
            if (wave == 0) { const unsigned c0 = hist[255 - 4 * lane], c1 = hist[254 - 4 * lane], c2 = hist[253 - 4 * lane], c3 = hist[252 - 4 * lane]; const unsigned sm = c0 + c1 + c2 + c3; unsigned inc = sm;
#pragma unroll
                for (int o = 1; o < 64; o <<= 1) { const unsigned t = shuu(inc, o, lane); if (lane >= o) inc += t; }
                const unsigned before = inc - sm;
                if (before < remaining && remaining <= inc) { unsigned r = remaining - before; unsigned d;
                    if (r <= c0) d = 255 - 4 * lane; else if (r <= c0 + c1) { d = 254 - 4 * lane; r -= c0; } else if (r <= c0 + c1 + c2) { d = 253 - 4 * lane; r -= c0 + c1; } else { d = 252 - 4 * lane; r -= c0 + c1 + c2; }
                    sel[0] = prefix | (d << shift); sel[1] = r; } }
            __syncthreads();
            prefix = sel[0]; remaining = sel[1]; mask |= 0xffu << shift;
        }
        unsigned ceq = 0;
#pragma unroll
        for (int i = 0; i < 8; ++i) ceq += (key[i] == prefix) ? 1u : 0u;
        unsigned eqb = block_excl_scan(ceq, wtot, lane, wave);
        bool sl[8]; unsigned csel = 0;
#pragma unroll
        for (int i = 0; i < 8; ++i) { const bool eq = key[i] == prefix; sl[i] = key[i] > prefix || (eq && eqb < remaining); eqb += eq ? 1u : 0u; csel += sl[i] ? 1u : 0u; }
        unsigned pos = block_excl_scan(csel, wtot, lane, wave);
#pragma unroll
        for (int i = 0; i < 8; ++i) { const int s = tid * 8 + i; int c = -1;
            if (sl[i]) { c = (int)pos++; const int slot = (e * BATCH + b) * CAP + c; slot_tok[slot] = b * SEQ + s; gate_slot[slot] = vals[i]; }
            slotmap[(size_t)(b * SEQ + s) * NE + e] = c; }
        __syncthreads();
    }
}
__device__ __forceinline__ void ph_gather(const Params& p, const int tid, int G, int bid) {
    unsigned char* ws_ = p.ws; LAUNDER_S(ws_);
    const int lane = tid & 63, gw = bid * 8 + __builtin_amdgcn_readfirstlane(tid >> 6), NGW = G * 8;
    const bf16_t* hb = (const bf16_t*)(ws_ + WS_H); bf16_t* xe = (bf16_t*)(ws_ + WS_XE); const int* slot_tok = (const int*)(ws_ + WS_ROUTE + RT_SLOTTOK);
    for (int r = gw; r < NSLOT; r += NGW) { const int tok = slot_tok[r]; const u32x4* s = (const u32x4*)((const unsigned char*)hb + (size_t)tok * D) + lane; u32x4* d = (u32x4*)((unsigned char*)xe + (size_t)r * D) + lane; d[0] = s[0]; }
}

__global__ void __launch_bounds__(512, 2) fwd(Params p) {
    extern __shared__ __attribute__((aligned(16))) unsigned char lds_raw[];
    LAS unsigned char* lds = (LAS unsigned char*)lds_raw;
    const int G = gridDim.x, bid = blockIdx.x, wave0 = __builtin_amdgcn_readfirstlane((int)threadIdx.x >> 6);
    { const int t = FRESH_TID(); if (t < 64) ((LAS unsigned*)lds)[t] = 0u; }
    __syncthreads();
    unsigned* ctl = (unsigned*)(p.ws + WS_CTL);
    XcdBarrier bar = xcd_barrier_post(ctl + CW_BAR + p.li * XCD_BAR_WORDS, (volatile LAS unsigned*)(lds + 16), wave0);
    const int lo = p.ph_lo, hi = p.ph_hi;
#define IN(k) (lo <= (k) && (k) < hi)
#define SEAM(k) do { if (IN(k) && IN((k) + 1)) xcd_barrier(bar); } while (0)
#define GTID(t) (bid * 512 + (t))
    LAS unsigned char* ring = lds + LDS_SCR;

    if (IN(0)) REPEAT(11) ph_convert(p, lds, FRESH_TID(), G, bid);
    SEAM(0);
    if (IN(1)) {
        unsigned char* ws_ = p.ws; LAUNDER_S(ws_);
        pg8::Gemm g{(const bf16_t*)(ws_ + WS_MEMH), (const bf16_t*)(ws_ + WS_WKV), DEPTH * BATCH * NMEM, DEPTH * 512, D}; pg8::KvOrder S{G, bid};
        pg8::EpiKvMem E{ws_, p.mem_gk};
        pg8::gemm_phase<pg8::EpiKvMem, pg8::KvOrder, true, true>(ring, g, S, E, FRESH_TID());
        __syncthreads();
        ph_cvt_experts(p, lds, FRESH_TID(), G, bid);
    }
    SEAM(1);
#pragma unroll 1
    for (int l = 0; l < DEPTH; ++l) {
        const int pb = 2 + 11 * l;
        if (IN(pb + 0)) { if (l == 0) ph_norm<0, true>(p, l, false, lds, FRESH_TID(), G, bid, p.x); else ph_norm<0, false>(p, l, true, lds, FRESH_TID(), G, bid, p.ws + WS_XB); }
        SEAM(pb + 0);
        if (IN(pb + 1)) REPEAT(1) {
            unsigned char* ws_ = p.ws; LAUNDER_S(ws_);
            pg8::Gemm g{(const bf16_t*)(ws_ + WS_XB), (const bf16_t*)(ws_ + WS_WIN) + (size_t)l * NPROJ * D, NTOK, NPROJ, D}; pg8::StaticOrder S; S.init(NTOK, NPROJ, G, bid);
            pg8::EpiProj E{ws_, (const float*)(ws_ + WS_GT) + l * 192, (const float*)(ws_ + WS_RR)};
            pg8::gemm_phase<pg8::EpiProj, pg8::StaticOrder, true, true>(ring, g, S, E, FRESH_TID());
        }
        SEAM(pb + 1);
        if (IN(pb + 2)) REPEAT(2) {
            REPEAT(13) ph_mlstm_a(p, l, lds, FRESH_TID(), G, bid);

            REPEAT(12) ph_na_lds(p, l, lds, FRESH_TID(), G, bid); REPEAT(14) ph_cross_lds(p, l, lds, FRESH_TID(), G, bid);
        }
        SEAM(pb + 2);
        if (IN(pb + 3)) REPEAT(3) { const int t = FRESH_TID(); ph_mlstm_scan(p, GTID(t), G * 512); }
        SEAM(pb + 3);
        if (IN(pb + 4)) REPEAT(4) ph_mlstm_c(p, l, lds, FRESH_TID(), G, bid);
        SEAM(pb + 4);
        if (IN(pb + 5)) REPEAT(5) {
            unsigned char* ws_ = p.ws; LAUNDER_S(ws_);
            pg8::Gemm g{(const bf16_t*)(ws_ + WS_Y), (const bf16_t*)(ws_ + WS_WOUT) + (size_t)l * D * D, NTOK, D, D}; pg8::StaticOrder S; S.init(NTOK, D, G, bid);
            pg8::EpiResid E{(bf16_t*)(ws_ + WS_XB)};
            if (l >= Y8_FROM) { pg8::Gemm g8{(const bf16_t*)(ws_ + WS_Y), (const bf16_t*)(ws_ + WS_WOUT) + (size_t)l * D * D, NTOK, D, D / 2};
                pg8::gemm_phase_f8<pg8::EpiResid, pg8::StaticOrder, true, true, 124, 119>(ring, g8, S, E, FRESH_TID()); }
            else pg8::gemm_phase<pg8::EpiResid, pg8::StaticOrder, true, true>(ring, g, S, E, FRESH_TID());
        }
        SEAM(pb + 5);
        if (IN(pb + 6)) ph_norm1_t4(p, l, lds, FRESH_TID(), G, bid);
        SEAM(pb + 6);
        if (IN(pb + 7)) REPEAT(7) ph_topk(p, lds, FRESH_TID(), G, bid);
        SEAM(pb + 7);
        if (IN(pb + 9)) REPEAT(9) {
            unsigned char* ws_ = p.ws; LAUNDER_S(ws_);
            pg8::Gemm g{(const bf16_t*)(ws_ + WS_H), (const bf16_t*)(ws_ + WS_W13 + (size_t)l * NE * 4096 * D), NSLOT, NE * 4096, D / 2}; pg8::MoeOrder S{G, bid, 16, 256};
            pg8::EpiSwiGLU8 E{ws_ + WS_HID};
            pg8::gemm_phase_f8g<pg8::EpiSwiGLU8, pg8::MoeOrder, true, true, 124, 119>(ring, g, S, E, FRESH_TID(), (const int*)(ws_ + WS_ROUTE + RT_SLOTTOK));
        }
        SEAM(pb + 9);
        if (IN(pb + 10)) REPEAT(10) {
            unsigned char* ws_ = p.ws; LAUNDER_S(ws_);
            pg8::Gemm g{(const bf16_t*)(ws_ + WS_HID), (const bf16_t*)(ws_ + WS_W2 + (size_t)l * NE * D * DFF), NSLOT, NE * D, DFF / 2}; pg8::MoeOrder S{G, bid, 4, 64};
            pg8::EpiGate E{(bf16_t*)(ws_ + WS_YBUF), (const float*)(ws_ + WS_ROUTE + RT_GATE)};
            pg8::gemm_phase_f8<pg8::EpiGate, pg8::MoeOrder, true, true, 124, 119>(ring, g, S, E, FRESH_TID());
        }
        SEAM(pb + 10);
    }
    if (IN(NPHASE - 1)) ph_norm<2, false>(p, 0, true, lds, FRESH_TID(), G, bid, p.ws + WS_XB);
#undef GTID
#undef IN
#undef SEAM
}

#ifndef ATTN_NAIVE
#define ATTN_NAIVE 0
#endif
#ifndef MK_PER_PHASE
#define MK_PER_PHASE 0
#endif
extern "C" void kernel_launch(void* const* d_in, const int* in_sizes, int n_in, void* d_out, int out_size, void* d_ws, size_t ws_size, hipStream_t stream) {
    static int grid = 0;
    if (grid == 0) {
        if (n_in != 20 || out_size != NTOK * D || ws_size < WS_END) { fprintf(stderr, "kernel_launch: unexpected shapes (n_in %d, out %d, ws %zu < %zu)\n", n_in, out_size, ws_size, (size_t)WS_END); grid = -1; return; }
        int dev = 0, cus = 0, per_cu = 0;
        if (hipGetDevice(&dev) != hipSuccess || hipDeviceGetAttribute(&cus, hipDeviceAttributeMultiprocessorCount, dev) != hipSuccess) { grid = -1; return; }
        if (hipFuncSetAttribute((const void*)fwd, hipFuncAttributeMaxDynamicSharedMemorySize, LDS_BYTES) != hipSuccess) { fprintf(stderr, "kernel_launch: hipFuncSetAttribute failed\n"); grid = -1; return; }
        if (hipOccupancyMaxActiveBlocksPerMultiprocessor(&per_cu, (const void*)fwd, 512, LDS_BYTES) != hipSuccess || per_cu < 1) { fprintf(stderr, "kernel_launch: occupancy query says %d\n", per_cu); per_cu = 1; }
        (void)hipGetLastError();
        grid = cus;
    }
    if (grid < 0) return;
    (void)hipMemsetAsync((char*)d_ws + WS_CTL, 0, CTL_BYTES, stream);
    Params P{};
    const float** pp = (const float**)&P;
    for (int i = 0; i < 20; ++i) pp[i] = (const float*)d_in[i];
    P.out = (float*)d_out; P.ws = (unsigned char*)d_ws; P.pad = 0;
#if MK_PER_PHASE
    for (int ph = 0; ph < NPHASE; ++ph) { P.ph_lo = ph; P.ph_hi = ph + 1; P.li = ph; hipLaunchKernelGGL(fwd, dim3(grid), dim3(512), LDS_BYTES, stream, P); }
#else
    P.ph_lo = 0; P.ph_hi = NPHASE; P.li = 0;
    hipLaunchKernelGGL(fwd, dim3(grid), dim3(512), LDS_BYTES, stream, P);
#endif
}
```

```cpp
#include <hip/hip_runtime.h>
#include <cstdio>
#include <cstdint>

constexpr size_t MiB = (size_t)1 << 20;
constexpr size_t WS_CTL = 0, CTL_BYTES = 1 * MiB;
constexpr size_t WS_WIN = 1 * MiB, WS_WKV = 21 * MiB, WS_WOUT = 25 * MiB, WS_W13 = 33 * MiB, WS_W2 = 545 * MiB;
constexpr size_t WS_H = 801 * MiB, WS_MEMH = 865 * MiB, WS_PROJ = 881 * MiB, WS_GATES = 1041 * MiB, WS_KVMEM = 1043 * MiB, WS_Y = 1051 * MiB;
constexpr size_t WS_AFF = 1115 * MiB, WS_ROUTE = 1117 * MiB, WS_XE = 1121 * MiB, WS_XB = WS_XE, WS_RR = WS_ROUTE + 3 * MiB, WS_OG = WS_H + 32 * MiB, WS_HID = 1249 * MiB, WS_YBUF = 1505 * MiB, WS_QKC = 1633 * MiB, WS_HDIR = 1665 * MiB, WS_VT = 1793 * MiB, WS_NVT = 1825 * MiB, WS_NRM = 1841 * MiB, WS_KMN = 1889 * MiB, WS_VMT = 1893 * MiB, WS_GT = 1897 * MiB, WS_END = 1898 * MiB;
constexpr size_t WS_MKV = WS_HID, WS_MCP = WS_HID + 64 * MiB, WS_MN = WS_HID + 96 * MiB, WS_MNP = WS_HID + 97 * MiB, WS_MCST = WS_HID + 98 * MiB, WS_MMP = WS_HID + 98 * MiB + 512 * 1024, WS_MGST = WS_HID + 99 * MiB;
constexpr size_t RT_SLOTTOK = 0, RT_GATE = 256 * 1024, RT_SLOTMAP = 1 * MiB;
constexpr int CW_BAR = 1024;


__device__ __forceinline__ float shx(float v, int mask, int lane) { return __int_as_float(__builtin_amdgcn_ds_bpermute((lane ^ mask) << 2, __float_as_int(v))); }
__device__ __forceinline__ float shu(float v, int o, int lane) { return __int_as_float(__builtin_amdgcn_ds_bpermute(((lane - o) & 63) << 2, __float_as_int(v))); }
__device__ __forceinline__ float shd(float v, int o, int lane) { return __int_as_float(__builtin_amdgcn_ds_bpermute(((lane + o) & 63) << 2, __float_as_int(v))); }
__device__ __forceinline__ float shb(float v, int src) { return __int_as_float(__builtin_amdgcn_ds_bpermute(src << 2, __float_as_int(v))); }
__device__ __forceinline__ unsigned shuu(unsigned v, int o, int lane) { return (unsigned)__builtin_amdgcn_ds_bpermute(((lane - o) & 63) << 2, (int)v); }

typedef unsigned u32x2s __attribute__((ext_vector_type(2)));
__device__ __forceinline__ float rows_sum4(float v) {
    u32x2s r = __builtin_amdgcn_permlane16_swap(__float_as_uint(v), __float_as_uint(v), false, false); v = __uint_as_float(r.x) + __uint_as_float(r.y);
    r = __builtin_amdgcn_permlane32_swap(__float_as_uint(v), __float_as_uint(v), false, false); return __uint_as_float(r.x) + __uint_as_float(r.y); }
__device__ __forceinline__ float rows_max4(float v) {
    u32x2s r = __builtin_amdgcn_permlane16_swap(__float_as_uint(v), __float_as_uint(v), false, false); v = fmaxf(__uint_as_float(r.x), __uint_as_float(r.y));
    r = __builtin_amdgcn_permlane32_swap(__float_as_uint(v), __float_as_uint(v), false, false); return fmaxf(__uint_as_float(r.x), __uint_as_float(r.y)); }
namespace pg8 {
#define PG8_LAS __attribute__((address_space(3)))
typedef unsigned short bf16_t;
typedef short bf16x8 __attribute__((ext_vector_type(8)));
typedef float f32x4 __attribute__((ext_vector_type(4)));
typedef unsigned u32x4 __attribute__((ext_vector_type(4)));
constexpr int BM = 256, BK = 64, HALF = 128, HTB = HALF * BK * 2  , STAGE_BYTES = 8 * HTB, NXCD = 8, WGM = 8;

__host__ __device__ __forceinline__ int lds_byte(int r, int c) { const int st = (r >> 4) * 2 + (c >> 5), rr = r & 15, cc = c & 31, ob = rr * 64 + cc * 2; return st * 1024 + (ob ^ (((ob >> 9) & 1) << 5)); }
__host__ __device__ __forceinline__ void stage_rc(int b, int& R, int& C) { const int st = b / 1024, sb = b % 1024, swz = sb ^ (((sb >> 9) & 1) << 5); R = (st >> 1) * 16 + swz / 64; C = (st & 1) * 32 + (swz % 64) / 2; }
__host__ __device__ __forceinline__ int perm32(int rho) { const int n = rho >> 4, i = rho & 15; return 8 * (i >> 2) + 4 * n + (i & 3); }

struct Unit { int pm, pn; };
struct Gemm { const bf16_t* A; const bf16_t* Bt; int M, N, K; };

struct StaticOrder {
    int nM, nN, nwg, G, c;
    __host__ __device__ void init(int M, int N, int G_, int c_) { nM = M / BM; nN = N / BM; nwg = nM * nN; G = G_; c = c_; }
    __host__ __device__ bool next(int i, Unit& u) const {
        const long L = (long)i * G + c; if (L >= nwg) return false;
        int wgid = (int)L; { const int q = nwg / NXCD, r = nwg % NXCD, xcd = wgid % NXCD, off = wgid / NXCD; wgid = (xcd < r ? xcd * (q + 1) : r * (q + 1) + (xcd - r) * q) + off; }
        const int nig = WGM * nN, gid = wgid / nig, fm = gid * WGM, gsz = (nM - fm) < WGM ? (nM - fm) : WGM;
        u.pm = fm + ((wgid % nig) % gsz); u.pn = (wgid % nig) / gsz; return true;
    }
    __device__ __forceinline__ void a_ready(const Unit&) const {}
    __device__ __forceinline__ void done(const Unit&) const {}
};

__device__ __forceinline__ unsigned cvt_pk_bf16(float lo, float hi) { unsigned r; asm volatile("v_cvt_pk_bf16_f32 %0, %1, %2" : "=v"(r) : "v"(lo), "v"(hi)); return r; }
typedef float f32x2 __attribute__((ext_vector_type(2)));

struct EpiStoreBf16 {
    static constexpr bool PERM = true, AFTER_DRAIN = false;
    bf16_t* O; int ldc; int ncolt;
    __device__ __forceinline__ void operator()(const f32x4 (&acc)[2][2][4][2], const Unit& u, int wr, int wc, int fr, int fq) const {
        const int row0 = u.pm * BM + wr * 64 + fr, col0 = (u.pn % ncolt) * BM + wc * 32 + 8 * fq;
#pragma unroll
        for (int ai = 0; ai < 2; ++ai)
#pragma unroll
            for (int m = 0; m < 4; ++m) { bf16_t* rowp = O + (size_t)(row0 + ai * HALF + m * 16) * ldc + col0;
#pragma unroll
                for (int bj = 0; bj < 2; ++bj) { const f32x4 v0 = acc[ai][bj][m][0], v1 = acc[ai][bj][m][1];
                    u32x4 w; w.x = cvt_pk_bf16(v0[0], v0[1]); w.y = cvt_pk_bf16(v0[2], v0[3]); w.z = cvt_pk_bf16(v1[0], v1[1]); w.w = cvt_pk_bf16(v1[2], v1[3]);
                    *(u32x4*)(rowp + bj * HALF) = w; } }
    }
};
struct EpiResid {
    static constexpr bool PERM = true, AFTER_DRAIN = false;
    bf16_t* X;
    __device__ __forceinline__ void operator()(const f32x4 (&acc)[2][2][4][2], const Unit& u, int wr, int wc, int fr, int fq) const {
        const int row0 = u.pm * BM + wr * 64 + fr, col0 = u.pn * BM + wc * 32 + 8 * fq;
        u32x4 t[2][4][2];
#pragma unroll
        for (int ai = 0; ai < 2; ++ai)
#pragma unroll
            for (int m = 0; m < 4; ++m) { const bf16_t* rowp = X + (size_t)(row0 + ai * HALF + m * 16) * 1024 + col0;
#pragma unroll
                for (int bj = 0; bj < 2; ++bj) t[ai][m][bj] = *(const u32x4*)(rowp + bj * HALF); }
#pragma unroll
        for (int ai = 0; ai < 2; ++ai)
#pragma unroll
            for (int m = 0; m < 4; ++m) { bf16_t* rowp = X + (size_t)(row0 + ai * HALF + m * 16) * 1024 + col0;
#pragma unroll
                for (int bj = 0; bj < 2; ++bj) { const f32x4 v0 = acc[ai][bj][m][0], v1 = acc[ai][bj][m][1]; const u32x4 x = t[ai][m][bj];
                    u32x4 w; w.x = cvt_pk_bf16(v0[0] + __uint_as_float(x.x << 16), v0[1] + __uint_as_float(x.x & 0xffff0000u)); w.y = cvt_pk_bf16(v0[2] + __uint_as_float(x.y << 16), v0[3] + __uint_as_float(x.y & 0xffff0000u));
                    w.z = cvt_pk_bf16(v1[0] + __uint_as_float(x.z << 16), v1[1] + __uint_as_float(x.z & 0xffff0000u)); w.w = cvt_pk_bf16(v1[2] + __uint_as_float(x.w << 16), v1[3] + __uint_as_float(x.w & 0xffff0000u));
                    *(u32x4*)(rowp + bj * HALF) = w; } }
    }
};
struct EpiSwiGLU {
    static constexpr bool PERM = true, AFTER_DRAIN = false;
    bf16_t* Hd;
    __device__ __forceinline__ void operator()(const f32x4 (&acc)[2][2][4][2], const Unit& u, int wr, int wc, int fr, int fq) const {
        const int row0 = u.pm * BM + wr * 64 + fr, col0 = (u.pn & 15) * HALF + wc * 32 + 8 * fq;
#pragma unroll
        for (int ai = 0; ai < 2; ++ai)
#pragma unroll
            for (int m = 0; m < 4; ++m) { bf16_t* rowp = Hd + (size_t)(row0 + ai * HALF + m * 16) * 2048 + col0;
                float h[8];
#pragma unroll
                for (int n = 0; n < 2; ++n)
#pragma unroll
                    for (int j = 0; j < 4; ++j) { const float a = acc[ai][0][m][n][j], b = acc[ai][1][m][n][j]; h[n * 4 + j] = a * __builtin_amdgcn_rcpf(1.0f + __expf(-a)) * b; }
                u32x4 w; w.x = cvt_pk_bf16(h[0], h[1]); w.y = cvt_pk_bf16(h[2], h[3]); w.z = cvt_pk_bf16(h[4], h[5]); w.w = cvt_pk_bf16(h[6], h[7]);
                *(u32x4*)rowp = w; }
    }
};

typedef unsigned u32x2v __attribute__((ext_vector_type(2)));
__device__ __forceinline__ unsigned pk4_fp8(float a, float b, float c, float d) {
    a = fminf(fmaxf(a, -448.f), 448.f); b = fminf(fmaxf(b, -448.f), 448.f); c = fminf(fmaxf(c, -448.f), 448.f); d = fminf(fmaxf(d, -448.f), 448.f);
    int w = 0; w = __builtin_amdgcn_cvt_pk_fp8_f32(a, b, w, false); w = __builtin_amdgcn_cvt_pk_fp8_f32(c, d, w, true); return (unsigned)w; }
typedef short v2s16 __attribute__((ext_vector_type(2)));
__device__ __forceinline__ unsigned pk4_fp8s(float a, float b, float c, float d, float scale) {
    v2s16 r = {0, 0}; r = __builtin_amdgcn_cvt_scalef32_pk_fp8_f32(r, a, b, scale, false); r = __builtin_amdgcn_cvt_scalef32_pk_fp8_f32(r, c, d, scale, true); return __builtin_bit_cast(unsigned, r); }
struct EpiSwiGLU8 {
    static constexpr bool PERM = true, AFTER_DRAIN = false;
    unsigned char* Hd;
    __device__ __forceinline__ void operator()(const f32x4 (&acc)[2][2][4][2], const Unit& u, int wr, int wc, int fr, int fq) const {
        const int row0 = u.pm * BM + wr * 64 + fr, col0 = (u.pn & 15) * HALF + wc * 32 + 8 * fq;
#pragma unroll
        for (int ai = 0; ai < 2; ++ai)
#pragma unroll
            for (int m = 0; m < 4; ++m) { unsigned char* rowp = Hd + (size_t)(row0 + ai * HALF + m * 16) * 2048 + col0;
                float h[8];
#pragma unroll
                for (int n = 0; n < 2; ++n)
#pragma unroll
                    for (int j = 0; j < 4; ++j) { const float a = acc[ai][0][m][n][j], b = acc[ai][1][m][n][j]; h[n * 4 + j] = 8.0f * a * __builtin_amdgcn_rcpf(1.0f + __expf(-a)) * b; }
                u32x2v w; w.x = pk4_fp8(h[0], h[1], h[2], h[3]); w.y = pk4_fp8(h[4], h[5], h[6], h[7]);
                *(u32x2v*)rowp = w; }
    }
};
struct EpiGate {
    static constexpr bool PERM = true, AFTER_DRAIN = false;
    bf16_t* Y; const float* gate;
    __device__ __forceinline__ void operator()(const f32x4 (&acc)[2][2][4][2], const Unit& u, int wr, int wc, int fr, int fq) const {
        const int row0 = u.pm * BM + wr * 64 + fr, col0 = (u.pn & 3) * BM + wc * 32 + 8 * fq;
        float gs[2][4];
#pragma unroll
        for (int ai = 0; ai < 2; ++ai)
#pragma unroll
            for (int m = 0; m < 4; ++m) gs[ai][m] = gate[row0 + ai * HALF + m * 16];
#pragma unroll
        for (int ai = 0; ai < 2; ++ai)
#pragma unroll
            for (int m = 0; m < 4; ++m) { const int row = row0 + ai * HALF + m * 16; const float g = gs[ai][m]; unsigned char* rowp = (unsigned char*)Y + (size_t)row * 1024 + col0;
#pragma unroll
                for (int bj = 0; bj < 2; ++bj) { const f32x4 v0 = acc[ai][bj][m][0] * g, v1 = acc[ai][bj][m][1] * g;
                    u32x2v w; w.x = pk4_fp8s(v0[0], v0[1], v0[2], v0[3], 0.125f); w.y = pk4_fp8s(v1[0], v1[1], v1[2], v1[3], 0.125f);
                    *(u32x2v*)(rowp + bj * HALF) = w; } }
    }
};

__device__ __forceinline__ void st_bf16(bf16_t* p, unsigned w, bool hi) { *p = (bf16_t)(hi ? (w >> 16) : (w & 0xffffu)); }
struct EpiProj {
    static constexpr bool PERM = true, AFTER_DRAIN = false;
    unsigned char* ws; const float* gt; const float* rrow;
    __device__ __forceinline__ void operator()(const f32x4 (&acc)[2][2][4][2], const Unit& u, int wr, int wc, int fr, int fq) const {
        const int pn = u.pn, row0 = u.pm * BM + wr * 64 + fr, lane = fq * 16 + fr;
        float rs[2][4];
#pragma unroll
        for (int ai = 0; ai < 2; ++ai)
#pragma unroll
            for (int m = 0; m < 4; ++m) rs[ai][m] = rrow[row0 + ai * HALF + m * 16];
        bf16_t* P = (bf16_t*)(ws + WS_PROJ); bf16_t* VT = (bf16_t*)(ws + WS_VT); bf16_t* NVT = (bf16_t*)(ws + WS_NVT); bf16_t* NRM = (bf16_t*)(ws + WS_NRM);
        if (pn == 6 || pn == 7 || pn == 9) {
            const int sel = pn == 6 ? 0 : (pn == 7 ? 1 : 2); const float* gsrc = gt + sel * 64; const float qs = pn == 7 ? 1.0f : (pn == 9 ? 0.125f * 1.44269504f : 0.125f);
            f32x4 gv[2][2];
#pragma unroll
            for (int bj = 0; bj < 2; ++bj)
#pragma unroll
                for (int n = 0; n < 2; ++n) gv[bj][n] = *(const f32x4*)(gsrc + 32 * bj + 8 * fq + 4 * n);
            const int nb = (pn == 6 ? 0 : (pn == 7 ? 256 : 512)) + 64 * wc + 8 * fq, pb = pn * BM + 64 * wc + 8 * fq;
#pragma unroll
            for (int ai = 0; ai < 2; ++ai)
#pragma unroll
                for (int m = 0; m < 4; ++m) { const size_t row = (size_t)(row0 + ai * HALF + m * 16); float ss = 0.f;
#pragma unroll
                    for (int bj = 0; bj < 2; ++bj)
#pragma unroll
                        for (int n = 0; n < 2; ++n) { const f32x4 v = acc[ai][bj][m][n]; ss += v[0] * v[0] + v[1] * v[1] + v[2] * v[2] + v[3] * v[3]; }
                    ss = rows_sum4(ss) * rs[ai][m] * rs[ai][m];
                    const float rr = rsqrtf(ss * (1.0f / 64.0f) + 1e-6f) * qs * rs[ai][m];
#pragma unroll
                    for (int bj = 0; bj < 2; ++bj) { const f32x4 v0 = acc[ai][bj][m][0], v1 = acc[ai][bj][m][1];
                        const f32x4 n0 = v0 * gv[bj][0] * rr, n1 = v1 * gv[bj][1] * rr; u32x4 w;
                        w.x = cvt_pk_bf16(n0[0], n0[1]); w.y = cvt_pk_bf16(n0[2], n0[3]); w.z = cvt_pk_bf16(n1[0], n1[1]); w.w = cvt_pk_bf16(n1[2], n1[3]);
                        *(u32x4*)(NRM + row * 768 + nb + 32 * bj) = w; } }
            return;
        }
        const int col0 = pn * BM + wc * 32 + 8 * fq;
        if (pn == 4 || pn == 5) {
            unsigned char* OG = ws + WS_OG;
#pragma unroll
            for (int ai = 0; ai < 2; ++ai)
#pragma unroll
                for (int m = 0; m < 4; ++m) { unsigned char* rowp = OG + (size_t)(row0 + ai * HALF + m * 16) * 512 + (pn - 4) * BM + wc * 32 + 8 * fq;
#pragma unroll
                    for (int bj = 0; bj < 2; ++bj) { const f32x4 v0 = acc[ai][bj][m][0] * rs[ai][m], v1 = acc[ai][bj][m][1] * rs[ai][m];
                        u32x2v w; w.x = pk4_fp8(8.f * v0[0], 8.f * v0[1], 8.f * v0[2], 8.f * v0[3]); w.y = pk4_fp8(8.f * v1[0], 8.f * v1[1], 8.f * v1[2], 8.f * v1[3]);
                        *(u32x2v*)(rowp + bj * HALF) = w; } }
            return;
        }
        if (!(pn == 2 || pn == 3 || pn == 8))
#pragma unroll
        for (int ai = 0; ai < 2; ++ai)
#pragma unroll
            for (int m = 0; m < 4; ++m) { bf16_t* rowp = P + (size_t)(row0 + ai * HALF + m * 16) * 2560 + col0;
#pragma unroll
                for (int bj = 0; bj < 2; ++bj) { const f32x4 v0 = acc[ai][bj][m][0] * rs[ai][m], v1 = acc[ai][bj][m][1] * rs[ai][m];
                    u32x4 w; w.x = cvt_pk_bf16(v0[0], v0[1]); w.y = cvt_pk_bf16(v0[2], v0[3]); w.z = cvt_pk_bf16(v1[0], v1[1]); w.w = cvt_pk_bf16(v1[2], v1[3]);
                    *(u32x4*)(rowp + bj * HALF) = w; } }
        if (pn == 2 || pn == 3 || pn == 8) {
            const int b = u.pm >> 4, s0 = (u.pm & 15) * BM + wr * 64 + fr;
#pragma unroll
            for (int bj = 0; bj < 2; ++bj) {
                bf16_t* base;
                if (pn == 8) base = NVT + ((size_t)((b * 4 + 2 * bj + (wc >> 1)) * 64 + 32 * (wc & 1) + 8 * fq)) * 4096 + s0;
                else base = VT + ((size_t)((b * 4 + (pn - 2) * 2 + bj) * 128 + 32 * wc + 8 * fq)) * 4096 + s0;
#pragma unroll
                for (int ai = 0; ai < 2; ++ai)
#pragma unroll
                    for (int m = 0; m < 4; ++m)
#pragma unroll
                        for (int n = 0; n < 2; ++n) { const f32x4 v = acc[ai][bj][m][n] * rs[ai][m]; const unsigned w0 = cvt_pk_bf16(v[0], v[1]), w1 = cvt_pk_bf16(v[2], v[3]);
                            if (pn == 8) {
                                const int head = 2 * bj + (wc >> 1), dim = 32 * (wc & 1) + 8 * fq + 4 * n, gr = (u.pm & 15) * 4 + wr + 2 * ai, colq = m * 16 + fr;
                                bf16_t* q = NVT + ((size_t)(((b * 4 + head) * 64 + gr) * 64 + dim)) * 64 + colq;
                                st_bf16(q, w0, false); st_bf16(q + 64, w0, true); st_bf16(q + 128, w1, false); st_bf16(q + 192, w1, true); }
                            else { bf16_t* q = base + (size_t)(4 * n) * 4096 + ai * HALF + m * 16;
                                st_bf16(q, w0, false); st_bf16(q + 4096, w0, true); st_bf16(q + 2 * 4096, w1, false); st_bf16(q + 3 * 4096, w1, true); } }
            }
        }
    }
};
struct EpiKvMem {
    static constexpr bool PERM = true, AFTER_DRAIN = false;
    unsigned char* ws; const float* gk;
    __device__ __forceinline__ void operator()(const f32x4 (&acc)[2][2][4][2], const Unit& u, int wr, int wc, int fr, int fq) const {
        const int row0 = u.pm * BM + wr * 64 + fr, l = u.pn >> 1, lane = fq * 16 + fr;
        bf16_t* KMN = (bf16_t*)(ws + WS_KMN); bf16_t* VMT = (bf16_t*)(ws + WS_VMT);
        if ((u.pn & 1) == 0) {
            f32x4 gv[2][2];
#pragma unroll
            for (int bj = 0; bj < 2; ++bj)
#pragma unroll
                for (int n = 0; n < 2; ++n) gv[bj][n] = *(const f32x4*)(gk + l * 64 + 32 * bj + 8 * fq + 4 * n);
#pragma unroll
            for (int ai = 0; ai < 2; ++ai)
#pragma unroll
                for (int m = 0; m < 4; ++m) { const size_t row = (size_t)(row0 + ai * HALF + m * 16); float ss = 0.f;
#pragma unroll
                    for (int bj = 0; bj < 2; ++bj)
#pragma unroll
                        for (int n = 0; n < 2; ++n) { const f32x4 v = acc[ai][bj][m][n]; ss += v[0] * v[0] + v[1] * v[1] + v[2] * v[2] + v[3] * v[3]; }
                    ss = rows_sum4(ss);
                    const float rr = rsqrtf(ss * (1.0f / 64.0f) + 1e-6f);
#pragma unroll
                    for (int bj = 0; bj < 2; ++bj) { const f32x4 v0 = acc[ai][bj][m][0], v1 = acc[ai][bj][m][1];
                        const f32x4 n0 = v0 * gv[bj][0] * rr, n1 = v1 * gv[bj][1] * rr; u32x4 w;
                        w.x = cvt_pk_bf16(n0[0], n0[1]); w.y = cvt_pk_bf16(n0[2], n0[3]); w.z = cvt_pk_bf16(n1[0], n1[1]); w.w = cvt_pk_bf16(n1[2], n1[3]);
                        *(u32x4*)(KMN + row * 256 + 64 * wc + 32 * bj + 8 * fq) = w; } }
            return;
        }
        const int lb = u.pm;
#pragma unroll
        for (int bj = 0; bj < 2; ++bj) { bf16_t* base = VMT + ((size_t)((lb * 4 + 2 * bj + (wc >> 1)) * 64 + 32 * (wc & 1) + 8 * fq)) * 256 + wr * 64 + fr;
#pragma unroll
            for (int ai = 0; ai < 2; ++ai)
#pragma unroll
                for (int m = 0; m < 4; ++m)
#pragma unroll
                    for (int n = 0; n < 2; ++n) { const f32x4 v = acc[ai][bj][m][n]; const unsigned w0 = cvt_pk_bf16(v[0], v[1]), w1 = cvt_pk_bf16(v[2], v[3]);
                        bf16_t* q = base + (size_t)(4 * n) * 256 + ai * HALF + m * 16;
                        st_bf16(q, w0, false); st_bf16(q + 256, w0, true); st_bf16(q + 512, w1, false); st_bf16(q + 768, w1, true); } }
    }
};
struct KvOrder {
    int G, c;
    __device__ bool next(int i, Unit& u) const { const int L = i * G + c; if (L >= 64) return false; const int l = L >> 4, w = L & 15; u.pm = l * 8 + (w & 7); u.pn = l * 2 + (w >> 3); return true; }
    __device__ __forceinline__ void a_ready(const Unit&) const {}
    __device__ __forceinline__ void done(const Unit&) const {}
};
struct MoeOrder {
    int G, c, nN, upe;
    __device__ bool next(int i, Unit& u) const {
        const int L = i * G + c; if (L >= 16 * upe) return false;
        const int e = L / upe, w = L % upe, q = upe / NXCD, wgid = (w % NXCD) * q + w / NXCD;
        int nig = WGM * nN, gid = wgid / nig, pml = gid * WGM + (wgid % nig) % WGM, pnl = (wgid % nig) / WGM;
        if (nN == 4) { pml = 2 * (w % NXCD) + ((w / NXCD) & 1); pnl = (w / NXCD) >> 1; }
        const int ee = (nN == 4) ? 15 - e : e;
        u.pm = ee * 16 + pml; u.pn = ee * nN + pnl; return true;
    }
    __device__ __forceinline__ void a_ready(const Unit&) const {}
    __device__ __forceinline__ void done(const Unit&) const {}
};

template <class Epi, class Sched, bool ALIGN_EPI = false, bool SP2 = false>
__device__ __forceinline__ void gemm_phase(PG8_LAS unsigned char* lds, const Gemm g, const Sched& S, const Epi& E, const int tid) {
    const int wid = __builtin_amdgcn_readfirstlane(tid >> 6), lane = tid & 63, wr = wid >> 2, wc = wid & 3, fr = lane & 15, fq = lane >> 4;
    const int K = g.K, nt = K / BK;
    unsigned voffA[2], voffB[2];
#pragma unroll
    for (int i = 0; i < 2; ++i) { int R, C; stage_rc(tid * 16 + i * 8192, R, C); const int Rb = Epi::PERM ? ((R & ~31) + perm32(R & 31)) : R;
        voffA[i] = (unsigned)(R * K + C) * 2u; voffB[i] = (unsigned)(Rb * K + C) * 2u; }
    const size_t kstep = (size_t)(BK * 2);
    const size_t hstep = (size_t)HALF * K * 2;
    const size_t tstep = 2 * hstep;
    const unsigned ldsw = (unsigned)wid * 1024u;
    const int aoff = lds_byte(wr * 64 + fr, fq * 8), boff = lds_byte(wc * 32 + fr, fq * 8);
#define PG8_SA(b, h) (((b) * 2 + (h)) * HTB)
#define PG8_SB(b, h) ((4 + (b) * 2 + (h)) * HTB)
#define PG8_STAGE(bufoff, gbase, voff) do { _Pragma("unroll") for (int _i = 0; _i < 2; ++_i) \
        __builtin_amdgcn_global_load_lds((const unsigned*)((const char*)(gbase) + (voff)[_i]), (PG8_LAS unsigned*)(lds + (bufoff) + ldsw + _i * 8192), 16, 0, 0); } while (0)
#define PG8_LDA(dst, b, h) do { _Pragma("unroll") for (int m = 0; m < 4; ++m) _Pragma("unroll") for (int k = 0; k < 2; ++k) dst[m][k] = *(const PG8_LAS bf16x8*)(lds + PG8_SA(b, h) + aoff + m * 2048 + k * 1024); } while (0)
#define PG8_LDB(dst, b, h) do { _Pragma("unroll") for (int n = 0; n < 2; ++n) _Pragma("unroll") for (int k = 0; k < 2; ++k) dst[n][k] = *(const PG8_LAS bf16x8*)(lds + PG8_SB(b, h) + boff + n * 2048 + k * 1024); } while (0)
#define PG8_MMA(ai, bj, At, Bt) do { __builtin_amdgcn_s_setprio(1); _Pragma("unroll") for (int m = 0; m < 4; ++m) _Pragma("unroll") for (int n = 0; n < 2; ++n) _Pragma("unroll") for (int k = 0; k < 2; ++k) \
        acc[ai][bj][m][n] = __builtin_amdgcn_mfma_f32_16x16x32_bf16(Bt[n][k], At[m][k], acc[ai][bj][m][n], 0, 0, 0); __builtin_amdgcn_s_setprio(0); } while (0)
#define PG8_WAIT_V(n) asm volatile("s_waitcnt vmcnt(" #n ")" ::: "memory")
#define PG8_WAIT_L(n) asm volatile("s_waitcnt lgkmcnt(" #n ")" ::: "memory")
#define PG8_BAR __builtin_amdgcn_s_barrier()
#define PG8_SCHED __builtin_amdgcn_sched_barrier(0)
    Unit cur, nxt; int ui = 0;
    if (!S.next(0, cur)) return;
    f32x4 acc[2][2][4][2];
#pragma unroll
    for (int a = 0; a < 2; ++a)
#pragma unroll
        for (int b = 0; b < 2; ++b)
#pragma unroll
            for (int m = 0; m < 4; ++m)
#pragma unroll
                for (int n = 0; n < 2; ++n) acc[a][b][m][n] = (f32x4){0.f, 0.f, 0.f, 0.f};
    bf16x8 At[4][2], B0[2][2], B1[2][2];
    const char* cA = (const char*)g.A + (size_t)cur.pm * tstep; const char* cB = (const char*)g.Bt + (size_t)cur.pn * tstep;
    S.a_ready(cur);
    if constexpr (SP2) {
        PG8_STAGE(PG8_SB(0, 0), cB, voffB); PG8_STAGE(PG8_SB(0, 1), cB + hstep, voffB); PG8_STAGE(PG8_SA(0, 0), cA, voffA); PG8_STAGE(PG8_SA(0, 1), cA + hstep, voffA);
        if (wr == 1) PG8_BAR;
        PG8_WAIT_V(2); PG8_BAR;
        PG8_STAGE(PG8_SB(1, 0), cB + kstep, voffB); PG8_STAGE(PG8_SA(1, 0), cA + kstep, voffA); PG8_STAGE(PG8_SB(1, 1), cB + hstep + kstep, voffB);
        PG8_WAIT_V(6); PG8_BAR;
    } else {
        PG8_STAGE(PG8_SB(0, 0), cB, voffB); PG8_STAGE(PG8_SA(0, 0), cA, voffA); PG8_STAGE(PG8_SB(0, 1), cB + hstep, voffB); PG8_STAGE(PG8_SA(0, 1), cA + hstep, voffA);
        if (wr == 1) PG8_BAR;
        PG8_WAIT_V(4); PG8_BAR;
        PG8_STAGE(PG8_SB(1, 0), cB + kstep, voffB); PG8_STAGE(PG8_SA(1, 0), cA + kstep, voffA); PG8_STAGE(PG8_SB(1, 1), cB + hstep + kstep, voffB);
        PG8_WAIT_V(6); PG8_BAR;
    }
    for (;;) {
        const bool has_next = S.next(ui + 1, nxt);
        const char* nA = has_next ? (const char*)g.A + (size_t)nxt.pm * tstep : cA; const char* nB = has_next ? (const char*)g.Bt + (size_t)nxt.pn * tstep : cB;
        for (int t = 0; t < nt; t += 2) {
            const bool last = (t == nt - 2);
            const char* a1 = cA + (size_t)(t + 1) * kstep;
            const char* a2 = last ? nA : cA + (size_t)(t + 2) * kstep; const char* b2 = last ? nB : cB + (size_t)(t + 2) * kstep;
            const char* a3 = a2 + kstep; const char* b3 = b2 + kstep;
            if (last && has_next) S.a_ready(nxt);
            if constexpr (SP2) {
            PG8_LDB(B0, 0, 0); PG8_LDB(B1, 0, 1); PG8_SCHED; PG8_LDA(At, 0, 0); PG8_STAGE(PG8_SA(1, 1), a1 + hstep, voffA);
            PG8_WAIT_V(8); PG8_WAIT_L(0); PG8_BAR; PG8_MMA(0, 0, At, B0); PG8_MMA(0, 1, At, B1); PG8_BAR; PG8_SCHED;
            PG8_LDA(At, 0, 1); PG8_STAGE(PG8_SB(0, 0), b2, voffB); PG8_STAGE(PG8_SB(0, 1), b2 + hstep, voffB); PG8_STAGE(PG8_SA(0, 0), a2, voffA);
            PG8_WAIT_V(8); PG8_WAIT_L(0); PG8_BAR; PG8_MMA(1, 0, At, B0); PG8_MMA(1, 1, At, B1); PG8_BAR; PG8_SCHED;
            PG8_LDB(B0, 1, 0); PG8_LDB(B1, 1, 1); PG8_SCHED; PG8_LDA(At, 1, 0); PG8_STAGE(PG8_SA(0, 1), a2 + hstep, voffA);
            PG8_WAIT_V(8); PG8_WAIT_L(0); PG8_BAR; PG8_MMA(0, 0, At, B0); PG8_MMA(0, 1, At, B1); PG8_BAR; PG8_SCHED;
            PG8_LDA(At, 1, 1); PG8_STAGE(PG8_SB(1, 0), b3, voffB); PG8_STAGE(PG8_SB(1, 1), b3 + hstep, voffB); PG8_STAGE(PG8_SA(1, 0), a3, voffA);
            PG8_WAIT_V(8); PG8_WAIT_L(0); PG8_BAR; PG8_MMA(1, 0, At, B0); PG8_MMA(1, 1, At, B1); PG8_BAR; PG8_SCHED;
            } else {
            PG8_LDB(B0, 0, 0); PG8_SCHED; PG8_LDA(At, 0, 0); PG8_STAGE(PG8_SA(1, 1), a1 + hstep, voffA);
            PG8_WAIT_L(8); PG8_BAR; PG8_WAIT_L(0); PG8_MMA(0, 0, At, B0); PG8_BAR; PG8_SCHED;
            PG8_LDB(B1, 0, 1); PG8_STAGE(PG8_SB(0, 0), b2, voffB);
            PG8_BAR; PG8_WAIT_L(0); PG8_MMA(0, 1, At, B1); PG8_BAR;
            PG8_LDA(At, 0, 1); PG8_STAGE(PG8_SA(0, 0), a2, voffA);
            PG8_BAR; PG8_WAIT_L(0); PG8_MMA(1, 0, At, B0); PG8_BAR; PG8_SCHED;
            PG8_STAGE(PG8_SB(0, 1), b2 + hstep, voffB);
            PG8_WAIT_V(6); PG8_BAR; PG8_MMA(1, 1, At, B1); PG8_BAR;
            PG8_LDB(B0, 1, 0); PG8_SCHED; PG8_LDA(At, 1, 0); PG8_STAGE(PG8_SA(0, 1), a2 + hstep, voffA);
            PG8_WAIT_L(8); PG8_BAR; PG8_WAIT_L(0); PG8_MMA(0, 0, At, B0); PG8_BAR; PG8_SCHED;
            PG8_LDB(B1, 1, 1); PG8_STAGE(PG8_SB(1, 0), b3, voffB);
            PG8_BAR; PG8_WAIT_L(0); PG8_MMA(0, 1, At, B1); PG8_BAR;
            PG8_LDA(At, 1, 1); PG8_STAGE(PG8_SA(1, 0), a3, voffA);
            PG8_BAR; PG8_WAIT_L(0); PG8_MMA(1, 0, At, B0); PG8_BAR; PG8_SCHED;
            PG8_STAGE(PG8_SB(1, 1), b3 + hstep, voffB);
            PG8_WAIT_V(6); PG8_BAR; PG8_MMA(1, 1, At, B1); PG8_BAR;
            }
        }
        if constexpr (ALIGN_EPI) { if (wr == 0) PG8_BAR; }
        asm volatile("s_nop 15\n\ts_nop 15" ::: "memory");
        if constexpr (!Epi::AFTER_DRAIN) { E(acc, cur, wr, wc, fr, fq); S.done(cur); }
        if (!has_next) break;
#pragma unroll
        for (int a = 0; a < 2; ++a)
#pragma unroll
            for (int b = 0; b < 2; ++b)
#pragma unroll
                for (int m = 0; m < 4; ++m)
#pragma unroll
                    for (int n = 0; n < 2; ++n) acc[a][b][m][n] = (f32x4){0.f, 0.f, 0.f, 0.f};
        cur = nxt; cA = nA; cB = nB; ++ui;
        if constexpr (ALIGN_EPI) { if (wr == 1) PG8_BAR; }
    }
    PG8_WAIT_V(0);
    if constexpr (!ALIGN_EPI) { if (wr == 0) PG8_BAR; }
    PG8_BAR;
    if constexpr (Epi::AFTER_DRAIN) { E.fused(acc, cur, wr, wc, fr, fq, lds, wid, lane); S.done(cur); }
#undef PG8_SA
#undef PG8_SB
#undef PG8_STAGE
#undef PG8_LDA
#undef PG8_LDB
#undef PG8_MMA
#undef PG8_WAIT_V
#undef PG8_WAIT_L
#undef PG8_BAR
#undef PG8_SCHED
}

typedef int v8i __attribute__((ext_vector_type(8)));
typedef int v4i __attribute__((ext_vector_type(4)));
__host__ __device__ __forceinline__ int lds_byte8(int r, int c) { const int st = (r >> 4) * 2 + (c >> 5), rr = r & 15, cc = c & 31, ob = rr * 64 + cc * 2; return st * 1024 + (ob ^ (((ob >> 9) & 1) << 4)); }
__host__ __device__ __forceinline__ void stage_rc8(int b, int& R, int& C) { const int st = b / 1024, sb = b % 1024, swz = sb ^ (((sb >> 9) & 1) << 4); R = (st >> 1) * 16 + swz / 64; C = (st & 1) * 32 + (swz % 64) / 2; }
template <class Epi, class Sched, bool ALIGN_EPI, bool SP2, int SCA  , int SCB  >
__device__ __forceinline__ void gemm_phase_f8(PG8_LAS unsigned char* lds, const Gemm g, const Sched& S, const Epi& E, const int tid) {
    const int wid = __builtin_amdgcn_readfirstlane(tid >> 6), lane = tid & 63, wr = wid >> 2, wc = wid & 3, fr = lane & 15, fq = lane >> 4;
    const int K = g.K, nt = K / BK;
    unsigned voffA[2], voffB[2];
#pragma unroll
    for (int i = 0; i < 2; ++i) { int R, C; stage_rc8(tid * 16 + i * 8192, R, C); const int Rb = Epi::PERM ? ((R & ~31) + perm32(R & 31)) : R;
        voffA[i] = (unsigned)(R * K + C) * 2u; voffB[i] = (unsigned)(Rb * K + C) * 2u; }
    const size_t kstep = (size_t)(BK * 2);
    const size_t hstep = (size_t)HALF * K * 2;
    const size_t tstep = 2 * hstep;
    const unsigned ldsw = (unsigned)wid * 1024u;
    const int aoff = lds_byte8(wr * 64 + fr, fq * 16), boff = lds_byte8(wc * 32 + fr, fq * 16);
#define PG8_SA(b, h) (((b) * 2 + (h)) * HTB)
#define PG8_SB(b, h) ((4 + (b) * 2 + (h)) * HTB)
#define PG8_STAGE(bufoff, gbase, voff) do { _Pragma("unroll") for (int _i = 0; _i < 2; ++_i) \
        __builtin_amdgcn_global_load_lds((const unsigned*)((const char*)(gbase) + (voff)[_i]), (PG8_LAS unsigned*)(lds + (bufoff) + ldsw + _i * 8192), 16, 0, 0); } while (0)
#define PG8_LDA(dst, b, h) do { _Pragma("unroll") for (int m = 0; m < 4; ++m) { const u32x4 lo_ = *(const PG8_LAS u32x4*)(lds + PG8_SA(b, h) + aoff + m * 2048), hi_ = *(const PG8_LAS u32x4*)(lds + PG8_SA(b, h) + (aoff ^ 16) + m * 2048); \
        dst[m] = __builtin_shufflevector(__builtin_bit_cast(v4i, lo_), __builtin_bit_cast(v4i, hi_), 0, 1, 2, 3, 4, 5, 6, 7); } } while (0)
#define PG8_LDB(dst, b, h) do { _Pragma("unroll") for (int n = 0; n < 2; ++n) { const u32x4 lo_ = *(const PG8_LAS u32x4*)(lds + PG8_SB(b, h) + boff + n * 2048), hi_ = *(const PG8_LAS u32x4*)(lds + PG8_SB(b, h) + (boff ^ 16) + n * 2048); \
        dst[n] = __builtin_shufflevector(__builtin_bit_cast(v4i, lo_), __builtin_bit_cast(v4i, hi_), 0, 1, 2, 3, 4, 5, 6, 7); } } while (0)
#define PG8_MMA(ai, bj, At, Bt) do { __builtin_amdgcn_s_setprio(1); _Pragma("unroll") for (int m = 0; m < 4; ++m) _Pragma("unroll") for (int n = 0; n < 2; ++n) \
        asm volatile("v_mfma_scale_f32_16x16x128_f8f6f4 %0, %1, %2, %0, %3, %4 op_sel_hi:[0,0,0]" : "+v"(acc[ai][bj][m][n]) : "v"(Bt[n]), "v"(At[m]), "v"(scb_), "v"(sca_)); __builtin_amdgcn_s_setprio(0); } while (0)
#define PG8_WAIT_V(n) asm volatile("s_waitcnt vmcnt(" #n ")" ::: "memory")
#define PG8_WAIT_L(n) asm volatile("s_waitcnt lgkmcnt(" #n ")" ::: "memory")
#define PG8_BAR __builtin_amdgcn_s_barrier()
#define PG8_SCHED __builtin_amdgcn_sched_barrier(0)
    Unit cur, nxt; int ui = 0;
    if (!S.next(0, cur)) return;
    f32x4 acc[2][2][4][2];
#pragma unroll
    for (int a = 0; a < 2; ++a)
#pragma unroll
        for (int b = 0; b < 2; ++b)
#pragma unroll
            for (int m = 0; m < 4; ++m)
#pragma unroll
                for (int n = 0; n < 2; ++n) acc[a][b][m][n] = (f32x4){0.f, 0.f, 0.f, 0.f};
    v8i At[4], B0[2], B1[2]; const int scb_ = SCB, sca_ = SCA;
    const char* cA = (const char*)g.A + (size_t)cur.pm * tstep; const char* cB = (const char*)g.Bt + (size_t)cur.pn * tstep;
    S.a_ready(cur);
    if constexpr (SP2) {
        PG8_STAGE(PG8_SB(0, 0), cB, voffB); PG8_STAGE(PG8_SB(0, 1), cB + hstep, voffB); PG8_STAGE(PG8_SA(0, 0), cA, voffA); PG8_STAGE(PG8_SA(0, 1), cA + hstep, voffA);
        if (wr == 1) PG8_BAR;
        PG8_WAIT_V(2); PG8_BAR;
        PG8_STAGE(PG8_SB(1, 0), cB + kstep, voffB); PG8_STAGE(PG8_SA(1, 0), cA + kstep, voffA); PG8_STAGE(PG8_SB(1, 1), cB + hstep + kstep, voffB);
        PG8_WAIT_V(6); PG8_BAR;
    } else {
        PG8_STAGE(PG8_SB(0, 0), cB, voffB); PG8_STAGE(PG8_SA(0, 0), cA, voffA); PG8_STAGE(PG8_SB(0, 1), cB + hstep, voffB); PG8_STAGE(PG8_SA(0, 1), cA + hstep, voffA);
        if (wr == 1) PG8_BAR;
        PG8_WAIT_V(4); PG8_BAR;
        PG8_STAGE(PG8_SB(1, 0), cB + kstep, voffB); PG8_STAGE(PG8_SA(1, 0), cA + kstep, voffA); PG8_STAGE(PG8_SB(1, 1), cB + hstep + kstep, voffB);
        PG8_WAIT_V(6); PG8_BAR;
    }
    for (;;) {
        const bool has_next = S.next(ui + 1, nxt);
        const char* nA = has_next ? (const char*)g.A + (size_t)nxt.pm * tstep : cA; const char* nB = has_next ? (const char*)g.Bt + (size_t)nxt.pn * tstep : cB;
        for (int t = 0; t < nt; t += 2) {
            const bool last = (t == nt - 2);
            const char* a1 = cA + (size_t)(t + 1) * kstep;
            const char* a2 = last ? nA : cA + (size_t)(t + 2) * kstep; const char* b2 = last ? nB : cB + (size_t)(t + 2) * kstep;
            const char* a3 = a2 + kstep; const char* b3 = b2 + kstep;
            if (last && has_next) S.a_ready(nxt);
            if constexpr (SP2) {
            PG8_LDB(B0, 0, 0); PG8_LDB(B1, 0, 1); PG8_SCHED; PG8_LDA(At, 0, 0); PG8_STAGE(PG8_SA(1, 1), a1 + hstep, voffA);
            PG8_WAIT_V(8); PG8_WAIT_L(0); PG8_BAR; PG8_MMA(0, 0, At, B0); PG8_MMA(0, 1, At, B1); PG8_BAR; PG8_SCHED;
            PG8_LDA(At, 0, 1); PG8_STAGE(PG8_SB(0, 0), b2, voffB); PG8_STAGE(PG8_SB(0, 1), b2 + hstep, voffB); PG8_STAGE(PG8_SA(0, 0), a2, voffA);
            PG8_WAIT_V(8); PG8_WAIT_L(0); PG8_BAR; PG8_MMA(1, 0, At, B0); PG8_MMA(1, 1, At, B1); PG8_BAR; PG8_SCHED;
            PG8_LDB(B0, 1, 0); PG8_LDB(B1, 1, 1); PG8_SCHED; PG8_LDA(At, 1, 0); PG8_STAGE(PG8_SA(0, 1), a2 + hstep, voffA);
            PG8_WAIT_V(8); PG8_WAIT_L(0); PG8_BAR; PG8_MMA(0, 0, At, B0); PG8_MMA(0, 1, At, B1); PG8_BAR; PG8_SCHED;
            PG8_LDA(At, 1, 1); PG8_STAGE(PG8_SB(1, 0), b3, voffB); PG8_STAGE(PG8_SB(1, 1), b3 + hstep, voffB); PG8_STAGE(PG8_SA(1, 0), a3, voffA);
            PG8_WAIT_V(8); PG8_WAIT_L(0); PG8_BAR; PG8_MMA(1, 0, At, B0); PG8_MMA(1, 1, At, B1); PG8_BAR; PG8_SCHED;
            } else {
            PG8_LDB(B0, 0, 0); PG8_SCHED; PG8_LDA(At, 0, 0); PG8_STAGE(PG8_SA(1, 1), a1 + hstep, voffA);
            PG8_WAIT_L(8); PG8_BAR; PG8_WAIT_L(0); PG8_MMA(0, 0, At, B0); PG8_BAR; PG8_SCHED;
            PG8_LDB(B1, 0, 1); PG8_STAGE(PG8_SB(0, 0), b2, voffB);
            PG8_BAR; PG8_WAIT_L(0); PG8_MMA(0, 1, At, B1); PG8_BAR;
            PG8_LDA(At, 0, 1); PG8_STAGE(PG8_SA(0, 0), a2, voffA);
            PG8_BAR; PG8_WAIT_L(0); PG8_MMA(1, 0, At, B0); PG8_BAR; PG8_SCHED;
            PG8_STAGE(PG8_SB(0, 1), b2 + hstep, voffB);
            PG8_WAIT_V(6); PG8_BAR; PG8_MMA(1, 1, At, B1); PG8_BAR;
            PG8_LDB(B0, 1, 0); PG8_SCHED; PG8_LDA(At, 1, 0); PG8_STAGE(PG8_SA(0, 1), a2 + hstep, voffA);
            PG8_WAIT_L(8); PG8_BAR; PG8_WAIT_L(0); PG8_MMA(0, 0, At, B0); PG8_BAR; PG8_SCHED;
            PG8_LDB(B1, 1, 1); PG8_STAGE(PG8_SB(1, 0), b3, voffB);
            PG8_BAR; PG8_WAIT_L(0); PG8_MMA(0, 1, At, B1); PG8_BAR;
            PG8_LDA(At, 1, 1); PG8_STAGE(PG8_SA(1, 0), a3, voffA);
            PG8_BAR; PG8_WAIT_L(0); PG8_MMA(1, 0, At, B0); PG8_BAR; PG8_SCHED;
            PG8_STAGE(PG8_SB(1, 1), b3 + hstep, voffB);
            PG8_WAIT_V(6); PG8_BAR; PG8_MMA(1, 1, At, B1); PG8_BAR;
            }
        }
        if constexpr (ALIGN_EPI) { if (wr == 0) PG8_BAR; }
        asm volatile("s_nop 15\n\ts_nop 15" ::: "memory");
        if constexpr (!Epi::AFTER_DRAIN) { E(acc, cur, wr, wc, fr, fq); S.done(cur); }
        if (!has_next) break;
#pragma unroll
        for (int a = 0; a < 2; ++a)
#pragma unroll
            for (int b = 0; b < 2; ++b)
#pragma unroll
                for (int m = 0; m < 4; ++m)
#pragma unroll
                    for (int n = 0; n < 2; ++n) acc[a][b][m][n] = (f32x4){0.f, 0.f, 0.f, 0.f};
        cur = nxt; cA = nA; cB = nB; ++ui;
        if constexpr (ALIGN_EPI) { if (wr == 1) PG8_BAR; }
    }
    PG8_WAIT_V(0);
    if constexpr (!ALIGN_EPI) { if (wr == 0) PG8_BAR; }
    PG8_BAR;
    if constexpr (Epi::AFTER_DRAIN) { E.fused(acc, cur, wr, wc, fr, fq, lds, wid, lane); S.done(cur); }
#undef PG8_SA
#undef PG8_SB
#undef PG8_STAGE
#undef PG8_LDA
#undef PG8_LDB
#undef PG8_MMA
#undef PG8_WAIT_V
#undef PG8_WAIT_L
#undef PG8_BAR
#undef PG8_SCHED
}


template <class Epi, class Sched, bool ALIGN_EPI, bool SP2, int SCA  , int SCB  >
__device__ __forceinline__ void gemm_phase_f8g(PG8_LAS unsigned char* lds, const Gemm g, const Sched& S, const Epi& E, const int tid, const int* rowtab) {
    const int wid = __builtin_amdgcn_readfirstlane(tid >> 6), lane = tid & 63, wr = wid >> 2, wc = wid & 3, fr = lane & 15, fq = lane >> 4;
    const int K = g.K, nt = K / BK;
    unsigned voffA[2], voffB[2]; int gR0 = 0; unsigned gCb = 0;
#pragma unroll
    for (int i = 0; i < 2; ++i) { int R, C; stage_rc8(tid * 16 + i * 8192, R, C); const int Rb = Epi::PERM ? ((R & ~31) + perm32(R & 31)) : R;
        voffA[i] = (unsigned)(R * K + C) * 2u; voffB[i] = (unsigned)(Rb * K + C) * 2u; if (i == 0) { gR0 = R; gCb = (unsigned)C * 2u; } }
    const size_t kstep = (size_t)(BK * 2);
    const size_t hstep = (size_t)HALF * K * 2;
    const size_t tstep = 2 * hstep;
    const unsigned ldsw = (unsigned)wid * 1024u;
    const int aoff = lds_byte8(wr * 64 + fr, fq * 16), boff = lds_byte8(wc * 32 + fr, fq * 16);
#define PG8_SA(b, h) (((b) * 2 + (h)) * HTB)
#define PG8_SB(b, h) ((4 + (b) * 2 + (h)) * HTB)
#define PG8_STAGE(bufoff, gbase, voff) do { _Pragma("unroll") for (int _i = 0; _i < 2; ++_i) \
        __builtin_amdgcn_global_load_lds((const unsigned*)((const char*)(gbase) + (voff)[_i]), (PG8_LAS unsigned*)(lds + (bufoff) + ldsw + _i * 8192), 16, 0, 0); } while (0)
#define PG8_STAGE_G(bufoff, o0, o1, kb) do { __builtin_amdgcn_global_load_lds((const unsigned*)((const char*)g.A + (o0) + (kb)), (PG8_LAS unsigned*)(lds + (bufoff) + ldsw), 16, 0, 0); \
        __builtin_amdgcn_global_load_lds((const unsigned*)((const char*)g.A + (o1) + (kb)), (PG8_LAS unsigned*)(lds + (bufoff) + ldsw + 8192), 16, 0, 0); } while (0)
#define PG8_ROWOFF(dst, pm_) do { const int* rt_ = rowtab + (pm_) * 256 + gR0; const unsigned kb_ = 2u * (unsigned)K; \
        dst[0][0] = (unsigned)rt_[0] * kb_ + gCb; dst[0][1] = (unsigned)rt_[64] * kb_ + gCb; dst[1][0] = (unsigned)rt_[128] * kb_ + gCb; dst[1][1] = (unsigned)rt_[192] * kb_ + gCb; } while (0)
#define PG8_LDA(dst, b, h) do { _Pragma("unroll") for (int m = 0; m < 4; ++m) { const u32x4 lo_ = *(const PG8_LAS u32x4*)(lds + PG8_SA(b, h) + aoff + m * 2048), hi_ = *(const PG8_LAS u32x4*)(lds + PG8_SA(b, h) + (aoff ^ 16) + m * 2048); \
        dst[m] = __builtin_shufflevector(__builtin_bit_cast(v4i, lo_), __builtin_bit_cast(v4i, hi_), 0, 1, 2, 3, 4, 5, 6, 7); } } while (0)
#define PG8_LDB(dst, b, h) do { _Pragma("unroll") for (int n = 0; n < 2; ++n) { const u32x4 lo_ = *(const PG8_LAS u32x4*)(lds + PG8_SB(b, h) + boff + n * 2048), hi_ = *(const PG8_LAS u32x4*)(lds + PG8_SB(b, h) + (boff ^ 16) + n * 2048); \
        dst[n] = __builtin_shufflevector(__builtin_bit_cast(v4i, lo_), __builtin_bit_cast(v4i, hi_), 0, 1, 2, 3, 4, 5, 6, 7); } } while (0)
#define PG8_MMA(ai, bj, At, Bt) do { __builtin_amdgcn_s_setprio(1); _Pragma("unroll") for (int m = 0; m < 4; ++m) _Pragma("unroll") for (int n = 0; n < 2; ++n) \
        asm volatile("v_mfma_scale_f32_16x16x128_f8f6f4 %0, %1, %2, %0, %3, %4 op_sel_hi:[0,0,0]" : "+v"(acc[ai][bj][m][n]) : "v"(Bt[n]), "v"(At[m]), "v"(scb_), "v"(sca_)); __builtin_amdgcn_s_setprio(0); } while (0)
#define PG8_WAIT_V(n) asm volatile("s_waitcnt vmcnt(" #n ")" ::: "memory")
#define PG8_WAIT_L(n) asm volatile("s_waitcnt lgkmcnt(" #n ")" ::: "memory")
#define PG8_BAR __builtin_amdgcn_s_barrier()
#define PG8_SCHED __builtin_amdgcn_sched_barrier(0)
    Unit cur, nxt; int ui = 0;
    if (!S.next(0, cur)) return;
    f32x4 acc[2][2][4][2];
#pragma unroll
    for (int a = 0; a < 2; ++a)
#pragma unroll
        for (int b = 0; b < 2; ++b)
#pragma unroll
            for (int m = 0; m < 4; ++m)
#pragma unroll
                for (int n = 0; n < 2; ++n) acc[a][b][m][n] = (f32x4){0.f, 0.f, 0.f, 0.f};
    v8i At[4], B0[2], B1[2]; const int scb_ = SCB, sca_ = SCA;
    const char* cA = (const char*)g.A + (size_t)cur.pm * tstep; const char* cB = (const char*)g.Bt + (size_t)cur.pn * tstep;
    S.a_ready(cur);
    unsigned co[2][2], no[2][2]; PG8_ROWOFF(co, cur.pm);
    if constexpr (SP2) {
        PG8_STAGE(PG8_SB(0, 0), cB, voffB); PG8_STAGE(PG8_SB(0, 1), cB + hstep, voffB); PG8_STAGE_G(PG8_SA(0, 0), co[0][0], co[0][1], 0); PG8_STAGE_G(PG8_SA(0, 1), co[1][0], co[1][1], 0);
        if (wr == 1) PG8_BAR;
        PG8_WAIT_V(2); PG8_BAR;
        PG8_STAGE(PG8_SB(1, 0), cB + kstep, voffB); PG8_STAGE_G(PG8_SA(1, 0), co[0][0], co[0][1], kstep); PG8_STAGE(PG8_SB(1, 1), cB + hstep + kstep, voffB);
        PG8_WAIT_V(6); PG8_BAR;
    } else {
        PG8_STAGE(PG8_SB(0, 0), cB, voffB); PG8_STAGE(PG8_SA(0, 0), cA, voffA); PG8_STAGE(PG8_SB(0, 1), cB + hstep, voffB); PG8_STAGE(PG8_SA(0, 1), cA + hstep, voffA);
        if (wr == 1) PG8_BAR;
        PG8_WAIT_V(4); PG8_BAR;
        PG8_STAGE(PG8_SB(1, 0), cB + kstep, voffB); PG8_STAGE(PG8_SA(1, 0), cA + kstep, voffA); PG8_STAGE(PG8_SB(1, 1), cB + hstep + kstep, voffB);
        PG8_WAIT_V(6); PG8_BAR;
    }
    for (;;) {
        const bool has_next = S.next(ui + 1, nxt);
        const char* nA = cA; const char* nB = has_next ? (const char*)g.Bt + (size_t)nxt.pn * tstep : cB;
        if (has_next) PG8_ROWOFF(no, nxt.pm); else { no[0][0] = co[0][0]; no[0][1] = co[0][1]; no[1][0] = co[1][0]; no[1][1] = co[1][1]; }
        for (int t = 0; t < nt; t += 2) {
            const bool last = (t == nt - 2);
            const char* a1 = cA + (size_t)(t + 1) * kstep;
            const char* a2 = last ? nA : cA + (size_t)(t + 2) * kstep; const char* b2 = last ? nB : cB + (size_t)(t + 2) * kstep;
            const char* a3 = a2 + kstep; const char* b3 = b2 + kstep;
            if (last && has_next) S.a_ready(nxt);
            const unsigned s00 = last ? no[0][0] : co[0][0], s01 = last ? no[0][1] : co[0][1], s10 = last ? no[1][0] : co[1][0], s11 = last ? no[1][1] : co[1][1];
            const size_t k1 = (size_t)(t + 1) * kstep, k2 = last ? (size_t)0 : (size_t)(t + 2) * kstep;
            if constexpr (SP2) {
            PG8_LDB(B0, 0, 0); PG8_LDB(B1, 0, 1); PG8_SCHED; PG8_LDA(At, 0, 0); PG8_STAGE_G(PG8_SA(1, 1), co[1][0], co[1][1], k1);
            PG8_WAIT_V(8); PG8_WAIT_L(0); PG8_BAR; PG8_MMA(0, 0, At, B0); PG8_MMA(0, 1, At, B1); PG8_BAR; PG8_SCHED;
            PG8_LDA(At, 0, 1); PG8_STAGE(PG8_SB(0, 0), b2, voffB); PG8_STAGE(PG8_SB(0, 1), b2 + hstep, voffB); PG8_STAGE_G(PG8_SA(0, 0), s00, s01, k2);
            PG8_WAIT_V(8); PG8_WAIT_L(0); PG8_BAR; PG8_MMA(1, 0, At, B0); PG8_MMA(1, 1, At, B1); PG8_BAR; PG8_SCHED;
            PG8_LDB(B0, 1, 0); PG8_LDB(B1, 1, 1); PG8_SCHED; PG8_LDA(At, 1, 0); PG8_STAGE_G(PG8_SA(0, 1), s10, s11, k2);
            PG8_WAIT_V(8); PG8_WAIT_L(0); PG8_BAR; PG8_MMA(0, 0, At, B0); PG8_MMA(0, 1, At, B1); PG8_BAR; PG8_SCHED;
            PG8_LDA(At, 1, 1); PG8_STAGE(PG8_SB(1, 0), b3, voffB); PG8_STAGE(PG8_SB(1, 1), b3 + hstep, voffB); PG8_STAGE_G(PG8_SA(1, 0), s00, s01, k2 + kstep);
            PG8_WAIT_V(8); PG8_WAIT_L(0); PG8_BAR; PG8_MMA(1, 0, At, B0); PG8_MMA(1, 1, At, B1); PG8_BAR; PG8_SCHED;
            } else {
            PG8_LDB(B0, 0, 0); PG8_SCHED; PG8_LDA(At, 0, 0); PG8_STAGE(PG8_SA(1, 1), a1 + hstep, voffA);
            PG8_WAIT_L(8); PG8_BAR; PG8_WAIT_L(0); PG8_MMA(0, 0, At, B0); PG8_BAR; PG8_SCHED;
            PG8_LDB(B1, 0, 1); PG8_STAGE(PG8_SB(0, 0), b2, voffB);
            PG8_BAR; PG8_WAIT_L(0); PG8_MMA(0, 1, At, B1); PG8_BAR;
            PG8_LDA(At, 0, 1); PG8_STAGE(PG8_SA(0, 0), a2, voffA);
            PG8_BAR; PG8_WAIT_L(0); PG8_MMA(1, 0, At, B0); PG8_BAR; PG8_SCHED;
            PG8_STAGE(PG8_SB(0, 1), b2 + hstep, voffB);
            PG8_WAIT_V(6); PG8_BAR; PG8_MMA(1, 1, At, B1); PG8_BAR;
            PG8_LDB(B0, 1, 0); PG8_SCHED; PG8_LDA(At, 1, 0); PG8_STAGE(PG8_SA(0, 1), a2 + hstep, voffA);
            PG8_WAIT_L(8); PG8_BAR; PG8_WAIT_L(0); PG8_MMA(0, 0, At, B0); PG8_BAR; PG8_SCHED;
            PG8_LDB(B1, 1, 1); PG8_STAGE(PG8_SB(1, 0), b3, voffB);
            PG8_BAR; PG8_WAIT_L(0); PG8_MMA(0, 1, At, B1); PG8_BAR;
            PG8_LDA(At, 1, 1); PG8_STAGE(PG8_SA(1, 0), a3, voffA);
            PG8_BAR; PG8_WAIT_L(0); PG8_MMA(1, 0, At, B0); PG8_BAR; PG8_SCHED;
            PG8_STAGE(PG8_SB(1, 1), b3 + hstep, voffB);
            PG8_WAIT_V(6); PG8_BAR; PG8_MMA(1, 1, At, B1); PG8_BAR;
            }
        }
        if constexpr (ALIGN_EPI) { if (wr == 0) PG8_BAR; }
        asm volatile("s_nop 15\n\ts_nop 15" ::: "memory");
        if constexpr (!Epi::AFTER_DRAIN) { E(acc, cur, wr, wc, fr, fq); S.done(cur); }
        if (!has_next) break;
#pragma unroll
        for (int a = 0; a < 2; ++a)
#pragma unroll
            for (int b = 0; b < 2; ++b)
#pragma unroll
                for (int m = 0; m < 4; ++m)
#pragma unroll
                    for (int n = 0; n < 2; ++n) acc[a][b][m][n] = (f32x4){0.f, 0.f, 0.f, 0.f};
        cur = nxt; cA = nA; cB = nB; ++ui; co[0][0] = no[0][0]; co[0][1] = no[0][1]; co[1][0] = no[1][0]; co[1][1] = no[1][1];
        if constexpr (ALIGN_EPI) { if (wr == 1) PG8_BAR; }
    }
    PG8_WAIT_V(0);
    if constexpr (!ALIGN_EPI) { if (wr == 0) PG8_BAR; }
    PG8_BAR;
    if constexpr (Epi::AFTER_DRAIN) { E.fused(acc, cur, wr, wc, fr, fq, lds, wid, lane); S.done(cur); }
#undef PG8_SA
#undef PG8_SB
#undef PG8_STAGE
#undef PG8_STAGE_G
#undef PG8_ROWOFF
#undef PG8_LDA
#undef PG8_LDB
#undef PG8_MMA
#undef PG8_WAIT_V
#undef PG8_WAIT_L
#undef PG8_BAR
#undef PG8_SCHED
}


}

#ifndef ATTN_NAIVE
#define ATTN_NAIVE 0
#endif
#ifndef REP_MASK
#define REP_MASK 0
#endif
#define REPEAT(j) for (int rep_ = 0; rep_ < ((REP_MASK >> (j)) & 1) + 1; ++rep_)
#ifndef MLSTM_NAIVE
#define MLSTM_NAIVE 0
#endif
constexpr int D = 1024, BATCH = 8, SEQ = 4096, DEPTH = 4, NTOK = BATCH * SEQ, NMEM = 256, NE = 16, CAP = 512, DFF = 2048, NSLOT = BATCH * NE * CAP;
constexpr int DIN = 2576, NPROJ = 2560;
constexpr int C_MQ = 0, C_MK = 256, C_MV = 512, C_MO = 1024, C_NQ = 1536, C_NK = 1792, C_NV = 2048, C_CQ = 2304;
constexpr int GATE_COL = 1536;
constexpr float EPS = 1e-6f;
constexpr int NPHASE = 2 + 11 * DEPTH + 1;

constexpr int LDS_BYTES = 147456;
constexpr int LDS_SCR = 256;

#define LAS __attribute__((address_space(3)))
typedef pg8::bf16_t bf16_t;
typedef pg8::f32x4 f32x4;
typedef pg8::u32x4 u32x4;
typedef unsigned u32x2 __attribute__((ext_vector_type(2)));
typedef float f32x2 __attribute__((ext_vector_type(2)));
#define LDS_WAIT() asm volatile("s_waitcnt lgkmcnt(0)" ::: "memory")
#ifndef Y8_FROM
#define Y8_FROM 1
#endif
#define GAS __attribute__((address_space(1)))
#define LAUNDER_V(x) asm volatile("" : "+v"(x))
#define LAUNDER_S(x) asm volatile("" : "+s"(x))
__device__ __forceinline__ int fresh_tid(int wave0) { int t_; asm volatile("v_mbcnt_lo_u32_b32 %0, -1, 0\n\tv_mbcnt_hi_u32_b32 %0, -1, %0" : "=v"(t_)); return (wave0 << 6) | t_; }
#define FRESH_TID() fresh_tid(wave0)
__device__ __forceinline__ float bflo(unsigned w) { return __uint_as_float(w << 16); }
__device__ __forceinline__ float bfhi(unsigned w) { return __uint_as_float(w & 0xffff0000u); }
__device__ __forceinline__ float bf1(bf16_t h) { return __uint_as_float(((unsigned)h) << 16); }
__device__ __forceinline__ unsigned pk2(float lo, float hi) { return pg8::cvt_pk_bf16(lo, hi); }
__device__ __forceinline__ unsigned f2bf_c(float f) { const unsigned u = __float_as_uint(f); return (u + 0x7fffu + ((u >> 16) & 1u)) >> 16; }
__device__ __forceinline__ unsigned pk2c(float lo, float hi) { return f2bf_c(lo) | (f2bf_c(hi) << 16); }
__device__ __forceinline__ float wave_sum(float v, int lane) {
#pragma unroll
    for (int o = 1; o < 64; o <<= 1) v += shx(v, o, lane);
    return v;
}
#define DPPF(v, ctrl) __int_as_float(__builtin_amdgcn_update_dpp(0, __float_as_int(v), (ctrl), 0xF, 0xF, true))
__device__ __forceinline__ float row_sum16(float v) { v += DPPF(v, 0xB1); v += DPPF(v, 0x4E); v += DPPF(v, 0x141); v += DPPF(v, 0x140); return v; }
__device__ __forceinline__ float row_max16(float v) { v = fmaxf(v, DPPF(v, 0xB1)); v = fmaxf(v, DPPF(v, 0x4E)); v = fmaxf(v, DPPF(v, 0x141)); v = fmaxf(v, DPPF(v, 0x140)); return v; }
__device__ __forceinline__ float wave_sum_fast(float v) { return rows_sum4(row_sum16(v)); }
#define SWZF(v, pat) __int_as_float(__builtin_amdgcn_ds_swizzle(__float_as_int(v), (pat)))
__device__ __forceinline__ float sigmoidf_(float x) { return __builtin_amdgcn_rcpf(1.0f + __expf(-x)); }

#define XB_TMO      128
#define XB_XCNT(j)  (256  + 64 * (j))
#define XB_XSUB(j)  (1280 + 64 * (j))
#define XB_XGEN(j)  (2304 + 64 * (j))
#define XB_TOP      3328
#define XB_TOPGEN   3392
#define XCD_BAR_WORDS 3456
#define XB_SPIN_CAP (1u << 18)
__device__ __forceinline__ unsigned xb_ld(unsigned* p)              { return __hip_atomic_load(p, __ATOMIC_RELAXED, __HIP_MEMORY_SCOPE_AGENT); }
__device__ __forceinline__ unsigned xb_add(unsigned* p, unsigned v) { return __hip_atomic_fetch_add(p, v, __ATOMIC_RELAXED, __HIP_MEMORY_SCOPE_AGENT); }
__device__ __forceinline__ unsigned xb_xcc_id() { return (unsigned)__builtin_amdgcn_s_getreg((3 << 11) | 20) & 0xFu; }
#define XB_SPIN(cond, bar) do { unsigned _sp = 0; while (cond) { __builtin_amdgcn_s_sleep(1); \
    if ((++_sp & 255u) == 0u) { if (xb_ld(&(bar)[XB_TMO])) break; if (_sp > XB_SPIN_CAP) { atomicAdd(&(bar)[XB_TMO], 1u); break; } } } } while (0)
struct XcdBarrier { unsigned* bar; unsigned x; volatile LAS unsigned* st; int w0; };
__device__ __forceinline__ XcdBarrier xcd_barrier_post(unsigned* bar, volatile LAS unsigned* st, int w0) {
    XcdBarrier b; b.bar = bar; b.x = xb_xcc_id(); b.st = st; b.w0 = w0;
    if (fresh_tid(w0) == 0) (void)xb_add(&bar[XB_XCNT(b.x)], 1u);
    return b;
}
__device__ __forceinline__ void xcd_barrier_complete(unsigned* bar, unsigned x, unsigned& nloc, unsigned& nx) {
    const unsigned G = gridDim.x * gridDim.y * gridDim.z;
    unsigned sum, cnt, mine, sp = 0u;
    for (;;) {
        sum = 0u; cnt = 0u; mine = 0u;
#pragma unroll
        for (unsigned j = 0; j < 16; ++j) { const unsigned c = xb_ld(&bar[XB_XCNT(j)]); sum += c; cnt += (c > 0u) ? 1u : 0u; mine = (j == x) ? c : mine; }
        if (sum == G) break;
        __builtin_amdgcn_s_sleep(1);
        if ((++sp & 255u) == 0u) { if (xb_ld(&bar[XB_TMO])) break; if (sp > XB_SPIN_CAP) { atomicAdd(&bar[XB_TMO], 1u); break; } }
    }
    nloc = mine > 0u ? mine : 1u; nx = cnt > 0u ? cnt : 1u;
}
__device__ __forceinline__ void xcd_barrier(const XcdBarrier& b) {
    asm volatile("s_waitcnt vmcnt(0)" ::: "memory");
    __syncthreads();
    if (fresh_tid(b.w0) == 0) {
        unsigned* bar = b.bar;
        __builtin_amdgcn_s_waitcnt(0);
        unsigned nloc = b.st[0], nx = b.st[1];
        if (nloc == 0u) { xcd_barrier_complete(bar, b.x, nloc, nx); b.st[0] = nloc; b.st[1] = nx; }
        const unsigned old = xb_add(&bar[XB_XSUB(b.x)], 1u);
        const unsigned gen = old / nloc;
        if (old + 1u == (gen + 1u) * nloc) {
            __builtin_amdgcn_fence(__ATOMIC_RELEASE, "agent");
            asm volatile("s_waitcnt vmcnt(0)" ::: "memory");
            const unsigned og = xb_add(&bar[XB_TOP], 1u);
            const unsigned tg = og / nx;
            if (og + 1u == (tg + 1u) * nx) xb_add(&bar[XB_TOPGEN], 1u);
            else XB_SPIN(xb_ld(&bar[XB_TOPGEN]) == tg, bar);
            __builtin_amdgcn_fence(__ATOMIC_ACQUIRE, "agent");
            xb_add(&bar[XB_XGEN(b.x)], 1u);
            asm volatile("s_waitcnt vmcnt(0)" ::: "memory");
        } else {
            XB_SPIN(xb_ld(&bar[XB_XGEN(b.x)]) == gen, bar);
            __builtin_amdgcn_fence(__ATOMIC_ACQUIRE, "agent");
            asm volatile("s_waitcnt vmcnt(0)" ::: "memory");
        }
    }
    __syncthreads();
}

struct Params {
    const float *x, *mem, *g_mix, *w_in, *b_gates, *conv_qk, *g_mh, *na_gq, *na_gk, *na_rpb, *g_mem, *w_mem_kv, *mem_gq, *mem_gk, *w_out, *g_ffn, *w_router, *w1, *w3, *w2;
    float* out; unsigned char* ws; int ph_lo, ph_hi, li, pad;
};

__device__ __forceinline__ void tr_tile(const float* src, int ldw, bf16_t* dst, int K, LAS float* scr, int lane, int jump = 0, const float* ksc = nullptr) {
    f32x4 v[16]; const int c = lane & 7;
    f32x4 g0 = {1.f, 1.f, 1.f, 1.f}, g1 = g0;
#pragma unroll
    for (int i = 0; i < 16; ++i) v[i] = *(const f32x4*)(src + (size_t)(4 * i + (lane >> 4)) * ldw + 4 * (lane & 15));
    if (ksc) { g0 = *(const f32x4*)(ksc + 8 * c); g1 = *(const f32x4*)(ksc + 8 * c + 4); }
#pragma unroll
    for (int i = 0; i < 16; ++i) { LAS float* s = scr + (4 * i + (lane >> 4)) * 65 + 4 * (lane & 15); s[0] = v[i].x; s[1] = v[i].y; s[2] = v[i].z; s[3] = v[i].w; }
    LDS_WAIT();
#pragma unroll
    for (int j = 0; j < 8; ++j) { const int n = (lane >> 3) + 8 * j; const LAS float* s = scr + (8 * c) * 65 + n;
        u32x4 o; o.x = pk2(s[0] * g0.x, s[65] * g0.y); o.y = pk2(s[130] * g0.z, s[195] * g0.w); o.z = pk2(s[260] * g1.x, s[325] * g1.y); o.w = pk2(s[390] * g1.z, s[455] * g1.w);
        *(u32x4*)(dst + (size_t)(n + (n >= 32 ? jump : 0)) * K + 8 * c) = o; }
    LDS_WAIT();
}
__device__ __forceinline__ void tr8_load(const float* src, int ldw, int lane, f32x4 (&v)[16]) {
#pragma unroll
    for (int i = 0; i < 16; ++i) v[i] = *(const f32x4*)(src + (size_t)(4 * i + (lane >> 4)) * ldw + 4 * (lane & 15));
}
__device__ __forceinline__ void tr8_finish(const f32x4 (&v)[16], unsigned char* dst, int K, LAS float* scr, int lane) {
#pragma unroll
    for (int i = 0; i < 16; ++i) { LAS float* s = scr + (4 * i + (lane >> 4)) * 65 + 4 * (lane & 15); s[0] = v[i].x; s[1] = v[i].y; s[2] = v[i].z; s[3] = v[i].w; }
    LDS_WAIT();
    const int c = lane & 7;
#pragma unroll
    for (int j = 0; j < 8; ++j) { const int n = (lane >> 3) + 8 * j; const LAS float* s = scr + (8 * c) * 65 + n;
        u32x2 o; o.x = pg8::pk4_fp8(256.f * s[0], 256.f * s[65], 256.f * s[130], 256.f * s[195]); o.y = pg8::pk4_fp8(256.f * s[260], 256.f * s[325], 256.f * s[390], 256.f * s[455]);
        *(u32x2*)(dst + (size_t)n * K + 8 * c) = o; }
    LDS_WAIT();
}
__device__ __forceinline__ void f8_tile(const Params& p, unsigned char* ws_, int it, const float*& src, int& ldw, unsigned char*& dst, int& K) {
    constexpr int T_W1 = 64 * 512;
    if (it < 2 * T_W1) { const int which = it / T_W1, r = it - which * T_W1, le = r >> 9, q = r & 511, kb = q >> 5, nb = q & 31, n0 = nb * 64, drow = (n0 >> 7) * 256 + (n0 & 127) + which * 128;
        src = (which ? p.w3 : p.w1) + (size_t)le * D * DFF + (size_t)kb * 64 * DFF + n0; ldw = DFF; dst = ws_ + WS_W13 + ((size_t)le * 4096 + drow) * D + kb * 64; K = D; }
    else { const int r = it - 2 * T_W1, le = r >> 9, q = r & 511, kb = q >> 4, nb = q & 15;
        src = p.w2 + (size_t)le * DFF * D + (size_t)kb * 64 * D + nb * 64; ldw = D; dst = ws_ + WS_W2 + ((size_t)le * D + nb * 64) * DFF + kb * 64; K = DFF; }
}
__device__ __forceinline__ void tr_tile8(const float* src, int ldw, unsigned char* dst, int K, LAS float* scr, int lane) {
#pragma unroll 4
    for (int i = 0; i < 16; ++i) { const int kk = 4 * i + (lane >> 4); const f32x4 v = *(const f32x4*)(src + (size_t)kk * ldw + 4 * (lane & 15));
        LAS float* s = scr + kk * 65 + 4 * (lane & 15); s[0] = v.x; s[1] = v.y; s[2] = v.z; s[3] = v.w; }
    LDS_WAIT();
    const int c = lane & 7;
#pragma unroll
    for (int j = 0; j < 8; ++j) { const int n = (lane >> 3) + 8 * j; const LAS float* s = scr + (8 * c) * 65 + n;
        u32x2 o; o.x = pg8::pk4_fp8(256.f * s[0], 256.f * s[65], 256.f * s[130], 256.f * s[195]); o.y = pg8::pk4_fp8(256.f * s[260], 256.f * s[325], 256.f * s[390], 256.f * s[455]);
        *(u32x2*)(dst + (size_t)n * K + 8 * c) = o; }
    LDS_WAIT();
}
__device__ __forceinline__ void ph_cvt_experts(const Params& p, LAS unsigned char* lds, const int tid, int G, int bid) {
    unsigned char* ws_ = p.ws; LAUNDER_S(ws_);
    const int lane = tid & 63, wave = __builtin_amdgcn_readfirstlane(tid >> 6);
    constexpr int NB = 3 * 4096;
    const bool shift = (G == 256);
    const int nmine = (NB - bid + G - 1) / G, nown = shift && bid < 64 ? 45 : nmine, n = shift && bid >= 64 ? nmine + 1 : nown;
    {
        LAS float* tile = (LAS float*)(lds + LDS_SCR);
        f32x4 cur[16]; const float* src = nullptr; int ldw = 0; unsigned char* dst = nullptr; int Kd = 0, hi = 0;
#define CVT_DECODE(I, src_, ldw_, dst_, K_, hi_) do { const int mtx = (I) >> 12, r_ = (I) & 4095, le = r_ >> 6, q_ = r_ & 63; \
            if (mtx < 2) { const int kb = q_ >> 3, nb = q_ & 7; \
                src_ = (mtx ? p.w3 : p.w1) + (size_t)le * D * DFF + (size_t)kb * 128 * DFF + nb * 256; ldw_ = DFF; dst_ = ws_ + WS_W13 + ((size_t)le * 4096 + nb * 512 + mtx * 128) * D + kb * 128; K_ = D; hi_ = 128; } \
            else { const int kb = q_ >> 2, nb = q_ & 3; \
                src_ = p.w2 + (size_t)le * DFF * D + (size_t)kb * 128 * D + nb * 256; ldw_ = D; dst_ = ws_ + WS_W2 + ((size_t)le * D + nb * 256) * DFF + kb * 128; K_ = DFF; hi_ = 0; } } while (0)
#define CVT_LOAD(v, src_, ldw_) do { _Pragma("unroll") for (int i = 0; i < 16; ++i) v[i] = *(const f32x4*)((src_) + (size_t)(16 * wave + i) * (ldw_) + 4 * lane); } while (0)
#define CVT_PROC(v, dst_, K_, hi_) do { \
            _Pragma("unroll") for (int i = 0; i < 16; ++i) { const int k = 16 * wave + i; *(LAS f32x4*)(tile + k * 256 + ((4 * lane) ^ ((k >> 3) << 2))) = v[i]; } \
            __syncthreads(); \
            { const int c = lane & 15; \
              _Pragma("unroll") for (int j = 0; j < 8; ++j) { const int n = 32 * wave + 4 * j + (lane >> 4); const LAS float* t1 = tile + (8 * c) * 256 + (n ^ (c << 2)); \
                  u32x2 o; o.x = pg8::pk4_fp8s(t1[0], t1[256], t1[512], t1[768], 0.00390625f); o.y = pg8::pk4_fp8s(t1[1024], t1[1280], t1[1536], t1[1792], 0.00390625f); \
                  *(u32x2*)((dst_) + (size_t)(n + (n >> 7) * (hi_)) * (K_) + 8 * c) = o; } } \
            __syncthreads(); } while (0)
        f32x4 vb[16]; const float* srcb = nullptr; int ldwb = 0; unsigned char* dstb = nullptr; int Kb = 0, hib = 0;
#define CVT_BLK(t_) ((t_) < nown ? bid + (t_) * G : ((bid - 64) & 63) + (45 + ((bid - 64) >> 6)) * G)
        int t = 0;
        if (t < n) { const int I = CVT_BLK(t); CVT_DECODE(I, src, ldw, dst, Kd, hi); CVT_LOAD(cur, src, ldw); }
#pragma unroll 1
        while (t < n) {
            if (t + 1 < n) { const int I2 = CVT_BLK(t + 1); CVT_DECODE(I2, srcb, ldwb, dstb, Kb, hib); CVT_LOAD(vb, srcb, ldwb); }
            CVT_PROC(cur, dst, Kd, hi);
            if (t + 1 >= n) break;
            if (t + 2 < n) { const int I3 = CVT_BLK(t + 2); CVT_DECODE(I3, src, ldw, dst, Kd, hi); CVT_LOAD(cur, src, ldw); }
            CVT_PROC(vb, dstb, Kb, hib);
            t += 2; }
#undef CVT_BLK
#undef CVT_PROC
#undef CVT_DECODE
#undef CVT_LOAD
    }
}
__device__ __forceinline__ void ph_convert(const Params& p, LAS unsigned char* lds, const int tid, int G, int bid) {
    unsigned char* ws_ = p.ws; LAUNDER_S(ws_);
    const int lane = tid & 63, wave = __builtin_amdgcn_readfirstlane(tid >> 6);
    LAS float* scr = (LAS float*)(lds + LDS_SCR + wave * 16640);
    const int gw = bid * 8 + wave, NGW = G * 8;
    bf16_t* w13t = (bf16_t*)(ws_ + WS_W13); bf16_t* w2t = (bf16_t*)(ws_ + WS_W2); bf16_t* wint = (bf16_t*)(ws_ + WS_WIN); bf16_t* wkvt = (bf16_t*)(ws_ + WS_WKV); bf16_t* woutt = (bf16_t*)(ws_ + WS_WOUT);
    constexpr int T_IN = 4 * 16 * 40, T_KV = 4 * 16 * 8, T_OUT = 4 * 16 * 16;
    for (int it = gw; it < T_IN + T_KV + T_OUT; it += NGW) {
        int r = it;
        if (r < T_IN) { const int l = r / 640, q = r % 640, kb = q / 40, nb = q % 40, n0 = nb * 64, sc = n0 < GATE_COL ? n0 : n0 + 16;
            const int tile = n0 >> 8; const bool hp = (tile == 6 || tile == 7 || tile == 9); const int drow = hp ? (tile * 256 + 32 * ((n0 & 255) >> 6)) : n0;
            tr_tile(p.w_in + (size_t)l * D * DIN + (size_t)kb * 64 * DIN + sc, DIN, wint + ((size_t)l * NPROJ + drow) * D + kb * 64, D, scr, lane, hp ? 96 : 0, p.g_mix + l * D + kb * 64); continue; }
        r -= T_IN;
        if (r < T_KV) { const int l = r >> 7, q = r & 127, kb = q >> 3, nb = q & 7;
            const bool hp = nb < 4; const int drow = hp ? 32 * nb : nb * 64;
            tr_tile(p.w_mem_kv + (size_t)l * D * 512 + (size_t)kb * 64 * 512 + nb * 64, 512, wkvt + ((size_t)l * 512 + drow) * D + kb * 64, D, scr, lane, hp ? 96 : 0); continue; }
        r -= T_KV;
        { const int l = r >> 8, q = r & 255, kb = q >> 4, nb = q & 15;
            if (l >= Y8_FROM) tr_tile8(p.w_out + (size_t)l * D * D + (size_t)kb * 64 * D + nb * 64, D, (unsigned char*)(woutt + (size_t)l * D * D) + (size_t)(nb * 64) * D + kb * 64, D, scr, lane);
          else tr_tile(p.w_out + (size_t)l * D * D + (size_t)kb * 64 * D + nb * 64, D, woutt + ((size_t)l * D + nb * 64) * D + kb * 64, D, scr, lane); }
    }
    bf16_t* memh = (bf16_t*)(ws_ + WS_MEMH);
    for (int r = gw; r < BATCH * NMEM; r += NGW) {
        const f32x4* xr = (const f32x4*)(p.mem + (size_t)r * D) + lane; f32x4 v[4]; float ss = 0.f;
#pragma unroll
        for (int j = 0; j < 4; ++j) { v[j] = xr[64 * j]; ss += v[j].x * v[j].x + v[j].y * v[j].y + v[j].z * v[j].z + v[j].w * v[j].w; }
        const float rr = rsqrtf(wave_sum(ss, lane) * (1.f / D) + EPS);
        f32x4 gm[DEPTH][4];
#pragma unroll
        for (int l = 0; l < DEPTH; ++l)
#pragma unroll
            for (int j = 0; j < 4; ++j) gm[l][j] = *((const f32x4*)(p.g_mem + l * D) + lane + 64 * j);
#pragma unroll
        for (int l = 0; l < DEPTH; ++l) { u32x2* o = (u32x2*)(memh + ((size_t)l * BATCH * NMEM + r) * D) + lane;
#pragma unroll
            for (int j = 0; j < 4; ++j) { const f32x4 g = gm[l][j]; u32x2 w; w.x = pk2(v[j].x * rr * g.x, v[j].y * rr * g.y); w.y = pk2(v[j].z * rr * g.z, v[j].w * rr * g.w); o[64 * j] = w; } }
    }
    { float* gt = (float*)(ws_ + WS_GT); const int i = bid * 512 + tid;
      if (i < DEPTH * 192) { const int l = i / 192, q = i % 192, w = q >> 6, d = q & 63; gt[i] = (w == 0 ? p.na_gq : (w == 1 ? p.na_gk : p.mem_gq))[l * 64 + d]; } }
}

__device__ __forceinline__ float reduce16(float (&pv)[16], int lane) {
    float a8[8], a4[4], a2[2];
#pragma unroll
    for (int i = 0; i < 8; ++i) { const bool od = lane & 1; const float keep = od ? pv[2 * i + 1] : pv[2 * i], send = od ? pv[2 * i] : pv[2 * i + 1]; a8[i] = keep + DPPF(send, 0xB1); }
#pragma unroll
    for (int i = 0; i < 4; ++i) { const bool od = lane & 2; const float keep = od ? a8[2 * i + 1] : a8[2 * i], send = od ? a8[2 * i] : a8[2 * i + 1]; a4[i] = keep + DPPF(send, 0x4E); }
#pragma unroll
    for (int i = 0; i < 2; ++i) { const bool od = lane & 4; const float keep = od ? a4[2 * i + 1] : a4[2 * i], send = od ? a4[2 * i] : a4[2 * i + 1]; a2[i] = keep + SWZF(send, 0x101F); }
    const bool od = lane & 8; const float keep = od ? a2[1] : a2[0], send = od ? a2[0] : a2[1];
    return rows_sum4(keep + SWZF(send, 0x201F));
}
template <bool F> struct NormRaw { typedef u32x2 T; };
template <> struct NormRaw<true> { typedef f32x4 T; };
__device__ __forceinline__ void nrm_ld(f32x4& r, const void* base, size_t tok, int idx) { r = *((const f32x4*)((const float*)base + tok * D) + idx); }
__device__ __forceinline__ void nrm_ld(u32x2& r, const void* base, size_t tok, int idx) { r = *((const u32x2*)((const bf16_t*)base + tok * D) + idx); }
__device__ __forceinline__ f32x4 nrm_up(const f32x4& r) { return r; }
__device__ __forceinline__ f32x4 nrm_up(const u32x2& r) { return f32x4{bflo(r.x), bfhi(r.x), bflo(r.y), bfhi(r.y)}; }
template <int MODE, bool XF32>
__device__ __forceinline__ void ph_norm(const Params& p, int l, bool combine, LAS unsigned char* lds, const int tid, int G, int bid, const void* xin) {
    GAS unsigned char* ws_ = (GAS unsigned char*)p.ws; LAUNDER_S(ws_);
    const int lane = tid & 63, wave = __builtin_amdgcn_readfirstlane(tid >> 6);
    LAS unsigned char* wl = lds + LDS_SCR;
    if (MODE != 2) {
        const GAS float* wsrc = (const GAS float*)(MODE == 0 ? p.w_in + (size_t)l * D * DIN + GATE_COL : p.w_router + (size_t)l * D * NE); const int ldw = MODE == 0 ? DIN : NE;
        f32x4 wt[8];
#pragma unroll
        for (int j = 0; j < 8; ++j) { const int i = tid + 512 * j, k = i >> 2, part = i & 3; wt[j] = *(const GAS f32x4*)(wsrc + (size_t)k * ldw + part * 4); }
#pragma unroll
        for (int j = 0; j < 8; ++j) { const int i = tid + 512 * j, k = i >> 2, part = i & 3; *(LAS f32x4*)(wl + k * 64 + (k >> 2) * 16 + part * 16) = wt[j]; }
        __syncthreads();
    }
    const GAS float* gsrc = (const GAS float*)(MODE == 0 ? p.g_mix + l * D : p.g_ffn + l * D);
    f32x4 gv[4];
#pragma unroll
    for (int j = 0; j < 4; ++j) gv[j] = MODE != 2 ? *((const GAS f32x4*)gsrc + lane + 64 * j) : (f32x4){0.f, 0.f, 0.f, 0.f};
    GAS bf16_t* hb = (GAS bf16_t*)(ws_ + WS_H); const GAS bf16_t* ybuf = (const GAS bf16_t*)(ws_ + WS_YBUF); const GAS int* slotmap = (const GAS int*)(ws_ + WS_ROUTE + RT_SLOTMAP);
    GAS float* gates = (GAS float*)(ws_ + WS_GATES); GAS float* aff = (GAS float*)(ws_ + WS_AFF);
    LAS unsigned char* stg = lds + LDS_SCR + 70656 + wave * 8192;
#define NORM_ISSUE(tok, e, c, slot) do { const GAS unsigned char* yr = (const GAS unsigned char*)ybuf + ((size_t)(((e) * BATCH + ((tok) >> 12)) * CAP + (c))) * D + lane * 16; LAS unsigned char* dl = stg + __builtin_amdgcn_readfirstlane(slot) * 1024; \
        __builtin_amdgcn_global_load_lds((const GAS unsigned*)yr, (LAS unsigned*)dl, 16, 0, 0); } while (0)
#define NORM_COMBINE2(va_, tokA_, cva_, vb_, tokB_, cvb_) do { int ca = 0, cb = 0; \
        _Pragma("unroll 1") for (int e = 0; e < NE; ++e) { const int c = __builtin_amdgcn_readlane(cva_, e);        \
            if (c >= 0) { NORM_ISSUE(tokA_, e, c, ca); if (++ca == 8) NORM_FLUSH2(va_, vb_); } } \
        _Pragma("unroll 1") for (int e = 0; e < NE; ++e) { const int c = __builtin_amdgcn_readlane(cvb_, e); \
            if (c >= 0) { NORM_ISSUE(tokB_, e, c, ca + cb); ++cb; if (ca + cb == 8) NORM_FLUSH2(va_, vb_); } } \
        if (ca + cb) NORM_FLUSH2(va_, vb_); \
        NORM_XSTORE(va_, tokA_); NORM_XSTORE(vb_, tokB_); } while (0)
#define NORM_FLUSH2(va_, vb_) do { asm volatile("s_waitcnt vmcnt(0)" ::: "memory"); \
        for (int k = 0; k < ca; ++k) { _Pragma("unroll") for (int j = 0; j < 4; ++j) { const unsigned w = *(const LAS unsigned*)(stg + k * 1024 + j * 256 + lane * 4); \
            va_[j].x += 0.125f * __builtin_amdgcn_cvt_f32_fp8(w, 0); va_[j].y += 0.125f * __builtin_amdgcn_cvt_f32_fp8(w, 1); va_[j].z += 0.125f * __builtin_amdgcn_cvt_f32_fp8(w, 2); va_[j].w += 0.125f * __builtin_amdgcn_cvt_f32_fp8(w, 3); } } \
        for (int k = 0; k < cb; ++k) { _Pragma("unroll") for (int j = 0; j < 4; ++j) { const unsigned w = *(const LAS unsigned*)(stg + (ca + k) * 1024 + j * 256 + lane * 4); \
            vb_[j].x += 0.125f * __builtin_amdgcn_cvt_f32_fp8(w, 0); vb_[j].y += 0.125f * __builtin_amdgcn_cvt_f32_fp8(w, 1); vb_[j].z += 0.125f * __builtin_amdgcn_cvt_f32_fp8(w, 2); vb_[j].w += 0.125f * __builtin_amdgcn_cvt_f32_fp8(w, 3); } } \
        asm volatile("s_waitcnt lgkmcnt(0)" ::: "memory"); ca = 0; cb = 0; } while (0)
#define NORM_XSTORE(v, tok) do { if (MODE == 2) { _Pragma("unroll") for (int j = 0; j < 4; ++j) __builtin_nontemporal_store(v[j], (GAS f32x4*)(p.out + (size_t)(tok) * D) + lane + 64 * j); }        \
        else { _Pragma("unroll") for (int j = 0; j < 4; ++j) { u32x2 w_; w_.x = pk2(v[j].x, v[j].y); w_.y = pk2(v[j].z, v[j].w); ((GAS u32x2*)(xb + (size_t)(tok) * D))[lane + 64 * j] = w_; } } } while (0)
    GAS bf16_t* xb = (GAS bf16_t*)(ws_ + WS_XB);
    const float bgate = MODE == 0 ? p.b_gates[l * 16 + (lane & 15)] : 0.f;
    int sna_ = -1, snb_ = -1;
    typename NormRaw<XF32>::T na_[4], nb_[4];
    { const int t0 = (bid * 8 + wave) * 2;
      if (t0 < NTOK) {
        if (combine) { sna_ = slotmap[(size_t)t0 * NE + (lane & 15)]; snb_ = slotmap[(size_t)(t0 + 1) * NE + (lane & 15)]; }
#pragma unroll
        for (int j = 0; j < 4; ++j) { nrm_ld(na_[j], xin, (size_t)t0, lane + 64 * j); nrm_ld(nb_[j], xin, (size_t)(t0 + 1), lane + 64 * j); } } }
#pragma unroll 1
    for (int tokA = (bid * 8 + wave) * 2; tokA < NTOK; tokA += G * 8 * 2) {
        const int tokB = tokA + 1;
        f32x4 va[4], vb[4];
#pragma unroll
        for (int j = 0; j < 4; ++j) { va[j] = nrm_up(na_[j]); vb[j] = nrm_up(nb_[j]); }
        const int cva = sna_, cvb = snb_;
        { const int tn = tokA + G * 8 * 2;
          if (tn < NTOK) {
            if (combine) { sna_ = slotmap[(size_t)tn * NE + (lane & 15)]; snb_ = slotmap[(size_t)(tn + 1) * NE + (lane & 15)]; }
#pragma unroll
            for (int j = 0; j < 4; ++j) { nrm_ld(na_[j], xin, (size_t)tn, lane + 64 * j); nrm_ld(nb_[j], xin, (size_t)(tn + 1), lane + 64 * j); } } }
        if (combine) { NORM_COMBINE2(va, tokA, cva, vb, tokB, cvb); }
        else if (XF32) { NORM_XSTORE(va, tokA); NORM_XSTORE(vb, tokB); }
        if (MODE == 2) continue;
        float ssa = 0.f, ssb = 0.f;
#pragma unroll
        for (int j = 0; j < 4; ++j) { ssa += va[j].x * va[j].x + va[j].y * va[j].y + va[j].z * va[j].z + va[j].w * va[j].w; }
#pragma unroll
        for (int j = 0; j < 4; ++j) { ssb += vb[j].x * vb[j].x + vb[j].y * vb[j].y + vb[j].z * vb[j].z + vb[j].w * vb[j].w; }
        const float rra = rsqrtf(wave_sum_fast(ssa) * (1.f / D) + EPS); float rrb = rsqrtf(wave_sum_fast(ssb) * (1.f / D) + EPS); asm volatile("" : "+v"(rrb));
        f32x2 pab[16];
#pragma unroll
        for (int g = 0; g < 16; ++g) pab[g] = (f32x2){0.f, 0.f};
        unsigned lb = (unsigned)lane * 272u + LDS_SCR; LAUNDER_V(lb);
        f32x4 hA[4], hB[4];
#pragma unroll
        for (int j = 0; j < 4; ++j) { const f32x4 gj = gv[j]; hA[j] = va[j] * gj * rra; hB[j] = vb[j] * gj * rrb; }
        f32x4 wc[2][4], wn[2][4];
#pragma unroll
        for (int qq = 0; qq < 2; ++qq) { const LAS f32x4* wr4 = (const LAS f32x4*)(lds + lb + qq * 64);
#pragma unroll
            for (int part = 0; part < 4; ++part) wc[qq][part] = wr4[part]; }
#pragma unroll
        for (int hs = 0; hs < 8; ++hs) {
            if (hs < 7) { const int jn = (hs + 1) >> 1, qb = 2 * ((hs + 1) & 1);
#pragma unroll
                for (int qq = 0; qq < 2; ++qq) { const LAS f32x4* wr4 = (const LAS f32x4*)(lds + lb + jn * 17408 + (qb + qq) * 64);
#pragma unroll
                    for (int part = 0; part < 4; ++part) wn[qq][part] = wr4[part]; } }
            __builtin_amdgcn_sched_barrier(0);
            { const int j = hs >> 1, qb = 2 * (hs & 1);
#pragma unroll
              for (int qq = 0; qq < 2; ++qq) { const f32x2 hq = {hA[j][qb + qq], hB[j][qb + qq]};
#pragma unroll
                  for (int part = 0; part < 4; ++part) { const f32x4 w4 = wc[qq][part];
                      pab[part * 4 + 0] += hq * w4.x; pab[part * 4 + 1] += hq * w4.y; pab[part * 4 + 2] += hq * w4.z; pab[part * 4 + 3] += hq * w4.w; } } }
            __builtin_amdgcn_sched_barrier(0);
            if (hs < 7) {
#pragma unroll
                for (int qq = 0; qq < 2; ++qq)
#pragma unroll
                    for (int part = 0; part < 4; ++part) wc[qq][part] = wn[qq][part]; } }
        float pa[16], pb[16];
#pragma unroll
        for (int g = 0; g < 16; ++g) { pa[g] = pab[g].x; pb[g] = pab[g].y; }
        const int g = lane & 15; const float ta = reduce16(pa, lane); float tb = reduce16(pb, lane);
        if (MODE == 0) { if (lane < 16) { gates[(size_t)tokA * 16 + g] = ta + bgate; gates[(size_t)tokB * 16 + g] = tb + bgate; }
            if (lane == 16) { GAS float* rrow = (GAS float*)(ws_ + WS_RR); rrow[tokA] = rra; rrow[tokB] = rrb; } }
        else { const float mxa = row_max16(ta), exa = __expf(ta - mxa), sma = row_sum16(exa); const float mxb = row_max16(tb), exb = __expf(tb - mxb), smb = row_sum16(exb);
            if (lane < 16) { aff[((size_t)(tokA >> 12) * NE + g) * SEQ + (tokA & (SEQ - 1))] = exa / sma; aff[((size_t)(tokB >> 12) * NE + g) * SEQ + (tokB & (SEQ - 1))] = exb / smb; } }
    }
#undef NORM_COMBINE2
#undef NORM_ISSUE
#undef NORM_XSTORE
#undef NORM_FLUSH2
}


__device__ __forceinline__ float reduce8(float (&pv)[8], int lane) {
    float a4[4], a2[2];
#pragma unroll
    for (int i = 0; i < 4; ++i) { const bool od = lane & 1; const float keep = od ? pv[2 * i + 1] : pv[2 * i], send = od ? pv[2 * i] : pv[2 * i + 1]; a4[i] = keep + DPPF(send, 0xB1); }
#pragma unroll
    for (int i = 0; i < 2; ++i) { const bool od = lane & 2; const float keep = od ? a4[2 * i + 1] : a4[2 * i], send = od ? a4[2 * i] : a4[2 * i + 1]; a2[i] = keep + DPPF(send, 0x4E); }
    const bool od = lane & 4; const float keep = od ? a2[1] : a2[0], send = od ? a2[0] : a2[1];
    float a1 = keep + SWZF(send, 0x101F);
    a1 += SWZF(a1, 0x201F);
    return rows_sum4(a1);
}
__device__ __forceinline__ void ph_norm1_t4(const Params& p, int l, LAS unsigned char* lds, const int tid, int G, int bid) {
    GAS unsigned char* ws_ = (GAS unsigned char*)p.ws; LAUNDER_S(ws_);
    const int lane = tid & 63, wave = __builtin_amdgcn_readfirstlane(tid >> 6);
    LAS unsigned char* wl = lds + LDS_SCR;
    { const GAS float* wsrc = (const GAS float*)(p.w_router + (size_t)l * D * NE);
      f32x4 wt[8];
#pragma unroll
      for (int j = 0; j < 8; ++j) { const int i = tid + 512 * j, k = i >> 2, part = i & 3; wt[j] = *(const GAS f32x4*)(wsrc + (size_t)k * NE + part * 4); }
#pragma unroll
      for (int j = 0; j < 8; ++j) { const int i = tid + 512 * j, k = i >> 2, part = i & 3; *(LAS f32x4*)(wl + k * 64 + (k >> 2) * 16 + part * 16) = wt[j]; }
      __syncthreads(); }
    const GAS float* gsrc = (const GAS float*)(p.g_ffn + l * D);
    f32x4 gv[4];
#pragma unroll
    for (int j = 0; j < 4; ++j) gv[j] = *((const GAS f32x4*)gsrc + lane + 64 * j);
    const GAS bf16_t* xb = (const GAS bf16_t*)(ws_ + WS_XB); GAS unsigned char* hb8 = ws_ + WS_H; GAS float* aff = (GAS float*)(ws_ + WS_AFF);
    u32x2 nr[4][4];
    const int tfirst = (bid * 8 + wave) * 4, tstep = G * 32;
    if (tfirst < NTOK) {
#pragma unroll
        for (int t = 0; t < 4; ++t)
#pragma unroll
            for (int j = 0; j < 4; ++j) nr[t][j] = *((const GAS u32x2*)(xb + (size_t)(tfirst + t) * D) + lane + 64 * j); }
#pragma unroll 1
    for (int tok0 = tfirst; tok0 < NTOK; tok0 += tstep) {
        f32x4 v[4][4]; float rr[4];
#pragma unroll
        for (int t = 0; t < 4; ++t)
#pragma unroll
            for (int j = 0; j < 4; ++j) { const u32x2 r = nr[t][j]; v[t][j] = (f32x4){bflo(r.x), bfhi(r.x), bflo(r.y), bfhi(r.y)}; }
        if (tok0 + tstep < NTOK) {
#pragma unroll
            for (int t = 0; t < 4; ++t)
#pragma unroll
                for (int j = 0; j < 4; ++j) nr[t][j] = *((const GAS u32x2*)(xb + (size_t)(tok0 + tstep + t) * D) + lane + 64 * j); }
#pragma unroll
        for (int t = 0; t < 4; ++t) { float ss = 0.f;
#pragma unroll
            for (int j = 0; j < 4; ++j) ss += v[t][j].x * v[t][j].x + v[t][j].y * v[t][j].y + v[t][j].z * v[t][j].z + v[t][j].w * v[t][j].w;
            rr[t] = rsqrtf(wave_sum_fast(ss) * (1.f / D) + EPS); }
#pragma unroll
        for (int j = 0; j < 4; ++j)
#pragma unroll
            for (int t = 0; t < 4; ++t) { const f32x4 h = v[t][j] * gv[j] * rr[t]; v[t][j] = h;
                ((GAS unsigned*)(hb8 + (size_t)(tok0 + t) * D))[lane + 64 * j] = pg8::pk4_fp8s(h.x, h.y, h.z, h.w, 0.125f); }
        float lg[4];
#pragma unroll
        for (int pass = 0; pass < 2; ++pass) {
            f32x2 pab[8], pcd[8];
#pragma unroll
            for (int e = 0; e < 8; ++e) { pab[e] = (f32x2){0.f, 0.f}; pcd[e] = (f32x2){0.f, 0.f}; }
            unsigned lb = (unsigned)lane * 272u + LDS_SCR + 32u * pass; LAUNDER_V(lb);
            f32x4 wcur[4][2], wnxt[4][2];
#pragma unroll
            for (int q = 0; q < 4; ++q) { const LAS f32x4* wr4 = (const LAS f32x4*)(lds + lb + q * 64); wcur[q][0] = wr4[0]; wcur[q][1] = wr4[1]; }
#pragma unroll
            for (int j = 0; j < 4; ++j) {
                if (j < 3) {
#pragma unroll
                    for (int q = 0; q < 4; ++q) { const LAS f32x4* wr4 = (const LAS f32x4*)(lds + lb + (j + 1) * 17408 + q * 64); wnxt[q][0] = wr4[0]; wnxt[q][1] = wr4[1]; } }
                __builtin_amdgcn_sched_barrier(0);
#pragma unroll
                for (int q = 0; q < 4; ++q) { const f32x2 hab = {v[0][j][q], v[1][j][q]}, hcd = {v[2][j][q], v[3][j][q]};
#pragma unroll
                    for (int pp = 0; pp < 2; ++pp) { const f32x4 w4 = wcur[q][pp];
                        pab[pp * 4 + 0] += hab * w4.x; pab[pp * 4 + 1] += hab * w4.y; pab[pp * 4 + 2] += hab * w4.z; pab[pp * 4 + 3] += hab * w4.w;
                        pcd[pp * 4 + 0] += hcd * w4.x; pcd[pp * 4 + 1] += hcd * w4.y; pcd[pp * 4 + 2] += hcd * w4.z; pcd[pp * 4 + 3] += hcd * w4.w; } }
                __builtin_amdgcn_sched_barrier(0);
                if (j < 3) {
#pragma unroll
                    for (int q = 0; q < 4; ++q) { wcur[q][0] = wnxt[q][0]; wcur[q][1] = wnxt[q][1]; } } }
            float pa[8], pb[8], pc[8], pd[8];
#pragma unroll
            for (int e = 0; e < 8; ++e) { pa[e] = pab[e].x; pb[e] = pab[e].y; pc[e] = pcd[e].x; pd[e] = pcd[e].y; }
            const float ra = reduce8(pa, lane), rb = reduce8(pb, lane), rc = reduce8(pc, lane), rd = reduce8(pd, lane);
            const bool mine = ((lane >> 3) & 1) == pass;
            if (pass == 0) { lg[0] = ra; lg[1] = rb; lg[2] = rc; lg[3] = rd; }
            else { lg[0] = mine ? ra : lg[0]; lg[1] = mine ? rb : lg[1]; lg[2] = mine ? rc : lg[2]; lg[3] = mine ? rd : lg[3]; }
        }
        const int g = lane & 15;
        f32x4 pr;
        ((GAS int*)(ws_ + WS_ROUTE + RT_SLOTMAP))[(size_t)tok0 * NE + lane] = -1;
#pragma unroll
        for (int t = 0; t < 4; ++t) { const float mx = row_max16(lg[t]), ex = __expf(lg[t] - mx), sm = row_sum16(ex); pr[t] = ex * __builtin_amdgcn_rcpf(sm); }
        if (lane < 16) *(GAS f32x4*)(aff + ((size_t)(tok0 >> 12) * NE + g) * SEQ + (tok0 & (SEQ - 1))) = pr;
    }
}

typedef pg8::bf16x8 bf16x8;
template <bool NA>
__device__ __forceinline__ void ph_attn_mfma(const Params& p, int l, LAS unsigned char* lds, const int tid, int G, int bid) {
    unsigned char* ws_ = p.ws; LAUNDER_S(ws_);
    const int lane = tid & 63, gw = bid * 8 + __builtin_amdgcn_readfirstlane(tid >> 6), NGW = G * 8, fr = lane & 15, g = lane >> 4;
    const bf16_t* nrm = (const bf16_t*)(ws_ + WS_NRM); const bf16_t* nvt = (const bf16_t*)(ws_ + WS_NVT); const bf16_t* kmn = (const bf16_t*)(ws_ + WS_KMN); const bf16_t* vmt = (const bf16_t*)(ws_ + WS_VMT);
    bf16_t* y = (bf16_t*)(ws_ + WS_Y);
    LAS float* tb = (LAS float*)(lds + LDS_SCR);
    if (NA) { const float* rpb = p.na_rpb + (size_t)l * 4 * 15 * 31;
        for (int i = tid; i < 4 * 15 * 64; i += 512) { const int dcp = (i & 63) - 16, hr = i >> 6; tb[i] = (dcp >= 0 && dcp < 31) ? rpb[hr * 31 + dcp] : 0.f; }
        __syncthreads(); }
#pragma unroll 1
    for (int it = gw; it < BATCH * 4 * 256; it += NGW) {
        const int qb = it & 255, head = (it >> 8) & 3, b = it >> 10, tok0 = b * SEQ + qb * 16, r = qb >> 2, seg = qb & 3;
        const int rs = min(max(r - 4, 0), 56), kc0 = min(max(seg * 16 - 8, 0), 32);
        const bf16_t* qp = nrm + (size_t)(tok0 + fr) * 768 + (NA ? 0 : 512) + head * 64 + 8 * g;
        const bf16x8 qf0 = *(const bf16x8*)qp, qf1 = *(const bf16x8*)(qp + 32);
        const int jj0 = 8 * (fr >> 2) + (fr & 3);
        const bf16_t* kb = NA ? nrm + (size_t)(b * SEQ + rs * 64 + kc0 + jj0) * 768 + 256 + head * 64 + 8 * g : kmn + (size_t)((l * BATCH + b) * NMEM + jj0) * 256 + head * 64 + 8 * g;
        constexpr int KGS = NA ? 64 * 768 : 32 * 256, KTS = NA ? 4 * 768 : 4 * 256;
        bf16x8 ka[16][2];
#pragma unroll
        for (int i = 0; i < 16; ++i) { const bf16_t* kp = kb + (i >> 1) * KGS + (i & 1) * KTS; ka[i][0] = *(const bf16x8*)kp; ka[i][1] = *(const bf16x8*)(kp + 32); }
        __builtin_amdgcn_sched_barrier(0);
        f32x4 S[16];
#pragma unroll
        for (int i = 0; i < 16; ++i) { f32x4 z = {0.f, 0.f, 0.f, 0.f}; z = __builtin_amdgcn_mfma_f32_16x16x32_bf16(ka[i][0], qf0, z, 0, 0, 0); S[i] = __builtin_amdgcn_mfma_f32_16x16x32_bf16(ka[i][1], qf1, z, 0, 0, 0); }
        const bf16_t* vb = NA ? nvt + ((size_t)((b * 4 + head) * 64 + fr)) * SEQ + rs * 64 + kc0 + 8 * g : vmt + ((size_t)(((l * BATCH + b) * 4 + head) * 64 + fr)) * NMEM + 8 * g;
        constexpr int VMS = NA ? 16 * SEQ : 16 * NMEM, VGS = NA ? 64 : 32;
        bf16x8 va[16];
#pragma unroll
        for (int i = 0; i < 16; ++i) va[i] = *(const bf16x8*)(vb + (i >> 3) * VMS + (i & 7) * VGS);
        __builtin_amdgcn_sched_barrier(0);
        float mx = -1e30f;
        if (NA) { const int c = seg * 16 + fr, lo = min(max(c - 8, 0), 48) - c, dc0 = kc0 + 8 * g - c;
            const LAS float* tbl = tb + (head * 15 + (rs - r + 7)) * 64 + dc0 + 31;
#pragma unroll
            for (int i = 0; i < 16; ++i)
#pragma unroll
                for (int q = 0; q < 4; ++q) { const int dj = 4 * (i & 1) + q, dc = dc0 + dj; const float bv = tbl[(i >> 1) * 64 + dj];
                    const float mk = (dc >= lo && dc <= lo + 15) ? 0.f : -1e30f; const float v = (S[i][q] + bv) + mk; S[i][q] = v; mx = fmaxf(mx, v); } }
        else {
#pragma unroll
            for (int i = 0; i < 16; ++i)
#pragma unroll
                for (int q = 0; q < 4; ++q) mx = fmaxf(mx, S[i][q]); }
        mx = rows_max4(mx);
        float sum = 0.f; bf16x8 pf[8];
#pragma unroll
        for (int Gk = 0; Gk < 8; ++Gk) { float e[8];
#pragma unroll
            for (int t = 0; t < 2; ++t)
#pragma unroll
                for (int q = 0; q < 4; ++q) { e[t * 4 + q] = __expf(S[2 * Gk + t][q] - mx); sum += e[t * 4 + q]; }
            u32x4 w; w.x = pk2(e[0], e[1]); w.y = pk2(e[2], e[3]); w.z = pk2(e[4], e[5]); w.w = pk2(e[6], e[7]);
            pf[Gk] = __builtin_bit_cast(bf16x8, w); }
        sum = rows_sum4(sum);
        bf16x8 vc[16];
#pragma unroll
        for (int i = 0; i < 16; ++i) vc[i] = *(const bf16x8*)(vb + (2 + (i >> 3)) * VMS + (i & 7) * VGS);
        __builtin_amdgcn_sched_barrier(0);
        f32x4 O[4];
#pragma unroll
        for (int mt = 0; mt < 2; ++mt) { O[mt] = (f32x4){0.f, 0.f, 0.f, 0.f};
#pragma unroll
            for (int Gk = 0; Gk < 8; ++Gk) O[mt] = __builtin_amdgcn_mfma_f32_16x16x32_bf16(va[mt * 8 + Gk], pf[Gk], O[mt], 0, 0, 0); }
#pragma unroll
        for (int mt = 0; mt < 2; ++mt) { O[2 + mt] = (f32x4){0.f, 0.f, 0.f, 0.f};
#pragma unroll
            for (int Gk = 0; Gk < 8; ++Gk) O[2 + mt] = __builtin_amdgcn_mfma_f32_16x16x32_bf16(vc[mt * 8 + Gk], pf[Gk], O[2 + mt], 0, 0, 0); }
        const float inv = 1.0f / sum; bf16_t* yo = y + (size_t)(tok0 + fr) * D + (NA ? 512 : 768) + head * 64 + 4 * g;
#pragma unroll
        for (int mt = 0; mt < 4; ++mt) { u32x2 w; w.x = pk2(O[mt][0] * inv, O[mt][1] * inv); w.y = pk2(O[mt][2] * inv, O[mt][3] * inv); *(u32x2*)(yo + 16 * mt) = w; }
    }
    if (NA) __syncthreads();
}


__device__ __forceinline__ void ph_na_lds(const Params& p, int l, LAS unsigned char* lds, const int tid, int G, int bid) {
    GAS unsigned char* ws_ = (GAS unsigned char*)p.ws; LAUNDER_S(ws_);
    const GAS bf16_t* nrm = (const GAS bf16_t*)(ws_ + WS_NRM); const GAS bf16_t* nvt = (const GAS bf16_t*)(ws_ + WS_NVT); GAS bf16_t* y = (GAS bf16_t*)(ws_ + WS_Y);
    LAS unsigned char* kl = lds + LDS_SCR; LAS unsigned char* vl = kl + 8 * 64 * 144; LAS float* tb = (LAS float*)(vl + 64 * 1040);
#pragma unroll 1
    for (int unit = bid; unit < BATCH * 4 * 8; unit += G) {
        int tid_ = tid; LAUNDER_V(tid_);
        const int lane = tid_ & 63, wave = __builtin_amdgcn_readfirstlane(tid_ >> 6), fr = lane & 15, g = lane >> 4;
        const int band = unit & 7, head = (unit >> 3) & 3, b = unit >> 5, r0 = band * 8, rs0 = min(max(r0 - 4, 0), 56);
        const GAS bf16_t* kg = nrm + (size_t)(b * SEQ) * 768 + 256 + head * 64;
        const GAS bf16_t* vg = nvt + (size_t)((b * 4 + head) * 64) * SEQ;
        __syncthreads();
        { const GAS float* rpb = (const GAS float*)(p.na_rpb + ((size_t)l * 4 + head) * 15 * 31);
          float tbv[2];
#pragma unroll
          for (int j = 0; j < 2; ++j) { const int i = tid_ + 512 * j, dcp = (i & 63) - 16; tbv[j] = (i < 15 * 64 && dcp >= 0 && dcp < 31) ? rpb[(i >> 6) * 31 + dcp] : 0.f; }
#pragma unroll
          for (int j = 0; j < 2; ++j) { const int i = tid_ + 512 * j; if (i < 15 * 64) tb[i] = tbv[j]; }
#pragma unroll
          for (int hb = 0; hb < 2; ++hb) { u32x4 tk[4], tv[4];
#pragma unroll
              for (int i = 0; i < 4; ++i) { const int idx = tid_ + 512 * (4 * hb + i), row = idx >> 9, rem = idx & 511, gr = rs0 + row;
                  tk[i] = *(const GAS u32x4*)(kg + (size_t)(gr * 64 + (rem >> 3)) * 768 + (rem & 7) * 8); tv[i] = *(const GAS u32x4*)(vg + (size_t)gr * 4096 + rem * 8); }
#pragma unroll
              for (int i = 0; i < 4; ++i) { const int idx = tid_ + 512 * (4 * hb + i), row = idx >> 9, rem = idx & 511, sl = (rs0 + row) & 7;
                  *(LAS u32x4*)(kl + (sl * 64 + (rem >> 3)) * 144 + (rem & 7) * 16) = tk[i]; *(LAS u32x4*)(vl + (rem >> 3) * 1040 + sl * 128 + (rem & 7) * 16) = tv[i]; } } }
        u32x4 ka_[2], va_[2], kb_[2], vb_[2];
#define NA_NEED(r_) (((r_) + 1 < r0 + 8) && (min(max((r_) - 3, 0), 56) != min(max((r_) - 4, 0), 56)))
#define NA_LOADROW(kk, vv, gn_) do { const int t2 = tid_ - 256; _Pragma("unroll") for (int i = 0; i < 2; ++i) { const int rem = t2 + 256 * i; kk[i] = *(const GAS u32x4*)(kg + (size_t)((gn_) * 64 + (rem >> 3)) * 768 + (rem & 7) * 8); vv[i] = *(const GAS u32x4*)(vg + (size_t)(gn_) * 4096 + rem * 8); } } while (0)
#define NA_STOREROW(kk, vv, gn_) do { const int t2 = tid_ - 256, sl = (gn_) & 7; _Pragma("unroll") for (int i = 0; i < 2; ++i) { const int rem = t2 + 256 * i; *(LAS u32x4*)(kl + (sl * 64 + (rem >> 3)) * 144 + (rem & 7) * 16) = kk[i]; *(LAS u32x4*)(vl + (rem >> 3) * 1040 + sl * 128 + (rem & 7) * 16) = vv[i]; } } while (0)
        if (wave >= 4 && NA_NEED(r0)) NA_LOADROW(ka_, va_, rs0 + 8);
        __syncthreads();
        auto na_row = [&](const int r, u32x4 (&lk)[2], u32x4 (&lv)[2], const u32x4 (&sk)[2], const u32x4 (&sv)[2]) __attribute__((always_inline)) {
            const int rs = min(max(r - 4, 0), 56);
            if (wave >= 4) { const int r1 = r + 1; if (NA_NEED(r1)) { const int gn1 = min(max(r1 - 4, 0), 56) + 8; NA_LOADROW(lk, lv, gn1); } }
            else {
                const int seg = wave, tok0 = b * SEQ + r * 64 + seg * 16, kc0 = min(max(seg * 16 - 8, 0), 32);
                const GAS bf16_t* qp = nrm + (size_t)(tok0 + fr) * 768 + head * 64 + 8 * g;
                const bf16x8 qf0 = *(const GAS bf16x8*)qp, qf1 = *(const GAS bf16x8*)(qp + 32);
                const int jj0 = 8 * (fr >> 2) + (fr & 3);
                f32x4 S[16];
                { bf16x8 kfr[16][2];
#pragma unroll
                  for (int i = 0; i < 16; ++i) { const int sl = (rs + (i >> 1)) & 7; const LAS unsigned char* ka = kl + (sl * 64 + kc0 + jj0 + 4 * (i & 1)) * 144 + 16 * g; kfr[i][0] = *(const LAS bf16x8*)ka; kfr[i][1] = *(const LAS bf16x8*)(ka + 64); }
                  __builtin_amdgcn_sched_barrier(0);
#pragma unroll
                  for (int i = 0; i < 16; ++i) { f32x4 z = {0.f, 0.f, 0.f, 0.f}; z = __builtin_amdgcn_mfma_f32_16x16x32_bf16(kfr[i][0], qf0, z, 0, 0, 0); S[i] = __builtin_amdgcn_mfma_f32_16x16x32_bf16(kfr[i][1], qf1, z, 0, 0, 0); } }
                float mx = -1e30f;
                { const int c = seg * 16 + fr, lo = min(max(c - 8, 0), 48) - c, dc0 = kc0 + 8 * g - c; const LAS float* tbl = tb + (rs - r + 7) * 64 + dc0 + 31;
                  float bvv[16][4];
#pragma unroll
                  for (int i = 0; i < 16; ++i)
#pragma unroll
                      for (int q = 0; q < 4; ++q) bvv[i][q] = tbl[(i >> 1) * 64 + 4 * (i & 1) + q];
                  __builtin_amdgcn_sched_barrier(0);
#pragma unroll
                  for (int i = 0; i < 16; ++i)
#pragma unroll
                      for (int q = 0; q < 4; ++q) { const int dj = 4 * (i & 1) + q, dc = dc0 + dj; const float bv = bvv[i][q];
                          const float mk = (dc >= lo && dc <= lo + 15) ? 0.f : -1e30f; const float v = (S[i][q] + bv) + mk; S[i][q] = v; mx = fmaxf(mx, v); } }
                mx = rows_max4(mx);
                float sum = 0.f; bf16x8 pf[8];
#pragma unroll
                for (int Gk = 0; Gk < 8; ++Gk) { float e[8];
#pragma unroll
                    for (int t = 0; t < 2; ++t)
#pragma unroll
                        for (int q = 0; q < 4; ++q) { e[t * 4 + q] = __expf(S[2 * Gk + t][q] - mx); sum += e[t * 4 + q]; }
                    u32x4 w; w.x = pk2(e[0], e[1]); w.y = pk2(e[2], e[3]); w.z = pk2(e[4], e[5]); w.w = pk2(e[6], e[7]); pf[Gk] = __builtin_bit_cast(bf16x8, w); }
                sum = rows_sum4(sum);
                const bool y8 = l >= Y8_FROM; const float inv = (y8 ? 8.0f : 1.0f) / sum; GAS bf16_t* yo = y + (size_t)(tok0 + fr) * D + 512 + head * 64 + 4 * g; GAS unsigned char* yo8 = (GAS unsigned char*)y + (size_t)(tok0 + fr) * D + 512 + head * 64 + 4 * g;
#pragma unroll
                for (int hv = 0; hv < 2; ++hv) { bf16x8 vfr[16];
#pragma unroll
                    for (int i = 0; i < 16; ++i) vfr[i] = *(const LAS bf16x8*)(vl + (16 * (2 * hv + (i >> 3)) + fr) * 1040 + ((rs + (i & 7)) & 7) * 128 + 2 * (kc0 + 8 * g));
                    __builtin_amdgcn_sched_barrier(0);
#pragma unroll
                    for (int m2 = 0; m2 < 2; ++m2) { f32x4 O = {0.f, 0.f, 0.f, 0.f};
#pragma unroll
                        for (int Gk = 0; Gk < 8; ++Gk) O = __builtin_amdgcn_mfma_f32_16x16x32_bf16(vfr[m2 * 8 + Gk], pf[Gk], O, 0, 0, 0);
                        if (y8) *(GAS unsigned*)(yo8 + 16 * (2 * hv + m2)) = pg8::pk4_fp8(O[0] * inv, O[1] * inv, O[2] * inv, O[3] * inv);
                        else { u32x2 w; w.x = pk2(O[0] * inv, O[1] * inv); w.y = pk2(O[2] * inv, O[3] * inv); *(GAS u32x2*)(yo + 16 * (2 * hv + m2)) = w; } } }
            }
            __syncthreads();
            if (wave >= 4 && NA_NEED(r)) { const int gn = rs + 8; NA_STOREROW(sk, sv, gn); }
            __syncthreads();
        };
#pragma unroll 1
        for (int r = r0; r < r0 + 8; r += 2) { na_row(r, kb_, vb_, ka_, va_); na_row(r + 1, ka_, va_, kb_, vb_); }
    }
}

__device__ __forceinline__ void ph_cross_lds(const Params& p, int l, LAS unsigned char* lds, const int tid, int G, int bid) {
    GAS unsigned char* ws_ = (GAS unsigned char*)p.ws; LAUNDER_S(ws_);
    const GAS bf16_t* nrm = (const GAS bf16_t*)(ws_ + WS_NRM); const GAS bf16_t* kmn = (const GAS bf16_t*)(ws_ + WS_KMN); const GAS bf16_t* vmt = (const GAS bf16_t*)(ws_ + WS_VMT); GAS bf16_t* y = (GAS bf16_t*)(ws_ + WS_Y);
    LAS unsigned char* kl = lds + LDS_SCR; LAS unsigned char* vl = kl + 256 * 144;
#pragma unroll 1
    for (int unit = bid; unit < BATCH * 4 * 8; unit += G) {
        int tid_ = tid; LAUNDER_V(tid_);
        const int lane = tid_ & 63, wave = __builtin_amdgcn_readfirstlane(tid_ >> 6), fr = lane & 15, g = lane >> 4;
        const int qc = unit & 7, head = (unit >> 3) & 3, b = unit >> 5;
        __syncthreads();
        { u32x4 tk[4], tv[4];
#pragma unroll
          for (int i = 0; i < 4; ++i) { const int idx = tid_ + 512 * i, rho = idx >> 3, c = idx & 7, key = (rho & ~31) + 8 * ((rho & 15) >> 2) + 4 * ((rho >> 4) & 1) + (rho & 3);
              tk[i] = *(const GAS u32x4*)(kmn + (size_t)((l * BATCH + b) * NMEM + key) * 256 + head * 64 + c * 8);
              const int dh = idx >> 5, cv = idx & 31; tv[i] = *(const GAS u32x4*)(vmt + ((size_t)(((l * BATCH + b) * 4 + head) * 64 + dh)) * NMEM + cv * 8); }
#pragma unroll
          for (int i = 0; i < 4; ++i) { const int idx = tid_ + 512 * i; *(LAS u32x4*)(kl + (idx >> 3) * 144 + (idx & 7) * 16) = tk[i]; *(LAS u32x4*)(vl + (idx >> 5) * 528 + (idx & 31) * 16) = tv[i]; } }
        __syncthreads();
#pragma unroll 1
        for (int ti = 0; ti < 4; ++ti) {
            const int tok0 = b * SEQ + qc * 512 + (wave * 4 + ti) * 16;
            const GAS bf16_t* qp = nrm + (size_t)(tok0 + fr) * 768 + 512 + head * 64 + 8 * g;
            const bf16x8 qf0 = *(const GAS bf16x8*)qp, qf1 = *(const GAS bf16x8*)(qp + 32);
            f32x4 S[16]; float mx = -1e30f;
            { bf16x8 kfr[16][2];
#pragma unroll
              for (int i = 0; i < 16; ++i) { const LAS unsigned char* ka = kl + (16 * i + fr) * 144 + 16 * g; kfr[i][0] = *(const LAS bf16x8*)ka; kfr[i][1] = *(const LAS bf16x8*)(ka + 64); }
              __builtin_amdgcn_sched_barrier(0);
#pragma unroll
              for (int i = 0; i < 16; ++i) { f32x4 z = {0.f, 0.f, 0.f, 0.f}; z = __builtin_amdgcn_mfma_f32_16x16x32_bf16(kfr[i][0], qf0, z, 0, 0, 0); S[i] = __builtin_amdgcn_mfma_f32_16x16x32_bf16(kfr[i][1], qf1, z, 0, 0, 0); } }
#pragma unroll
            for (int i = 0; i < 16; ++i)
#pragma unroll
                for (int q = 0; q < 4; ++q) mx = fmaxf(mx, S[i][q]);
            mx = rows_max4(mx);
            float sum = 0.f; bf16x8 pf[8];
#pragma unroll
            for (int Gk = 0; Gk < 8; ++Gk) { float e[8];
#pragma unroll
                for (int t = 0; t < 2; ++t)
#pragma unroll
                    for (int q = 0; q < 4; ++q) { e[t * 4 + q] = __builtin_amdgcn_exp2f(S[2 * Gk + t][q] - mx); sum += e[t * 4 + q]; }
                u32x4 w; w.x = pk2(e[0], e[1]); w.y = pk2(e[2], e[3]); w.z = pk2(e[4], e[5]); w.w = pk2(e[6], e[7]); pf[Gk] = __builtin_bit_cast(bf16x8, w); }
            sum = rows_sum4(sum);
            const bool y8 = l >= Y8_FROM; const float inv = (y8 ? 8.0f : 1.0f) / sum; GAS bf16_t* yo = y + (size_t)(tok0 + fr) * D + 768 + head * 64 + 4 * g; GAS unsigned char* yo8 = (GAS unsigned char*)y + (size_t)(tok0 + fr) * D + 768 + head * 64 + 4 * g;
#pragma unroll
            for (int hv = 0; hv < 2; ++hv) { bf16x8 vfr[16];
#pragma unroll
                for (int i = 0; i < 16; ++i) vfr[i] = *(const LAS bf16x8*)(vl + (16 * (2 * hv + (i >> 3)) + fr) * 528 + 16 * (4 * (i & 7) + g));
                __builtin_amdgcn_sched_barrier(0);
#pragma unroll
                for (int m2 = 0; m2 < 2; ++m2) { f32x4 O = {0.f, 0.f, 0.f, 0.f};
#pragma unroll
                    for (int Gk = 0; Gk < 8; ++Gk) O = __builtin_amdgcn_mfma_f32_16x16x32_bf16(vfr[m2 * 8 + Gk], pf[Gk], O, 0, 0, 0);
                    if (y8) *(GAS unsigned*)(yo8 + 16 * (2 * hv + m2)) = pg8::pk4_fp8(O[0] * inv, O[1] * inv, O[2] * inv, O[3] * inv);
                    else { u32x2 w; w.x = pk2(O[0] * inv, O[1] * inv); w.y = pk2(O[2] * inv, O[3] * inv); *(GAS u32x2*)(yo + 16 * (2 * hv + m2)) = w; } } }
        }
    }
    __syncthreads();
}

__device__ __forceinline__ float logsigmoidf_(float x) { return x >= 0.f ? -__logf(1.0f + __expf(-x)) : x - __logf(1.0f + __expf(x)); }
#define DPPS(old_, v_, ctrl_, rmask_, bc_) __int_as_float(__builtin_amdgcn_update_dpp(__float_as_int(old_), __float_as_int(v_), (ctrl_), (rmask_), 0xF, (bc_)))
__device__ __forceinline__ float wave_iscan_add(float v) {
    v += DPPS(0.f, v, 0x111, 0xF, true); v += DPPS(0.f, v, 0x112, 0xF, true); v += DPPS(0.f, v, 0x114, 0xF, true); v += DPPS(0.f, v, 0x118, 0xF, true);
    v += DPPS(0.f, v, 0x142, 0xA, true); v += DPPS(0.f, v, 0x143, 0xC, true); return v; }
__device__ __forceinline__ float wave_iscan_max(float v) {
    const float ninf = -3.0e38f;
    v = fmaxf(v, DPPS(ninf, v, 0x111, 0xF, false)); v = fmaxf(v, DPPS(ninf, v, 0x112, 0xF, false)); v = fmaxf(v, DPPS(ninf, v, 0x114, 0xF, false)); v = fmaxf(v, DPPS(ninf, v, 0x118, 0xF, false));
    v = fmaxf(v, DPPS(ninf, v, 0x142, 0xA, false)); v = fmaxf(v, DPPS(ninf, v, 0x143, 0xC, false)); return v; }
__device__ __forceinline__ void conv8(const bf16_t* proj, const float* cw, int tok, int sg, int c0, float (&a)[8]) {
#pragma unroll
    for (int q = 0; q < 8; ++q) a[q] = 0.f;
#pragma unroll
    for (int j = 0; j < 5; ++j) { const int sj = sg + j - 2; if (sj >= 0 && sj < SEQ) { const u32x4 w = *(const u32x4*)(proj + (size_t)(tok + j - 2) * NPROJ + c0); const f32x4 w0 = *(const f32x4*)(cw + j * 512 + c0), w1 = *(const f32x4*)(cw + j * 512 + c0 + 4);
            a[0] += bflo(w.x) * w0.x; a[1] += bfhi(w.x) * w0.y; a[2] += bflo(w.y) * w0.z; a[3] += bfhi(w.y) * w0.w; a[4] += bflo(w.z) * w1.x; a[5] += bfhi(w.z) * w1.y; a[6] += bflo(w.w) * w1.z; a[7] += bfhi(w.w) * w1.w; } }
#pragma unroll
    for (int q = 0; q < 8; ++q) a[q] = a[q] * sigmoidf_(a[q]);
}
__device__ __forceinline__ void ph_mlstm_a(const Params& p, int l, LAS unsigned char* lds, const int tid, int G, int bid) {
    GAS unsigned char* ws_ = (GAS unsigned char*)p.ws; LAUNDER_S(ws_);
    LAS float* wf = (LAS float*)(lds + LDS_SCR); LAS float* wb = wf + 128; LAS bf16_t* kwt = (LAS bf16_t*)(lds + LDS_SCR + 1024);
    constexpr int NIT = BATCH * 4 * 32;
    u32x4 nxr[8]; bf16x8 nbv[4]; float ngq[8]; f32x4 wq[5][2]; int hw = -1;
#define MA_LOAD(item_, xr_, bv_, gq_) do { int t__ = tid; LAUNDER_V(t__); GAS unsigned char* w__ = ws_; LAUNDER_S(w__); const int itr_ = NIT - 1 - (item_), chunk_ = itr_ & 31, h_ = (itr_ >> 5) & 3, b_ = itr_ >> 7; \
        const int slot_ = t__ & 31, cg_ = t__ >> 5, ch_ = ((cg_ >> 3) ? C_MK : C_MQ) + h_ * 64 + (cg_ & 7) * 8, ln_ = t__ & 63, wv_ = __builtin_amdgcn_readfirstlane(t__ >> 6); \
        const GAS bf16_t* pj_ = (const GAS bf16_t*)(w__ + WS_PROJ); \
        _Pragma("unroll") for (int r = 0; r < 8; ++r) { const int sg = chunk_ * 128 + 4 * slot_ - 2 + r, sc = min(max(sg, 0), SEQ - 1); xr_[r] = *(const GAS u32x4*)(pj_ + (size_t)(b_ * SEQ + sc) * NPROJ + ch_); } \
        { const GAS bf16_t* vp = (const GAS bf16_t*)(w__ + WS_VT) + ((size_t)((b_ * 4 + h_) * 128 + 16 * wv_ + (ln_ & 15))) * SEQ + chunk_ * 128 + 8 * (ln_ >> 4); \
          _Pragma("unroll") for (int ks = 0; ks < 4; ++ks) bv_[ks] = *(const GAS bf16x8*)(vp + 32 * ks); } \
        if (wv_ == 0) { const GAS float* gp = (const GAS float*)(w__ + WS_GATES) + (size_t)(b_ * SEQ + chunk_ * 128 + 2 * ln_) * 16 + h_; \
          _Pragma("unroll") for (int q = 0; q < 8; ++q) gq_[q] = gp[4 * q]; } } while (0)
    if (bid < NIT) MA_LOAD(bid, nxr, nbv, ngq);
#pragma unroll 1
    for (int item = bid; item < NIT; item += G) {
        GAS unsigned char* wsl = ws_; LAUNDER_S(wsl); int tid_ = tid; LAUNDER_V(tid_);
        const int lane = tid_ & 63, wave = __builtin_amdgcn_readfirstlane(tid_ >> 6), fr = lane & 15, g = lane >> 4;
        GAS bf16_t* qkc = (GAS bf16_t*)(wsl + WS_QKC);
        GAS float* mkv = (GAS float*)(wsl + WS_MKV); GAS float* mn = (GAS float*)(wsl + WS_MN); GAS float* cst = (GAS float*)(wsl + WS_MCST); GAS float* gst = (GAS float*)(wsl + WS_MGST); const GAS float* cw = (const GAS float*)(p.conv_qk + (size_t)l * 5 * 512);
        const int itr = NIT - 1 - item;
        const int chunk = itr & 31, h = (itr >> 5) & 3, b = itr >> 7, tokb = b * SEQ + chunk * 128, ccf = ((b * 4 + h) * 2) * 32 + chunk, ccb = ccf + 32;
        const int slot = tid_ & 31, cg = tid_ >> 5, isk = cg >> 3, ch0 = (isk ? C_MK : C_MQ) + h * 64 + (cg & 7) * 8;
        u32x4 xr[8]; bf16x8 bv[4]; float gq[8];
#pragma unroll
        for (int r = 0; r < 8; ++r) xr[r] = nxr[r];
#pragma unroll
        for (int ks = 0; ks < 4; ++ks) bv[ks] = nbv[ks];
#pragma unroll
        for (int q = 0; q < 8; ++q) gq[q] = ngq[q];
        if (h != hw) { hw = h;
#pragma unroll
            for (int tp = 0; tp < 5; ++tp) { wq[tp][0] = *(const GAS f32x4*)(cw + tp * 512 + ch0); wq[tp][1] = *(const GAS f32x4*)(cw + tp * 512 + ch0 + 4); } }
#pragma unroll
        for (int r = 0; r < 8; ++r) { const int sg = chunk * 128 + 4 * slot - 2 + r; if (sg < 0 || sg >= SEQ) xr[r] = (u32x4){0u, 0u, 0u, 0u}; }
        if (item + G < NIT) MA_LOAD(item + G, nxr, nbv, ngq);
        if (wave == 0) {
            const int t0 = 2 * lane;
            const float if0 = gq[0], ff0 = gq[1], ib0 = gq[2], fb0 = gq[3], if1 = gq[4], ff1 = gq[5], ib1 = gq[6], fb1 = gq[7];
            const float lf0 = logsigmoidf_(ff0), lf1 = logsigmoidf_(ff1), lb0 = logsigmoidf_(fb0), lb1 = logsigmoidf_(fb1);
            const float incf = wave_iscan_add(lf0 + lf1), incb = wave_iscan_add(lb0 + lb1);
            const float totf = __int_as_float(__builtin_amdgcn_readlane(__float_as_int(incf), 63)), totb = __int_as_float(__builtin_amdgcn_readlane(__float_as_int(incb), 63)), basef = incf - (lf0 + lf1), baseb = incb - (lb0 + lb1);
            const float bf0 = basef + lf0, bf1 = basef + lf0 + lf1, bb0 = totb - baseb, bb1 = totb - (baseb + lb0);
            const float uf0 = if0 - bf0, uf1 = if1 - bf1, ub0 = ib0 - bb0, ub1 = ib1 - bb1;
            const float incm = wave_iscan_max(fmaxf(uf0, uf1));
            const float incs = shb(wave_iscan_max(shb(fmaxf(ub0, ub1), 63 - lane)), 63 - lane);
            float exm = shu(incm, 1, lane), exs = shd(incs, 1, lane); if (lane == 0) exm = -3.0e38f; if (lane == 63) exs = -3.0e38f;
            const float pmf0 = fmaxf(exm, uf0), pmf1 = fmaxf(pmf0, uf1), pmb1 = fmaxf(exs, ub1), pmb0 = fmaxf(pmb1, ub0);
            const float maxuf = __int_as_float(__builtin_amdgcn_readlane(__float_as_int(incm), 63)), maxub = __int_as_float(__builtin_amdgcn_readlane(__float_as_int(incs), 0));
            *(LAS f32x2*)(wf + t0) = (f32x2){__expf(uf0 - maxuf), __expf(uf1 - maxuf)}; *(LAS f32x2*)(wb + t0) = (f32x2){__expf(ub0 - maxub), __expf(ub1 - maxub)};
            GAS float* gs = gst + (size_t)itr * 768 + t0;
            *(GAS f32x2*)(gs) = (f32x2){bf0, bf1}; *(GAS f32x2*)(gs + 128) = (f32x2){uf0, uf1}; *(GAS f32x2*)(gs + 256) = (f32x2){pmf0, pmf1};
            *(GAS f32x2*)(gs + 384) = (f32x2){bb0, bb1}; *(GAS f32x2*)(gs + 512) = (f32x2){ub0, ub1}; *(GAS f32x2*)(gs + 640) = (f32x2){pmb0, pmb1};
            if (lane == 0) { *(GAS f32x2*)(cst + 2 * ccf) = (f32x2){totf + maxuf, totf}; *(GAS f32x2*)(cst + 2 * ccb) = (f32x2){totb + maxub, totb}; }
        }
        float cv[4][8];
#pragma unroll
        for (int j = 0; j < 4; ++j) { float a[8];
#pragma unroll
            for (int q = 0; q < 8; ++q) a[q] = 0.f;
#pragma unroll
            for (int tp = 0; tp < 5; ++tp) { const u32x4 w = xr[j + tp]; const f32x4 w0 = wq[tp][0], w1 = wq[tp][1];
                a[0] += bflo(w.x) * w0.x; a[1] += bfhi(w.x) * w0.y; a[2] += bflo(w.y) * w0.z; a[3] += bfhi(w.y) * w0.w; a[4] += bflo(w.z) * w1.x; a[5] += bfhi(w.z) * w1.y; a[6] += bflo(w.w) * w1.z; a[7] += bfhi(w.w) * w1.w; }
            const float sc = isk ? 1.0f : 0.125f;
#pragma unroll
            for (int q = 0; q < 8; ++q) { a[q] = a[q] * sigmoidf_(a[q]); cv[j][q] = a[q]; }
            u32x4 o; o.x = pk2(a[0] * sc, a[1] * sc); o.y = pk2(a[2] * sc, a[3] * sc); o.z = pk2(a[4] * sc, a[5] * sc); o.w = pk2(a[6] * sc, a[7] * sc);
            *(GAS u32x4*)(qkc + (size_t)(tokb + 4 * slot + j) * 512 + isk * 256 + h * 64 + (cg & 7) * 8) = o; }
        __syncthreads();
        if (isk) { const int kc = (cg & 7) * 8; const f32x4 wf4 = *(const LAS f32x4*)(wf + 4 * slot), wb4 = *(const LAS f32x4*)(wb + 4 * slot);
#pragma unroll
            for (int jp = 0; jp < 2; ++jp) { const float wfa = wf4[2 * jp], wfb = wf4[2 * jp + 1], wba = wb4[2 * jp], wbb = wb4[2 * jp + 1];
#pragma unroll
                for (int q = 0; q < 8; ++q) { LAS unsigned* kf = (LAS unsigned*)(kwt + (kc + q) * 136 + 4 * slot + 2 * jp); LAS unsigned* kb = (LAS unsigned*)(kwt + 64 * 136 + (kc + q) * 136 + 4 * slot + 2 * jp);
                    *kf = pk2(cv[2 * jp][q] * wfa, cv[2 * jp + 1][q] * wfb); *kb = pk2(cv[2 * jp][q] * wba, cv[2 * jp + 1][q] * wbb); } } }
        __syncthreads();
        {
#pragma unroll
            for (int dir = 0; dir < 2; ++dir) { GAS bf16_t* outp = (GAS bf16_t*)mkv + ((size_t)(dir ? ccb : ccf) * 128 + 16 * wave + fr) * 64 + 4 * g;
                bf16x8 af[16];
#pragma unroll
                for (int i = 0; i < 16; ++i) af[i] = *(const LAS bf16x8*)(kwt + dir * 64 * 136 + (16 * (i >> 2) + fr) * 136 + 32 * (i & 3) + 8 * g);
                __builtin_amdgcn_sched_barrier(0);
#pragma unroll
                for (int mt = 0; mt < 4; ++mt) { f32x4 acc = {0.f, 0.f, 0.f, 0.f};
#pragma unroll
                    for (int ks = 0; ks < 4; ++ks) acc = __builtin_amdgcn_mfma_f32_16x16x32_bf16(af[mt * 4 + ks], bv[ks], acc, 0, 0, 0);
                    u32x2 w; w.x = pk2c(acc[0], acc[1]); w.y = pk2c(acc[2], acc[3]); *(GAS u32x2*)(outp + 16 * mt) = w; } }
            if (tid_ < 128) { const int dir = tid_ >> 6, dk = tid_ & 63; float sm = 0.f;
#pragma unroll
                for (int c8 = 0; c8 < 16; ++c8) { const u32x4 w4 = *(const LAS u32x4*)(kwt + dir * 64 * 136 + dk * 136 + 8 * c8); sm += (bflo(w4.x) + bfhi(w4.x)) + (bflo(w4.y) + bfhi(w4.y)) + (bflo(w4.z) + bfhi(w4.z)) + (bflo(w4.w) + bfhi(w4.w)); }
                mn[(size_t)(dir ? ccb : ccf) * 64 + dk] = sm; }
        }
        __syncthreads();
    }
}
__device__ __forceinline__ void ph_mlstm_scan(const Params& p, int gtid, int gsz) {
    GAS unsigned char* ws_ = (GAS unsigned char*)p.ws; LAUNDER_S(ws_);
    const GAS bf16_t* mkv = (const GAS bf16_t*)(ws_ + WS_MKV); const GAS float* mn = (const GAS float*)(ws_ + WS_MN); const GAS float* cst = (const GAS float*)(ws_ + WS_MCST);
    GAS bf16_t* mcp = (GAS bf16_t*)(ws_ + WS_MCP); GAS float* mnp = (GAS float*)(ws_ + WS_MNP); GAS float* mmp = (GAS float*)(ws_ + WS_MMP);
    if ((gtid & 511) < 16) {
#pragma unroll 1
        for (int ni = (gtid >> 9) * 16 + (gtid & 511); ni < 64 * 64; ni += (gsz >> 9) * 16) {
            const int chain = ni >> 6, dk = ni & 63, dir = chain & 1; float n = 0.f, m = 0.f;
#pragma unroll 1
            for (int hb = 0; hb < 2; ++hb) { float ncv[16]; f32x2 ag[16];
#pragma unroll
                for (int i = 0; i < 16; ++i) { const int ci = 16 * hb + i, c = dir ? 31 - ci : ci; const size_t cc = (size_t)chain * 32 + c; ncv[i] = mn[cc * 64 + dk]; ag[i] = *(const GAS f32x2*)(cst + 2 * cc); }
#pragma unroll
                for (int i = 0; i < 16; ++i) { const int ci = 16 * hb + i, c = dir ? 31 - ci : ci; const size_t cc = (size_t)chain * 32 + c;
                    mnp[cc * 64 + dk] = n; if (dk == 0) mmp[cc] = m;
                    const float mnew = fmaxf(ag[i].y + m, ag[i].x), sp = __expf(ag[i].y + m - mnew), sc = __expf(ag[i].x - mnew);
                    n = n * sp + ncv[i] * sc; m = mnew; } }
        }
    }
#pragma unroll 1
    for (int idx = gtid; idx < 64 * 128 * 16; idx += gsz) {
        const int dkq = idx & 15, dv = (idx >> 4) & 127, chain = idx >> 11, dir = chain & 1;
        f32x4 C = {0.f, 0.f, 0.f, 0.f}; float m = 0.f;
#pragma unroll 1
        for (int hb = 0; hb < 2; ++hb) {
            u32x2 kvw[16]; f32x2 ag[16];
#pragma unroll
            for (int i = 0; i < 16; ++i) { const int ci = 16 * hb + i, c = dir ? 31 - ci : ci; const size_t cc = (size_t)chain * 32 + c; kvw[i] = *(const GAS u32x2*)(mkv + (cc * 128 + dv) * 64 + dkq * 4); ag[i] = *(const GAS f32x2*)(cst + 2 * cc); }
#pragma unroll
            for (int i = 0; i < 16; ++i) { const int ci = 16 * hb + i, c = dir ? 31 - ci : ci; const size_t cc = (size_t)chain * 32 + c;
                u32x2 w; w.x = pk2(C[0], C[1]); w.y = pk2(C[2], C[3]); *(GAS u32x2*)(mcp + (cc * 128 + dv) * 64 + dkq * 4) = w;
                const float mnew = fmaxf(ag[i].y + m, ag[i].x), sp = __expf(ag[i].y + m - mnew), sc = __expf(ag[i].x - mnew);
                const f32x4 kv = {bflo(kvw[i].x), bfhi(kvw[i].x), bflo(kvw[i].y), bfhi(kvw[i].y)};
                C = C * sp + kv * sc; m = mnew; }
        }
    }
}
__device__ __forceinline__ void ph_mlstm_c(const Params& p, int l, LAS unsigned char* lds, const int tid, int G, int bid) {
    GAS unsigned char* ws_ = (GAS unsigned char*)p.ws; LAUNDER_S(ws_);
    LAS unsigned char* kl = lds + LDS_SCR; LAS unsigned char* vl = kl + 128 * 144; LAS unsigned char* cfl = vl + 128 * 272; LAS unsigned char* cbl = cfl + 128 * 144; LAS float* ugl = (LAS float*)(cbl + 128 * 144);
#pragma unroll 1
    for (int item = bid; item < BATCH * 4 * 32; item += G) {
        GAS unsigned char* wsl = ws_; LAUNDER_S(wsl);
        int tid_ = tid; LAUNDER_V(tid_);
        const int lane = tid_ & 63, wave = __builtin_amdgcn_readfirstlane(tid_ >> 6), fr = lane & 15, g = lane >> 4;
        const GAS bf16_t* proj = (const GAS bf16_t*)(wsl + WS_PROJ); const GAS bf16_t* qkc = (const GAS bf16_t*)(wsl + WS_QKC); const GAS bf16_t* vt = (const GAS bf16_t*)(wsl + WS_VT); const GAS bf16_t* mcp = (const GAS bf16_t*)(wsl + WS_MCP);
        const GAS float* mnp = (const GAS float*)(wsl + WS_MNP); const GAS float* mmp = (const GAS float*)(wsl + WS_MMP); const GAS float* gst = (const GAS float*)(wsl + WS_MGST); GAS bf16_t* y = (GAS bf16_t*)(wsl + WS_Y);
        const int chunk = item & 31, h = (item >> 5) & 3, b = item >> 7, tokb = b * SEQ + chunk * 128, t = 16 * wave + fr, tq = tokb + t;
        const size_t ccf = (size_t)((b * 4 + h) * 2) * 32 + chunk, ccb = ccf + 32;
        const GAS bf16_t* qp = qkc + (size_t)tq * 512 + h * 64 + 8 * g;
        const u32x4 q0 = *(const GAS u32x4*)qp, q1 = *(const GAS u32x4*)(qp + 32);
        const GAS float* gs = gst + (size_t)item * 768;
        const float bfw = gs[t], pmf = gs[256 + t], bbw = gs[384 + t], pmb = gs[640 + t], mpf = mmp[ccf], mpb = mmp[ccb];
        f32x4 npf[4], npb[4];
#pragma unroll
        for (int i = 0; i < 4; ++i) { npf[i] = *(const GAS f32x4*)(mnp + ccf * 64 + 32 * (i >> 1) + 8 * g + 4 * (i & 1)); npb[i] = *(const GAS f32x4*)(mnp + ccb * 64 + 32 * (i >> 1) + 8 * g + 4 * (i & 1)); }
        unsigned ogw[8];
        { const GAS unsigned char* op = (const GAS unsigned char*)(wsl + WS_OG) + (size_t)tq * 512 + h * 128 + 4 * g;
#pragma unroll
          for (int mt = 0; mt < 8; ++mt) ogw[mt] = *(const GAS unsigned*)(op + 16 * mt); }
        __syncthreads();
        { u32x4 tk[2], tv[4], tf[2], tb[2];
#pragma unroll
          for (int i = 0; i < 2; ++i) { const int idx = tid_ + 512 * i, rho = idx >> 3, c = idx & 7, key = (rho & ~31) + 8 * ((rho & 15) >> 2) + 4 * ((rho >> 4) & 1) + (rho & 3);
              tk[i] = *(const GAS u32x4*)(qkc + (size_t)(tokb + key) * 512 + 256 + h * 64 + c * 8);
              tf[i] = *(const GAS u32x4*)(mcp + (ccf * 128 + rho) * 64 + c * 8); tb[i] = *(const GAS u32x4*)(mcp + (ccb * 128 + rho) * 64 + c * 8); }
#pragma unroll
          for (int i = 0; i < 4; ++i) { const int idx = tid_ + 512 * i, dv = idx >> 4, c = idx & 15; tv[i] = *(const GAS u32x4*)(vt + ((size_t)((b * 4 + h) * 128 + dv)) * SEQ + chunk * 128 + c * 8); }
          f32x4 ugv = {0.f, 0.f, 0.f, 0.f};
          if (tid_ < 64) { const GAS float* gsu = gst + (size_t)item * 768 + (tid_ < 32 ? 128 : 512 - 128) + 4 * tid_; ugv = *(const GAS f32x4*)gsu; }
#pragma unroll
          for (int i = 0; i < 2; ++i) { const int idx = tid_ + 512 * i, rho = idx >> 3, c = idx & 7; *(LAS u32x4*)(kl + rho * 144 + c * 16) = tk[i]; *(LAS u32x4*)(cfl + rho * 144 + c * 16) = tf[i]; *(LAS u32x4*)(cbl + rho * 144 + c * 16) = tb[i]; }
#pragma unroll
          for (int i = 0; i < 4; ++i) { const int idx = tid_ + 512 * i; *(LAS u32x4*)(vl + (idx >> 4) * 272 + (idx & 15) * 16) = tv[i]; }
          if (tid_ < 64) *(LAS f32x4*)(ugl + 4 * tid_) = ugv; }
        const float Mf = fmaxf(mpf, pmf), Mb = fmaxf(mpb, pmb), sif = __expf(mpf - Mf), sib = __expf(mpb - Mb), flf = __expf(-bfw - Mf), flb = __expf(-bbw - Mb);
        const float qv[16] = {bflo(q0.x), bfhi(q0.x), bflo(q0.y), bfhi(q0.y), bflo(q0.z), bfhi(q0.z), bflo(q0.w), bfhi(q0.w), bflo(q1.x), bfhi(q1.x), bflo(q1.y), bfhi(q1.y), bflo(q1.z), bfhi(q1.z), bflo(q1.w), bfhi(q1.w)};
        float qnf = 0.f, qnb = 0.f;
#pragma unroll
        for (int ks = 0; ks < 2; ++ks)
#pragma unroll
            for (int hf = 0; hf < 2; ++hf) { const f32x4 nf = npf[ks * 2 + hf], nb = npb[ks * 2 + hf];
#pragma unroll
                for (int q = 0; q < 4; ++q) { qnf += qv[ks * 8 + hf * 4 + q] * nf[q]; qnb += qv[ks * 8 + hf * 4 + q] * nb[q]; } }
        qnf = rows_sum4(qnf); qnb = rows_sum4(qnb);
        const bf16x8 qf0 = __builtin_bit_cast(bf16x8, q0), qf1 = __builtin_bit_cast(bf16x8, q1);
        __syncthreads();
        f32x4 scf[4][2], scb[4][2]; float rsf = 0.f, rsb = 0.f;
        bf16x8 kfr[8][2];
#pragma unroll
        for (int i = 0; i < 8; ++i) { const LAS unsigned char* ka = kl + (16 * i + fr) * 144 + 16 * g; kfr[i][0] = *(const LAS bf16x8*)ka; kfr[i][1] = *(const LAS bf16x8*)(ka + 64); }
        __builtin_amdgcn_sched_barrier(0);
#pragma unroll
        for (int Gk = 0; Gk < 4; ++Gk)
#pragma unroll
            for (int tt = 0; tt < 2; ++tt) {
                f32x4 z = {0.f, 0.f, 0.f, 0.f};
                z = __builtin_amdgcn_mfma_f32_16x16x32_bf16(kfr[2 * Gk + tt][0], qf0, z, 0, 0, 0); z = __builtin_amdgcn_mfma_f32_16x16x32_bf16(kfr[2 * Gk + tt][1], qf1, z, 0, 0, 0);
                const int s0 = 32 * Gk + 8 * g + 4 * tt; const f32x4 uf = *(const LAS f32x4*)(ugl + s0), ub = *(const LAS f32x4*)(ugl + 128 + s0);
#pragma unroll
                for (int q = 0; q < 4; ++q) { const int s = s0 + q; const float ef = __expf(s <= t ? uf[q] - Mf : -1e30f), eb = __expf(s >= t ? ub[q] - Mb : -1e30f);
                    scf[Gk][tt][q] = z[q] * ef; scb[Gk][tt][q] = z[q] * eb; rsf += scf[Gk][tt][q]; rsb += scb[Gk][tt][q]; } }
        rsf = rows_sum4(rsf); rsb = rows_sum4(rsb);
        const float invf = 1.0f / fmaxf(fabsf(sif * qnf + rsf), flf), invb = 1.0f / fmaxf(fabsf(sib * qnb + rsb), flb), cf = sif * invf, cb = sib * invb;
        bf16x8 pf[4], qff[2], qfb[2];
#pragma unroll
        for (int Gk = 0; Gk < 4; ++Gk) { float e[8];
#pragma unroll
            for (int tt = 0; tt < 2; ++tt)
#pragma unroll
                for (int q = 0; q < 4; ++q) e[tt * 4 + q] = scf[Gk][tt][q] * invf + scb[Gk][tt][q] * invb;
            u32x4 w; w.x = pk2(e[0], e[1]); w.y = pk2(e[2], e[3]); w.z = pk2(e[4], e[5]); w.w = pk2(e[6], e[7]); pf[Gk] = __builtin_bit_cast(bf16x8, w); }
#pragma unroll
        for (int ks = 0; ks < 2; ++ks) { u32x4 w;
            w.x = pk2(qv[ks * 8 + 0] * cf, qv[ks * 8 + 1] * cf); w.y = pk2(qv[ks * 8 + 2] * cf, qv[ks * 8 + 3] * cf); w.z = pk2(qv[ks * 8 + 4] * cf, qv[ks * 8 + 5] * cf); w.w = pk2(qv[ks * 8 + 6] * cf, qv[ks * 8 + 7] * cf); qff[ks] = __builtin_bit_cast(bf16x8, w);
            w.x = pk2(qv[ks * 8 + 0] * cb, qv[ks * 8 + 1] * cb); w.y = pk2(qv[ks * 8 + 2] * cb, qv[ks * 8 + 3] * cb); w.z = pk2(qv[ks * 8 + 4] * cb, qv[ks * 8 + 5] * cb); w.w = pk2(qv[ks * 8 + 6] * cb, qv[ks * 8 + 7] * cb); qfb[ks] = __builtin_bit_cast(bf16x8, w); }
        f32x4 O[8]; float ss = 0.f;
#pragma unroll
        for (int hv = 0; hv < 2; ++hv) {
            bf16x8 fa[4][8];
#pragma unroll
            for (int m2 = 0; m2 < 4; ++m2) { const int mt = 4 * hv + m2; const LAS unsigned char* va = vl + (16 * mt + fr) * 272 + 16 * g; const LAS unsigned char* fp = cfl + (16 * mt + fr) * 144 + 16 * g; const LAS unsigned char* bp = cbl + (16 * mt + fr) * 144 + 16 * g;
#pragma unroll
                for (int Gk = 0; Gk < 4; ++Gk) fa[m2][Gk] = *(const LAS bf16x8*)(va + 64 * Gk);
                fa[m2][4] = *(const LAS bf16x8*)fp; fa[m2][5] = *(const LAS bf16x8*)(fp + 64); fa[m2][6] = *(const LAS bf16x8*)bp; fa[m2][7] = *(const LAS bf16x8*)(bp + 64); }
            __builtin_amdgcn_sched_barrier(0);
#pragma unroll
            for (int m2 = 0; m2 < 4; ++m2) { f32x4 acc = {0.f, 0.f, 0.f, 0.f};
#pragma unroll
                for (int Gk = 0; Gk < 4; ++Gk) acc = __builtin_amdgcn_mfma_f32_16x16x32_bf16(fa[m2][Gk], pf[Gk], acc, 0, 0, 0);
                acc = __builtin_amdgcn_mfma_f32_16x16x32_bf16(fa[m2][4], qff[0], acc, 0, 0, 0); acc = __builtin_amdgcn_mfma_f32_16x16x32_bf16(fa[m2][5], qff[1], acc, 0, 0, 0);
                acc = __builtin_amdgcn_mfma_f32_16x16x32_bf16(fa[m2][6], qfb[0], acc, 0, 0, 0); acc = __builtin_amdgcn_mfma_f32_16x16x32_bf16(fa[m2][7], qfb[1], acc, 0, 0, 0);
                O[4 * hv + m2] = acc; ss += acc[0] * acc[0] + acc[1] * acc[1] + acc[2] * acc[2] + acc[3] * acc[3]; }
        }
        ss = rows_sum4(ss);
        const float rr = rsqrtf(ss * (1.0f / 128.0f) + EPS);
        const GAS float* gm = (const GAS float*)(p.g_mh + l * 512 + h * 128 + 4 * g); GAS bf16_t* yo = y + (size_t)tq * D + h * 128 + 4 * g; GAS unsigned char* yo8 = (GAS unsigned char*)y + (size_t)tq * D + h * 128 + 4 * g; const bool y8 = l >= Y8_FROM; const float rrs = y8 ? 8.0f * rr : rr;
        f32x4 gmv[8];
#pragma unroll
        for (int mt = 0; mt < 8; ++mt) gmv[mt] = *(const GAS f32x4*)(gm + 16 * mt);
#pragma unroll
        for (int mt = 0; mt < 8; ++mt) { const unsigned ow = ogw[mt]; const f32x4 gv = gmv[mt];
            const float o0 = sigmoidf_(0.125f * __builtin_amdgcn_cvt_f32_fp8(ow, 0)) * O[mt][0] * rrs * gv.x, o1 = sigmoidf_(0.125f * __builtin_amdgcn_cvt_f32_fp8(ow, 1)) * O[mt][1] * rrs * gv.y, o2 = sigmoidf_(0.125f * __builtin_amdgcn_cvt_f32_fp8(ow, 2)) * O[mt][2] * rrs * gv.z, o3 = sigmoidf_(0.125f * __builtin_amdgcn_cvt_f32_fp8(ow, 3)) * O[mt][3] * rrs * gv.w;
            if (y8) *(GAS unsigned*)(yo8 + 16 * mt) = pg8::pk4_fp8(o0, o1, o2, o3);
            else { u32x2 w; w.x = pk2(o0, o1); w.y = pk2(o2, o3); *(GAS u32x2*)(yo + 16 * mt) = w; } }
    }
    __syncthreads();
}

__device__ __forceinline__ unsigned wave_iscan_addu(unsigned v) {
#define DPPU(v_, ctrl_, rmask_) ((unsigned)__builtin_amdgcn_update_dpp(0, (int)(v_), (ctrl_), (rmask_), 0xF, true))
    v += DPPU(v, 0x111, 0xF); v += DPPU(v, 0x112, 0xF); v += DPPU(v, 0x114, 0xF); v += DPPU(v, 0x118, 0xF);
    v += DPPU(v, 0x142, 0xA); v += DPPU(v, 0x143, 0xC);
#undef DPPU
    return v; }
__device__ __forceinline__ unsigned block_excl_scan(unsigned val, LAS unsigned* wtot, int lane, int wave) {
    const unsigned inc = wave_iscan_addu(val);
    if (lane == 63) wtot[wave] = inc;
    __syncthreads();
    unsigned base = 0;
    for (int w = 0; w < wave; ++w) base += wtot[w];
    __syncthreads();
    return base + inc - val;
}
__device__ __forceinline__ void ph_topk(const Params& p, LAS unsigned char* lds, const int tid, int G, int bid) {
    GAS unsigned char* ws_ = (GAS unsigned char*)p.ws; LAUNDER_S(ws_);
    const int lane = tid & 63, wave = __builtin_amdgcn_readfirstlane(tid >> 6);
    LAS unsigned* hist = (LAS unsigned*)(lds + LDS_SCR); LAS unsigned* sel = hist + 256; LAS unsigned* wtot = hist + 272;
    const GAS float* aff = (const GAS float*)(ws_ + WS_AFF); GAS int* slot_tok = (GAS int*)(ws_ + WS_ROUTE + RT_SLOTTOK); GAS float* gate_slot = (GAS float*)(ws_ + WS_ROUTE + RT_GATE); GAS int* slotmap = (GAS int*)(ws_ + WS_ROUTE + RT_SLOTMAP);
    for (int item = bid; item < BATCH * NE; item += G) {
        const int b = item >> 4, e = item & 15; const GAS float* av = aff + (size_t)item * SEQ + tid * 8;
        const f32x4 v0 = *(const GAS f32x4*)av, v1 = *(const GAS f32x4*)(av + 4);
        const float vals[8] = {v0.x, v0.y, v0.z, v0.w, v1.x, v1.y, v1.z, v1.w}; unsigned key[8];
#pragma unroll
        for (int i = 0; i < 8; ++i) key[i] = __float_as_uint(vals[i]);
        unsigned prefix = 0u, mask = 0u, remaining = CAP;
        for (int pass = 0; pass < 4; ++pass) { const int shift = 24 - 8 * pass;
            if (tid < 256) hist[tid] = 0u;
            __syncthreads();
#pragma unroll
            for (int i = 0; i < 8; ++i) if ((key[i] & mask) == prefix) atomicAdd((unsigned*)&hist[(key[i] >> shift) & 255u], 1u);
            __syncthreads();
            if (wave == 0) { const unsigned c0 = hist[255 - 4 * lane], c1 = hist[254 - 4 * lane], c2 = hist[253 - 4 * lane], c3 = hist[252 - 4 * lane]; const unsigned sm = c0 + c1 + c2 + c3; const unsigned inc = wave_iscan_addu(sm);
                const unsigned before = inc - sm;
                if (before < remaining && remaining <= inc) { unsigned r = remaining - before; unsigned d;
                    if (r <= c0) d = 255 - 4 * lane; else if (r <= c0 + c1) { d = 254 - 4 * lane; r -= c0; } else if (r <= c0 + c1 + c2) { d = 253 - 4 * lane; r -= c0 + c1; } else { d = 252 - 4 * lane; r -= c0 + c1 + c2; }
                    sel[0] = prefix | (d << shift); sel[1] = r; } }
            __syncthreads();
            prefix = sel[0]; remaining = sel[1]; mask |= 0xffu << shift;
        }
        unsigned ceq = 0;
#pragma unroll
        for (int i = 0; i < 8; ++i) ceq += (key[i] == prefix) ? 1u : 0u;
        unsigned eqb = block_excl_scan(ceq, wtot, lane, wave);
        bool sl[8]; unsigned csel = 0;
#pragma unroll
        for (int i = 0; i < 8; ++i) { const bool eq = key[i] == prefix; sl[i] = key[i] > prefix || (eq && eqb < remaining); eqb += eq ? 1u : 0u; csel += sl[i] ? 1u : 0u; }
        unsigned pos = block_excl_scan(csel, wtot, lane, wave);
#pragma unroll
        for (int i = 0; i < 8; ++i) { const int s = tid * 8 + i; int c = -1;
            if (sl[i]) { c = (int)pos++; const int slot = (e * BATCH + b) * CAP + c; slot_tok[slot] = b * SEQ + s; gate_slot[slot] = vals[i];
                slotmap[(size_t)(b * SEQ + s) * NE + e] = c; } }
        __syncthreads();
    }
}
__device__ __forceinline__ void ph_gather(const Params& p, const int tid, int G, int bid) {
    unsigned char* ws_ = p.ws; LAUNDER_S(ws_);
    const int lane = tid & 63, gw = bid * 8 + __builtin_amdgcn_readfirstlane(tid >> 6), NGW = G * 8;
    const bf16_t* hb = (const bf16_t*)(ws_ + WS_H); bf16_t* xe = (bf16_t*)(ws_ + WS_XE); const int* slot_tok = (const int*)(ws_ + WS_ROUTE + RT_SLOTTOK);
    for (int r = gw; r < NSLOT; r += NGW) { const int tok = slot_tok[r]; const u32x4* s = (const u32x4*)((const unsigned char*)hb + (size_t)tok * D) + lane; u32x4* d = (u32x4*)((unsigned char*)xe + (size_t)r * D) + lane; d[0] = s[0]; }
}

__global__ void __launch_bounds__(512, 2) fwd(Params p) {
    extern __shared__ __attribute__((aligned(16))) unsigned char lds_raw[];
    LAS unsigned char* lds = (LAS unsigned char*)lds_raw;
    const int G = gridDim.x, bid = blockIdx.x, wave0 = __builtin_amdgcn_readfirstlane((int)threadIdx.x >> 6);
    { const int t = FRESH_TID(); if (t < 64) ((LAS unsigned*)lds)[t] = 0u; }
    __syncthreads();
    unsigned* ctl = (unsigned*)(p.ws + WS_CTL);
    XcdBarrier bar = xcd_barrier_post(ctl + CW_BAR + p.li * XCD_BAR_WORDS, (volatile LAS unsigned*)(lds + 16), wave0);
    const int lo = p.ph_lo, hi = p.ph_hi;
#define IN(k) (lo <= (k) && (k) < hi)
#define SEAM(k) do { if (IN(k) && IN((k) + 1)) xcd_barrier(bar); } while (0)
#define GTID(t) (bid * 512 + (t))
    LAS unsigned char* ring = lds + LDS_SCR;

    if (IN(0)) REPEAT(11) ph_convert(p, lds, FRESH_TID(), G, bid);
    SEAM(0);
    if (IN(1)) {
        unsigned char* ws_ = p.ws; LAUNDER_S(ws_);
        pg8::Gemm g{(const bf16_t*)(ws_ + WS_MEMH), (const bf16_t*)(ws_ + WS_WKV), DEPTH * BATCH * NMEM, DEPTH * 512, D}; pg8::KvOrder S{G, bid};
        pg8::EpiKvMem E{ws_, p.mem_gk};
        pg8::gemm_phase<pg8::EpiKvMem, pg8::KvOrder, true, true>(ring, g, S, E, FRESH_TID());
        __syncthreads();
        ph_cvt_experts(p, lds, FRESH_TID(), G, bid);
    }
    SEAM(1);
#pragma unroll 1
    for (int l = 0; l < DEPTH; ++l) {
        const int pb = 2 + 11 * l;
        if (IN(pb + 0)) { if (l == 0) ph_norm<0, true>(p, l, false, lds, FRESH_TID(), G, bid, p.x); else ph_norm<0, false>(p, l, true, lds, FRESH_TID(), G, bid, p.ws + WS_XB); }
        SEAM(pb + 0);
        if (IN(pb + 1)) REPEAT(1) {
            unsigned char* ws_ = p.ws; LAUNDER_S(ws_);
            pg8::Gemm g{(const bf16_t*)(ws_ + WS_XB), (const bf16_t*)(ws_ + WS_WIN) + (size_t)l * NPROJ * D, NTOK, NPROJ, D}; pg8::StaticOrder S; S.init(NTOK, NPROJ, G, bid);
            pg8::EpiProj E{ws_, (const float*)(ws_ + WS_GT) + l * 192, (const float*)(ws_ + WS_RR)};
            pg8::gemm_phase<pg8::EpiProj, pg8::StaticOrder, true, true>(ring, g, S, E, FRESH_TID());
        }
        SEAM(pb + 1);
        if (IN(pb + 2)) REPEAT(2) {
            REPEAT(13) ph_mlstm_a(p, l, lds, FRESH_TID(), G, bid);

            REPEAT(12) ph_na_lds(p, l, lds, FRESH_TID(), G, bid); REPEAT(14) ph_cross_lds(p, l, lds, FRESH_TID(), G, bid);
        }
        SEAM(pb + 2);
        if (IN(pb + 3)) REPEAT(3) { const int t = FRESH_TID(); ph_mlstm_scan(p, GTID(t), G * 512); }
        SEAM(pb + 3);
        if (IN(pb + 4)) REPEAT(4) ph_mlstm_c(p, l, lds, FRESH_TID(), G, bid);
        SEAM(pb + 4);
        if (IN(pb + 5)) REPEAT(5) {
            unsigned char* ws_ = p.ws; LAUNDER_S(ws_);
            pg8::Gemm g{(const bf16_t*)(ws_ + WS_Y), (const bf16_t*)(ws_ + WS_WOUT) + (size_t)l * D * D, NTOK, D, D}; pg8::StaticOrder S; S.init(NTOK, D, G, bid);
            pg8::EpiResid E{(bf16_t*)(ws_ + WS_XB)};
            if (l >= Y8_FROM) { pg8::Gemm g8{(const bf16_t*)(ws_ + WS_Y), (const bf16_t*)(ws_ + WS_WOUT) + (size_t)l * D * D, NTOK, D, D / 2};
                pg8::gemm_phase_f8<pg8::EpiResid, pg8::StaticOrder, true, true, 124, 119>(ring, g8, S, E, FRESH_TID()); }
            else pg8::gemm_phase<pg8::EpiResid, pg8::StaticOrder, true, true>(ring, g, S, E, FRESH_TID());
        }
        SEAM(pb + 5);
        if (IN(pb + 6)) ph_norm1_t4(p, l, lds, FRESH_TID(), G, bid);
        SEAM(pb + 6);
        if (IN(pb + 7)) REPEAT(7) ph_topk(p, lds, FRESH_TID(), G, bid);
        SEAM(pb + 7);
        if (IN(pb + 9)) REPEAT(9) {
            unsigned char* ws_ = p.ws; LAUNDER_S(ws_);
            pg8::Gemm g{(const bf16_t*)(ws_ + WS_H), (const bf16_t*)(ws_ + WS_W13 + (size_t)l * NE * 4096 * D), NSLOT, NE * 4096, D / 2}; pg8::MoeOrder S{G, bid, 16, 256};
            pg8::EpiSwiGLU8 E{ws_ + WS_HID};
            pg8::gemm_phase_f8g<pg8::EpiSwiGLU8, pg8::MoeOrder, true, true, 124, 119>(ring, g, S, E, FRESH_TID(), (const int*)(ws_ + WS_ROUTE + RT_SLOTTOK));
        }
        SEAM(pb + 9);
        if (IN(pb + 10)) REPEAT(10) {
            unsigned char* ws_ = p.ws; LAUNDER_S(ws_);
            pg8::Gemm g{(const bf16_t*)(ws_ + WS_HID), (const bf16_t*)(ws_ + WS_W2 + (size_t)l * NE * D * DFF), NSLOT, NE * D, DFF / 2}; pg8::MoeOrder S{G, bid, 4, 64};
            pg8::EpiGate E{(bf16_t*)(ws_ + WS_YBUF), (const float*)(ws_ + WS_ROUTE + RT_GATE)};
            pg8::gemm_phase_f8<pg8::EpiGate, pg8::MoeOrder, true, true, 124, 119>(ring, g, S, E, FRESH_TID());
        }
        SEAM(pb + 10);
    }
    if (IN(NPHASE - 1)) ph_norm<2, false>(p, 0, true, lds, FRESH_TID(), G, bid, p.ws + WS_XB);
#undef GTID
#undef IN
#undef SEAM
}

#ifndef ATTN_NAIVE
#define ATTN_NAIVE 0
#endif
#ifndef MK_PER_PHASE
#define MK_PER_PHASE 0
#endif
extern "C" void kernel_launch(void* const* d_in, const int* in_sizes, int n_in, void* d_out, int out_size, void* d_ws, size_t ws_size, hipStream_t stream) {
    static int grid = 0;
    if (grid == 0) {
        if (n_in != 20 || out_size != NTOK * D || ws_size < WS_END) { fprintf(stderr, "kernel_launch: unexpected shapes (n_in %d, out %d, ws %zu < %zu)\n", n_in, out_size, ws_size, (size_t)WS_END); grid = -1; return; }
        int dev = 0, cus = 0, per_cu = 0;
        if (hipGetDevice(&dev) != hipSuccess || hipDeviceGetAttribute(&cus, hipDeviceAttributeMultiprocessorCount, dev) != hipSuccess) { grid = -1; return; }
        if (hipFuncSetAttribute((const void*)fwd, hipFuncAttributeMaxDynamicSharedMemorySize, LDS_BYTES) != hipSuccess) { fprintf(stderr, "kernel_launch: hipFuncSetAttribute failed\n"); grid = -1; return; }
        if (hipOccupancyMaxActiveBlocksPerMultiprocessor(&per_cu, (const void*)fwd, 512, LDS_BYTES) != hipSuccess || per_cu < 1) { fprintf(stderr, "kernel_launch: occupancy query says %d\n", per_cu); per_cu = 1; }
        (void)hipGetLastError();
        grid = cus;
    }
    if (grid < 0) return;
    (void)hipMemsetAsync((char*)d_ws + WS_CTL, 0, MK_PER_PHASE ? CTL_BYTES : (size_t)64 * 1024, stream);
    Params P{};
    const float** pp = (const float**)&P;
    for (int i = 0; i < 20; ++i) pp[i] = (const float*)d_in[i];
    P.out = (float*)d_out; P.ws = (unsigned char*)d_ws; P.pad = 0;
#if MK_PER_PHASE
    for (int ph = 0; ph < NPHASE; ++ph) { P.ph_lo = ph; P.ph_hi = ph + 1; P.li = ph; hipLaunchKernelGGL(fwd, dim3(grid), dim3(512), LDS_BYTES, stream, P); }
#else
    P.ph_lo = 0; P.ph_hi = NPHASE; P.li = 0;
    hipLaunchKernelGGL(fwd, dim3(grid), dim3(512), LDS_BYTES, stream, P);
#endif
}
```
